# Optimizing an MI355X kernel written in HIP

```python
import jax, jax.numpy as jnp
from jax import lax
import numpy as np

D_MODEL = 1024
BATCH = 2
SEQ = 8192
DEPTH = 2

N_MIXERS = 2

HG_HEADS = 8
HG_DK = D_MODEL // HG_HEADS
HG_DV = D_MODEL // HG_HEADS
HG_KDIM = HG_HEADS * HG_DK
HG_VDIM = HG_HEADS * HG_DV
HG_CHUNK = 64
N_HGRN = (DEPTH + 1) // 2

LRU_WIDTH = D_MODEL
LRU_BLOCKS = 4
LRU_BW = LRU_WIDTH // LRU_BLOCKS
CONV_WIDTH = 4
LRU_C = 8.0
N_LRU = DEPTH // 2

D_FF = ((8 * D_MODEL // 3 + 255) // 256) * 256

EPS = 1e-6

kernel_name = "hgrn2_rglru_interleaved_trunk"


def rmsnorm(x, w):
    xf = x.astype(jnp.float32)
    y = xf * lax.rsqrt(jnp.mean(xf * xf, axis=-1, keepdims=True) + EPS) * w.astype(jnp.float32)
    return y.astype(x.dtype)


def hgrn2_mixer(h, w_in, lb, norm_w, w_out):
    B, S, _ = h.shape
    C = HG_CHUNK
    nc = S // C
    proj = h @ w_in
    q, fl, v, g = jnp.split(proj, [HG_KDIM, 2 * HG_KDIM, 2 * HG_KDIM + HG_VDIM], axis=-1)
    q = jax.nn.silu(q.astype(jnp.float32))
    fl = fl.astype(jnp.float32)
    lbv = lb.astype(jnp.float32)
    log_f = jnp.logaddexp(jnp.log(lbv), jnp.log1p(-lbv) + jax.nn.log_sigmoid(fl))
    k = (1.0 - lbv) * jax.nn.sigmoid(-fl)

    def to_chunks(t, d):
        return t.reshape(B, nc, C, HG_HEADS, d).transpose(1, 0, 3, 2, 4)

    qc = to_chunks(q, HG_DK)
    kc = to_chunks(k, HG_DK)
    vc = to_chunks(v.astype(jnp.float32), HG_DV)
    bc = jnp.cumsum(to_chunks(log_f, HG_DK), axis=3)
    causal = jnp.tril(jnp.ones((C, C), dtype=bool))[:, :, None]

    def step(state, inp):
        qb, kb, vb, bb = inp
        rel = bb[:, :, :, None, :] - bb[:, :, None, :, :]
        decay = jnp.exp(jnp.where(causal, rel, -jnp.inf))
        scores = jnp.einsum('bhtk,bhtsk,bhsk->bhts', qb, decay, kb)
        o = jnp.einsum('bhts,bhsv->bhtv', scores, vb) + jnp.einsum('bhtk,bhkv->bhtv', qb * jnp.exp(bb), state)
        b_last = bb[:, :, -1, :]
        state = jnp.exp(b_last)[..., None] * state + jnp.einsum(
            'bhsk,bhsv->bhkv', kb * jnp.exp(b_last[:, :, None, :] - bb), vb)
        return state, o

    s0 = jnp.zeros((B, HG_HEADS, HG_DK, HG_DV), jnp.float32)
    _, oc = lax.scan(step, s0, (qc, kc, vc, bc))
    o = oc.transpose(1, 0, 3, 2, 4).reshape(B, S, HG_HEADS, HG_DV)
    o = o * lax.rsqrt(jnp.mean(o * o, axis=-1, keepdims=True) + EPS) * norm_w.astype(jnp.float32)
    o = o.reshape(B, S, HG_VDIM) * jax.nn.silu(g.astype(jnp.float32))
    return o.astype(h.dtype) @ w_out


def rglru_mixer(h, w_in, conv_w, conv_b, wa, ba, wx, bx, lam, w_out):
    B, S, _ = h.shape
    proj = h @ w_in
    y, u = jnp.split(proj, [LRU_WIDTH], axis=-1)
    y = jax.nn.gelu(y.astype(jnp.float32))
    u = u.astype(jnp.float32)
    u_pad = jnp.pad(u, ((0, 0), (CONV_WIDTH - 1, 0), (0, 0)))
    cw = conv_w.astype(jnp.float32)
    uc = conv_b.astype(jnp.float32)
    for tap in range(CONV_WIDTH):
        uc = uc + u_pad[:, tap:tap + S, :] * cw[tap]
    ub = uc.reshape(B, S, LRU_BLOCKS, LRU_BW)
    r = jax.nn.sigmoid(jnp.einsum('bsnc,ncd->bsnd', ub, wa.astype(jnp.float32)).reshape(B, S, LRU_WIDTH)
                       + ba.astype(jnp.float32))
    ig = jax.nn.sigmoid(jnp.einsum('bsnc,ncd->bsnd', ub, wx.astype(jnp.float32)).reshape(B, S, LRU_WIDTH)
                        + bx.astype(jnp.float32))
    log_a = -LRU_C * r * jax.nn.softplus(-lam.astype(jnp.float32))
    a = jnp.exp(log_a)
    b_in = jnp.sqrt(-jnp.expm1(2.0 * log_a)) * (ig * uc)

    def combine(left, right):
        a1, b1 = left
        a2, b2 = right
        return a1 * a2, a2 * b1 + b2

    _, hs = lax.associative_scan(combine, (a, b_in), axis=1)
    return (hs * y).astype(h.dtype) @ w_out


def swiglu(h, w_in, w_out):
    gate, up = jnp.split(h @ w_in, [D_FF], axis=-1)
    return (jax.nn.silu(gate) * up) @ w_out


def setup_inputs(seed: int = 0) -> dict:
    key = jax.random.key(seed)
    ks = jax.random.split(key, 24)
    f32 = jnp.float32
    D = D_MODEL

    def nrm(k, shape, fan_in):
        return jax.random.normal(k, shape, f32) * (fan_in ** -0.5)

    x = jax.random.normal(ks[0], (BATCH, SEQ, D), f32)
    norm_mix = 1.0 + 0.02 * jax.random.normal(ks[1], (DEPTH, D), f32)
    norm_ffn = 1.0 + 0.02 * jax.random.normal(ks[2], (DEPTH, D), f32)
    norm_final = 1.0 + 0.02 * jax.random.normal(ks[3], (D,), f32)

    hgrn_w_in = nrm(ks[4], (N_HGRN, D, 2 * HG_KDIM + 2 * HG_VDIM), D)
    hgrn_lb = 0.1 * jax.random.normal(ks[5], (N_HGRN + 1, HG_KDIM), f32)
    hgrn_norm = 1.0 + 0.02 * jax.random.normal(ks[6], (N_HGRN, HG_DV), f32)
    hgrn_w_out = nrm(ks[7], (N_HGRN, HG_VDIM, D), HG_VDIM)

    lru_w_in = nrm(ks[8], (N_LRU, D, 2 * LRU_WIDTH), D)
    lru_conv_w = nrm(ks[9], (N_LRU, CONV_WIDTH, LRU_WIDTH), CONV_WIDTH)
    lru_conv_b = 0.01 * jax.random.normal(ks[10], (N_LRU, LRU_WIDTH), f32)
    lru_wa = nrm(ks[11], (N_LRU, LRU_BLOCKS, LRU_BW, LRU_BW), LRU_BW)
    lru_ba = 0.01 * jax.random.normal(ks[12], (N_LRU, LRU_WIDTH), f32)
    lru_wx = nrm(ks[13], (N_LRU, LRU_BLOCKS, LRU_BW, LRU_BW), LRU_BW)
    lru_bx = 0.01 * jax.random.normal(ks[14], (N_LRU, LRU_WIDTH), f32)
    a0 = jax.random.uniform(ks[15], (N_LRU, LRU_WIDTH), f32, 0.9, 0.999)
    s = a0 ** (1.0 / LRU_C)
    lru_lambda = jnp.log(s) - jnp.log1p(-s)
    lru_w_out = nrm(ks[16], (N_LRU, LRU_WIDTH, D), LRU_WIDTH)

    ffn_w_in = nrm(ks[17], (DEPTH, D, 2 * D_FF), D)
    ffn_w_out = nrm(ks[18], (DEPTH, D_FF, D), D_FF)

    return {"x": x, "norm_mix": norm_mix, "norm_ffn": norm_ffn, "norm_final": norm_final,
            "hgrn_w_in": hgrn_w_in, "hgrn_lb": hgrn_lb, "hgrn_norm": hgrn_norm, "hgrn_w_out": hgrn_w_out,
            "lru_w_in": lru_w_in, "lru_conv_w": lru_conv_w, "lru_conv_b": lru_conv_b,
            "lru_wa": lru_wa, "lru_ba": lru_ba, "lru_wx": lru_wx, "lru_bx": lru_bx,
            "lru_lambda": lru_lambda, "lru_w_out": lru_w_out,
            "ffn_w_in": ffn_w_in, "ffn_w_out": ffn_w_out}


def reference(x, norm_mix, norm_ffn, norm_final, hgrn_w_in, hgrn_lb, hgrn_norm, hgrn_w_out,
              lru_w_in, lru_conv_w, lru_conv_b, lru_wa, lru_ba, lru_wx, lru_bx, lru_lambda, lru_w_out,
              ffn_w_in, ffn_w_out):
    lb_all = jnp.cumsum(jax.nn.softmax(hgrn_lb.astype(jnp.float32), axis=0), axis=0)
    for l in range(DEPTH):
        j = l // N_MIXERS
        hn = rmsnorm(x, norm_mix[l])
        if l % N_MIXERS == 0:
            mix = hgrn2_mixer(hn, hgrn_w_in[j], lb_all[j], hgrn_norm[j], hgrn_w_out[j])
        else:
            mix = rglru_mixer(hn, lru_w_in[j], lru_conv_w[j], lru_conv_b[j], lru_wa[j], lru_ba[j],
                              lru_wx[j], lru_bx[j], lru_lambda[j], lru_w_out[j])
        x = x + mix
        x = x + swiglu(rmsnorm(x, norm_ffn[l]), ffn_w_in[l], ffn_w_out[l])
    return rmsnorm(x, norm_final)
```

```cpp
#include <hip/hip_runtime.h>
#include <cstdio>
#include <cstdint>
namespace pg8 {
#define PG8_LAS __attribute__((address_space(3)))
typedef unsigned short bf16_t;
typedef short bf16x8 __attribute__((ext_vector_type(8)));
typedef float f32x4 __attribute__((ext_vector_type(4)));
typedef unsigned u32x4 __attribute__((ext_vector_type(4)));
constexpr int BM = 256, BK = 64, HALF = 128, HTB = HALF * BK * 2  , STAGE_BYTES = 8 * HTB, NXCD = 8, WGM = 8;

__host__ __device__ __forceinline__ int lds_byte(int r, int c) { const int st = (r >> 4) * 2 + (c >> 5), rr = r & 15, cc = c & 31, ob = rr * 64 + cc * 2; return st * 1024 + (ob ^ (((ob >> 9) & 1) << 5)); }
__host__ __device__ __forceinline__ void stage_rc(int b, int& R, int& C) { const int st = b / 1024, sb = b % 1024, swz = sb ^ (((sb >> 9) & 1) << 5); R = (st >> 1) * 16 + swz / 64; C = (st & 1) * 32 + (swz % 64) / 2; }
__host__ __device__ __forceinline__ int perm32(int rho) { const int n = rho >> 4, i = rho & 15; return 8 * (i >> 2) + 4 * n + (i & 3); }

struct Unit { int pm, pn; };
struct Gemm { const bf16_t* A; const bf16_t* Bt; int lda, ldb, K, ablk; };

struct StaticOrder {
    int nM, nN, nwg, G, c;
    __host__ __device__ void init(int nM_, int nN_, int G_, int c_) { nM = nM_; nN = nN_; nwg = nM * nN; G = G_; c = c_; }
    __host__ __device__ bool next(int i, Unit& u) const {
        const long L = (long)i * G + c; if (L >= nwg) return false;
        int wgid = (int)L; { const int q = nwg / NXCD, r = nwg % NXCD, xcd = wgid % NXCD, off = wgid / NXCD; wgid = (xcd < r ? xcd * (q + 1) : r * (q + 1) + (xcd - r) * q) + off; }
        const int nig = WGM * nN, gid = wgid / nig, fm = gid * WGM, gsz = (nM - fm) < WGM ? (nM - fm) : WGM;
        u.pm = fm + ((wgid % nig) % gsz); u.pn = (wgid % nig) / gsz; return true;
    }
    __device__ __forceinline__ void a_ready(const Unit&) const {}
    __device__ __forceinline__ void done(const Unit&) const {}
};
__device__ __forceinline__ unsigned cvt_pk_bf16(float lo, float hi) { unsigned r; asm volatile("v_cvt_pk_bf16_f32 %0, %1, %2" : "=v"(r) : "v"(lo), "v"(hi)); return r; }
template <class Epi, class Sched, bool ALIGN_EPI = false, bool SP2 = false>
__device__ __forceinline__ void gemm_phase(PG8_LAS unsigned char* lds, const Gemm g, const Sched& S, const Epi& E) {
    const int tid = threadIdx.x, wid = __builtin_amdgcn_readfirstlane(tid >> 6), lane = tid & 63, wr = wid >> 2, wc = wid & 3, fr = lane & 15, fq = lane >> 4;
    const int K = g.K, nt = K / BK;
    unsigned voffA[2], voffB[2];
#pragma unroll
    for (int i = 0; i < 2; ++i) { int R, C; stage_rc(tid * 16 + i * 8192, R, C); const int Rb = Epi::PERM ? ((R & ~31) + perm32(R & 31)) : R;
        voffA[i] = (unsigned)(R * g.lda + C) * 2u; voffB[i] = (unsigned)(Rb * g.ldb + C) * 2u; }
    const size_t kstep = (size_t)(BK * 2);
    const size_t hstepA = (size_t)HALF * g.lda * 2, hstepB = (size_t)HALF * g.ldb * 2;
    const unsigned ldsw = (unsigned)wid * 1024u;
    const int aoff = lds_byte(wr * 64 + fr, fq * 8), boff = lds_byte(wc * 32 + fr, fq * 8);
#define PG8_UA(u) ((const char*)g.A + (size_t)(u).pm * 2 * hstepA + (g.ablk ? (size_t)((u).pn >> 1) * 512 : (size_t)0))
#define PG8_UB(u) ((const char*)g.Bt + (size_t)(u).pn * 2 * hstepB)
#define PG8_SA(b, h) (((b) * 2 + (h)) * HTB)
#define PG8_SB(b, h) ((4 + (b) * 2 + (h)) * HTB)
#define PG8_STAGE(bufoff, gbase, voff) do { _Pragma("unroll") for (int _i = 0; _i < 2; ++_i) \
        __builtin_amdgcn_global_load_lds((const unsigned*)((const char*)(gbase) + (voff)[_i]), (PG8_LAS unsigned*)(lds + (bufoff) + ldsw + _i * 8192), 16, 0, 0); } while (0)
#define PG8_LDA(dst, b, h) do { _Pragma("unroll") for (int m = 0; m < 4; ++m) _Pragma("unroll") for (int k = 0; k < 2; ++k) dst[m][k] = *(const PG8_LAS bf16x8*)(lds + PG8_SA(b, h) + aoff + m * 2048 + k * 1024); } while (0)
#define PG8_LDB(dst, b, h) do { _Pragma("unroll") for (int n = 0; n < 2; ++n) _Pragma("unroll") for (int k = 0; k < 2; ++k) dst[n][k] = *(const PG8_LAS bf16x8*)(lds + PG8_SB(b, h) + boff + n * 2048 + k * 1024); } while (0)
#define PG8_MMA(ai, bj, At, Bt) do { __builtin_amdgcn_s_setprio(1); _Pragma("unroll") for (int m = 0; m < 4; ++m) _Pragma("unroll") for (int n = 0; n < 2; ++n) _Pragma("unroll") for (int k = 0; k < 2; ++k) \
        acc[ai][bj][m][n] = __builtin_amdgcn_mfma_f32_16x16x32_bf16(Bt[n][k], At[m][k], acc[ai][bj][m][n], 0, 0, 0); __builtin_amdgcn_s_setprio(0); } while (0)
#define PG8_WAIT_V(n) asm volatile("s_waitcnt vmcnt(" #n ")" ::: "memory")
#define PG8_WAIT_L(n) asm volatile("s_waitcnt lgkmcnt(" #n ")" ::: "memory")
#define PG8_BAR __builtin_amdgcn_s_barrier()
#define PG8_SCHED __builtin_amdgcn_sched_barrier(0)
    Unit cur, nxt; int ui = 0;
    if (!S.next(0, cur)) return;
    f32x4 acc[2][2][4][2];
#pragma unroll
    for (int a = 0; a < 2; ++a)
#pragma unroll
        for (int b = 0; b < 2; ++b)
#pragma unroll
            for (int m = 0; m < 4; ++m)
#pragma unroll
                for (int n = 0; n < 2; ++n) acc[a][b][m][n] = (f32x4){0.f, 0.f, 0.f, 0.f};
    bf16x8 At[4][2], B0[2][2], B1[2][2];
    const char* cA = PG8_UA(cur); const char* cB = PG8_UB(cur);
    S.a_ready(cur);
    if constexpr (SP2) {
        PG8_STAGE(PG8_SB(0, 0), cB, voffB); PG8_STAGE(PG8_SB(0, 1), cB + hstepB, voffB); PG8_STAGE(PG8_SA(0, 0), cA, voffA); PG8_STAGE(PG8_SA(0, 1), cA + hstepA, voffA);
        if (wr == 1) PG8_BAR;
        PG8_WAIT_V(2); PG8_BAR;
        PG8_STAGE(PG8_SB(1, 0), cB + kstep, voffB); PG8_STAGE(PG8_SA(1, 0), cA + kstep, voffA); PG8_STAGE(PG8_SB(1, 1), cB + hstepB + kstep, voffB);
        PG8_WAIT_V(6); PG8_BAR;
    } else {
        PG8_STAGE(PG8_SB(0, 0), cB, voffB); PG8_STAGE(PG8_SA(0, 0), cA, voffA); PG8_STAGE(PG8_SB(0, 1), cB + hstepB, voffB); PG8_STAGE(PG8_SA(0, 1), cA + hstepA, voffA);
        if (wr == 1) PG8_BAR;
        PG8_WAIT_V(4); PG8_BAR;
        PG8_STAGE(PG8_SB(1, 0), cB + kstep, voffB); PG8_STAGE(PG8_SA(1, 0), cA + kstep, voffA); PG8_STAGE(PG8_SB(1, 1), cB + hstepB + kstep, voffB);
        PG8_WAIT_V(6); PG8_BAR;
    }
    for (;;) {
        const bool has_next = S.next(ui + 1, nxt);
        const char* nA = has_next ? PG8_UA(nxt) : cA; const char* nB = has_next ? PG8_UB(nxt) : cB;
        for (int t = 0; t < nt; t += 2) {
            const bool last = (t == nt - 2);
            const char* a1 = cA + (size_t)(t + 1) * kstep;
            const char* a2 = last ? nA : cA + (size_t)(t + 2) * kstep; const char* b2 = last ? nB : cB + (size_t)(t + 2) * kstep;
            const char* a3 = a2 + kstep; const char* b3 = b2 + kstep;
            if (last && has_next) S.a_ready(nxt);
            if constexpr (SP2) {
            PG8_LDB(B0, 0, 0); PG8_LDB(B1, 0, 1); PG8_SCHED; PG8_LDA(At, 0, 0); PG8_STAGE(PG8_SA(1, 1), a1 + hstepA, voffA);
            PG8_WAIT_V(8); PG8_WAIT_L(0); PG8_BAR; PG8_MMA(0, 0, At, B0); PG8_MMA(0, 1, At, B1); PG8_BAR; PG8_SCHED;
            PG8_LDA(At, 0, 1); PG8_STAGE(PG8_SB(0, 0), b2, voffB); PG8_STAGE(PG8_SB(0, 1), b2 + hstepB, voffB); PG8_STAGE(PG8_SA(0, 0), a2, voffA);
            PG8_WAIT_V(8); PG8_WAIT_L(0); PG8_BAR; PG8_MMA(1, 0, At, B0); PG8_MMA(1, 1, At, B1); PG8_BAR; PG8_SCHED;
            PG8_LDB(B0, 1, 0); PG8_LDB(B1, 1, 1); PG8_SCHED; PG8_LDA(At, 1, 0); PG8_STAGE(PG8_SA(0, 1), a2 + hstepA, voffA);
            PG8_WAIT_V(8); PG8_WAIT_L(0); PG8_BAR; PG8_MMA(0, 0, At, B0); PG8_MMA(0, 1, At, B1); PG8_BAR; PG8_SCHED;
            PG8_LDA(At, 1, 1); PG8_STAGE(PG8_SB(1, 0), b3, voffB); PG8_STAGE(PG8_SB(1, 1), b3 + hstepB, voffB); PG8_STAGE(PG8_SA(1, 0), a3, voffA);
            PG8_WAIT_V(8); PG8_WAIT_L(0); PG8_BAR; PG8_MMA(1, 0, At, B0); PG8_MMA(1, 1, At, B1); PG8_BAR; PG8_SCHED;
            } else {
            PG8_LDB(B0, 0, 0); PG8_SCHED; PG8_LDA(At, 0, 0); PG8_STAGE(PG8_SA(1, 1), a1 + hstepA, voffA);
            PG8_WAIT_L(8); PG8_BAR; PG8_WAIT_L(0); PG8_MMA(0, 0, At, B0); PG8_BAR; PG8_SCHED;
            PG8_LDB(B1, 0, 1); PG8_STAGE(PG8_SB(0, 0), b2, voffB);
            PG8_BAR; PG8_WAIT_L(0); PG8_MMA(0, 1, At, B1); PG8_BAR;
            PG8_LDA(At, 0, 1); PG8_STAGE(PG8_SA(0, 0), a2, voffA);
            PG8_BAR; PG8_WAIT_L(0); PG8_MMA(1, 0, At, B0); PG8_BAR; PG8_SCHED;
            PG8_STAGE(PG8_SB(0, 1), b2 + hstepB, voffB);
            PG8_WAIT_V(6); PG8_BAR; PG8_MMA(1, 1, At, B1); PG8_BAR;
            PG8_LDB(B0, 1, 0); PG8_SCHED; PG8_LDA(At, 1, 0); PG8_STAGE(PG8_SA(0, 1), a2 + hstepA, voffA);
            PG8_WAIT_L(8); PG8_BAR; PG8_WAIT_L(0); PG8_MMA(0, 0, At, B0); PG8_BAR; PG8_SCHED;
            PG8_LDB(B1, 1, 1); PG8_STAGE(PG8_SB(1, 0), b3, voffB);
            PG8_BAR; PG8_WAIT_L(0); PG8_MMA(0, 1, At, B1); PG8_BAR;
            PG8_LDA(At, 1, 1); PG8_STAGE(PG8_SA(1, 0), a3, voffA);
            PG8_BAR; PG8_WAIT_L(0); PG8_MMA(1, 0, At, B0); PG8_BAR; PG8_SCHED;
            PG8_STAGE(PG8_SB(1, 1), b3 + hstepB, voffB);
            PG8_WAIT_V(6); PG8_BAR; PG8_MMA(1, 1, At, B1); PG8_BAR;
            }
        }
        if constexpr (ALIGN_EPI) { if (wr == 0) PG8_BAR; }
        if constexpr (!Epi::AFTER_DRAIN) { E(acc, cur, wr, wc, fr, fq); S.done(cur); }
        if (!has_next) break;
#pragma unroll
        for (int a = 0; a < 2; ++a)
#pragma unroll
            for (int b = 0; b < 2; ++b)
#pragma unroll
                for (int m = 0; m < 4; ++m)
#pragma unroll
                    for (int n = 0; n < 2; ++n) acc[a][b][m][n] = (f32x4){0.f, 0.f, 0.f, 0.f};
        cur = nxt; cA = nA; cB = nB; ++ui;
        if constexpr (ALIGN_EPI) { if (wr == 1) PG8_BAR; }
    }
    PG8_WAIT_V(0);
    if constexpr (!ALIGN_EPI) { if (wr == 0) PG8_BAR; }
    PG8_BAR;
    if constexpr (Epi::AFTER_DRAIN) { E.fused(acc, cur, wr, wc, fr, fq, lds, wid, lane); S.done(cur); }
#undef PG8_UA
#undef PG8_UB
#undef PG8_SA
#undef PG8_SB
#undef PG8_STAGE
#undef PG8_LDA
#undef PG8_LDB
#undef PG8_MMA
#undef PG8_WAIT_V
#undef PG8_WAIT_L
#undef PG8_BAR
#undef PG8_SCHED
}
}
#define GAS __attribute__((address_space(1)))
#define LAS __attribute__((address_space(3)))
typedef unsigned short bf16;
typedef unsigned v4u __attribute__((ext_vector_type(4)));
typedef float f32x4 __attribute__((ext_vector_type(4)));
typedef short bf16x8 __attribute__((ext_vector_type(8)));
typedef GAS unsigned gu32;
typedef GAS unsigned long long gu64;
#define RLX_AGENT __ATOMIC_RELAXED, __HIP_MEMORY_SCOPE_AGENT
#define LDS_WAIT() asm volatile("s_waitcnt lgkmcnt(0)" ::: "memory")
#define VM_WAIT() asm volatile("s_waitcnt vmcnt(0)" ::: "memory")
__device__ __forceinline__ unsigned long long rt() { return __builtin_amdgcn_s_memrealtime(); }
__device__ __forceinline__ unsigned f2bf(float f) { unsigned u = __builtin_bit_cast(unsigned, f); return (u + 0x7fffu + ((u >> 16) & 1u)) >> 16; }
__device__ __forceinline__ unsigned pk2(float lo, float hi) { return f2bf(lo) | (f2bf(hi) << 16); }

#define XB_TMO      128
#define XB_XCNT(j)  (256  + 64 * (j))
#define XB_XSUB(j)  (1280 + 64 * (j))
#define XB_XGEN(j)  (2304 + 64 * (j))
#define XB_TOP      3328
#define XB_TOPGEN   3392
#define XCD_BAR_WORDS 3456
#define XB_SPIN_CAP (1u << 18)

__device__ __forceinline__ unsigned xb_ld(unsigned* p)              { return __hip_atomic_load(p, __ATOMIC_RELAXED, __HIP_MEMORY_SCOPE_AGENT); }
__device__ __forceinline__ unsigned xb_add(unsigned* p, unsigned v) { return __hip_atomic_fetch_add(p, v, __ATOMIC_RELAXED, __HIP_MEMORY_SCOPE_AGENT); }
__device__ __forceinline__ unsigned xb_xcc_id() { return (unsigned)__builtin_amdgcn_s_getreg((3 << 11) | 20) & 0xFu; }
#define XB_SPIN(cond, bar) do { unsigned _sp = 0; while (cond) { __builtin_amdgcn_s_sleep(1); \
    if ((++_sp & 255u) == 0u) { if (xb_ld(&(bar)[XB_TMO])) break; if (_sp > XB_SPIN_CAP) { atomicAdd(&(bar)[XB_TMO], 1u); break; } } } } while (0)

struct XcdBarrier {
    unsigned* bar; unsigned x;
    volatile LAS unsigned* st;
};

__device__ __forceinline__ XcdBarrier xcd_barrier_post(unsigned* bar, volatile LAS unsigned* st) {
    XcdBarrier b; b.bar = bar; b.x = xb_xcc_id(); b.st = st;
    if (threadIdx.x == 0) (void)xb_add(&bar[XB_XCNT(b.x)], 1u);
    return b;
}
__device__ __forceinline__ void xcd_barrier_complete(unsigned* bar, unsigned x, unsigned& nloc, unsigned& nx) {
    const unsigned G = gridDim.x * gridDim.y * gridDim.z;
    unsigned sum, cnt, mine, sp = 0u;
    for (;;) {
        sum = 0u; cnt = 0u; mine = 0u;
#pragma unroll
        for (unsigned j = 0; j < 16; ++j) { const unsigned c = xb_ld(&bar[XB_XCNT(j)]); sum += c; cnt += (c > 0u) ? 1u : 0u; mine = (j == x) ? c : mine; }
        if (sum == G) break;
        __builtin_amdgcn_s_sleep(1);
        if ((++sp & 255u) == 0u) { if (xb_ld(&bar[XB_TMO])) break; if (sp > XB_SPIN_CAP) { atomicAdd(&bar[XB_TMO], 1u); break; } }
    }
    nloc = mine > 0u ? mine : 1u; nx = cnt > 0u ? cnt : 1u;
}

__device__ __forceinline__ void xcd_barrier(const XcdBarrier& b) {
    asm volatile("s_waitcnt vmcnt(0)" ::: "memory");
    __syncthreads();
    if (threadIdx.x == 0) {
        unsigned* bar = b.bar;
        __builtin_amdgcn_s_waitcnt(0);
        unsigned nloc = b.st[0], nx = b.st[1];
        if (nloc == 0u) { xcd_barrier_complete(bar, b.x, nloc, nx); b.st[0] = nloc; b.st[1] = nx; }
        const unsigned old = xb_add(&bar[XB_XSUB(b.x)], 1u);
        const unsigned gen = old / nloc;
        if (old + 1u == (gen + 1u) * nloc) {
            __builtin_amdgcn_fence(__ATOMIC_RELEASE, "agent");
            asm volatile("s_waitcnt vmcnt(0)" ::: "memory");
            const unsigned og = xb_add(&bar[XB_TOP], 1u);
            const unsigned tg = og / nx;
            if (og + 1u == (tg + 1u) * nx) xb_add(&bar[XB_TOPGEN], 1u);
            else XB_SPIN(xb_ld(&bar[XB_TOPGEN]) == tg, bar);
            __builtin_amdgcn_fence(__ATOMIC_ACQUIRE, "agent");
            xb_add(&bar[XB_XGEN(b.x)], 1u);
            asm volatile("s_waitcnt vmcnt(0)" ::: "memory");
        } else {
            XB_SPIN(xb_ld(&bar[XB_XGEN(b.x)]) == gen, bar);
            __builtin_amdgcn_fence(__ATOMIC_ACQUIRE, "agent");
            asm volatile("s_waitcnt vmcnt(0)" ::: "memory");
        }
    }
    __syncthreads();
}
constexpr int NWAVES = 8;
constexpr int BATCH = 2, SEQ = 8192, D = 1024, M = BATCH * SEQ, DFF = 2816;
constexpr int NH = 8, DK = 128, CH = 64, NCHUNK = M / CH  , CPB = SEQ / CH  , NSEG = 16, CPS = 8  , NUNIT = BATCH * NH * NSEG  ;
constexpr int SCH = 128  , NSC = M / SCH  , SCPB = SEQ / SCH  ;
constexpr float EPS = 1e-6f;
constexpr size_t MiB = 1u << 20;
constexpr size_t WS_CTL = 0, CTL_ZERO_BYTES = 1 * MiB;
constexpr size_t WS_SSP = 1 * MiB;
constexpr size_t WS_DEC = 2 * MiB;
constexpr size_t WS_TAB = 3 * MiB;
constexpr size_t WS_AP = 3 * MiB + 65536, WS_HE = WS_AP + 524288;
constexpr size_t WS_W_HIN = 5 * MiB, WS_W_HOUT = 13 * MiB, WS_W_LIN = 15 * MiB, WS_W_LOUT = 19 * MiB, WS_W_GATE = 21 * MiB;
constexpr size_t WS_W_FIN0 = 22 * MiB, WS_W_FIN1 = 33 * MiB, WS_W_FOUT0 = 44 * MiB, WS_W_FOUT1 = 44 * MiB + 5632 * 1024, WS_XB = 56 * MiB, WS_SLOC = 88 * MiB;
constexpr size_t WS_ACT = 104 * MiB;
constexpr size_t WS_QT = WS_ACT, WS_KT = WS_ACT + 32 * MiB, WS_V = WS_ACT + 64 * MiB, WS_SG = WS_ACT + 96 * MiB;
constexpr size_t WS_H = WS_ACT;
constexpr size_t WS_YG = WS_ACT, WS_U = WS_ACT + 32 * MiB, WS_UC = WS_ACT + 64 * MiB, WS_BI = WS_ACT + 96 * MiB;
constexpr size_t WS_END = WS_ACT + 128 * MiB;
static_assert(WS_W_FOUT1 + 5632 * 1024 <= WS_XB && WS_HE + 524288 <= WS_W_HIN && WS_END <= 256 * MiB, "d_ws map");
constexpr int CW_BAR = 4096;
constexpr int RING_BYTES = 131072, LDSCTL_OFF = RING_BYTES, MISC_OFF = LDSCTL_OFF + 320, LDS_BYTES = 147456;
using pg8::Unit;
typedef unsigned u32x2v __attribute__((ext_vector_type(2)));
__device__ __forceinline__ float bf2f(unsigned short h) { return __builtin_bit_cast(float, (unsigned)h << 16); }
__device__ __forceinline__ float fsigmoid(float x) { return __frcp_rn(1.0f + __expf(-x)); }
__device__ __forceinline__ float fsilu(float x) { return x * fsigmoid(x); }
__device__ __forceinline__ float row_rstd(const float* ssp, int row) {
    const f32x4* p = (const f32x4*)(ssp + (unsigned)row * 16);
    const f32x4 a = p[0], b = p[1], c = p[2], d = p[3];
    const float s = ((a.x + a.y) + (a.z + a.w)) + ((b.x + b.y) + (b.z + b.w)) + ((c.x + c.y) + (c.z + c.w)) + ((d.x + d.y) + (d.z + d.w));
    return rsqrtf(s * (1.0f / D) + EPS);
}
__device__ __forceinline__ v4u pack8(const f32x4 a, const f32x4 b) { v4u w; w.x = pg8::cvt_pk_bf16(a[0], a[1]); w.y = pg8::cvt_pk_bf16(a[2], a[3]); w.z = pg8::cvt_pk_bf16(b[0], b[1]); w.w = pg8::cvt_pk_bf16(b[2], b[3]); return w; }
#define EPI_ROWS(...) _Pragma("unroll") for (int ai = 0; ai < 2; ++ai) _Pragma("unroll") for (int m = 0; m < 4; ++m) { const int row = u.pm * 256 + ai * 128 + wr * 64 + m * 16 + fr; __VA_ARGS__ }

#define EPI_RS(rs) float rs[2][4]; _Pragma("unroll") for (int ai = 0; ai < 2; ++ai) _Pragma("unroll") for (int m = 0; m < 4; ++m) rs[ai][m] = row_rstd(ssp, u.pm * 256 + ai * 128 + wr * 64 + m * 16 + fr);
struct EpiHgrnIn {
    static constexpr bool PERM = true, AFTER_DRAIN = false;
    const float* ssp; const float* lbv; const float* oml; bf16* QT; bf16* KT; bf16* V; bf16* SG; float* LF;
    __device__ __forceinline__ void operator()(const f32x4 (&acc)[2][2][4][2], const Unit& u, int wr, int wc, int fr, int fq) const {
        const int type = u.pn >> 2, cg = 256 * (u.pn & 3) + 32 * wc + 8 * fq;
        EPI_RS(rs)
        if (type == 1) {
            f32x4 lbq[2][2], omq[2][2];
#pragma unroll
            for (int bj = 0; bj < 2; ++bj)
#pragma unroll
                for (int n = 0; n < 2; ++n) { lbq[bj][n] = *(const f32x4*)(lbv + cg + 128 * bj + 4 * n); omq[bj][n] = *(const f32x4*)(oml + cg + 128 * bj + 4 * n); }
            EPI_ROWS(
                _Pragma("unroll") for (int bj = 0; bj < 2; ++bj) { const int col = cg + 128 * bj; f32x4 lf[2], kk[2];
                    _Pragma("unroll") for (int n = 0; n < 2; ++n) {
                        _Pragma("unroll") for (int i = 0; i < 4; ++i) { const float z = acc[ai][bj][m][n][i] * rs[ai][m]; const float e = __expf(-z), sg = __frcp_rn(1.0f + e);
                            const float f = lbq[bj][n][i] + omq[bj][n][i] * sg; lf[n][i] = __logf(f); kk[n][i] = omq[bj][n][i] * (e * sg); } }
                    *(f32x4*)(LF + (unsigned)row * D + col) = lf[0]; *(f32x4*)(LF + (unsigned)row * D + col + 4) = lf[1];
                    *(v4u*)(KT + (unsigned)row * D + col) = pack8(kk[0], kk[1]); })
        } else {
            bf16* O = QT + (size_t)type * (16u << 20); const bool act = type != 2;
            EPI_ROWS(
                _Pragma("unroll") for (int bj = 0; bj < 2; ++bj) { const int col = cg + 128 * bj; f32x4 o[2];
                    _Pragma("unroll") for (int n = 0; n < 2; ++n) _Pragma("unroll") for (int i = 0; i < 4; ++i) { const float z = acc[ai][bj][m][n][i] * rs[ai][m]; o[n][i] = act ? fsilu(z) : z; }
                    *(v4u*)(O + (unsigned)row * D + col) = pack8(o[0], o[1]); })
        }
    }
};
struct EpiRes {
    static constexpr bool PERM = true, AFTER_DRAIN = false;
    const float* base; float* out; bf16* xb; float* ssp;
    __device__ __forceinline__ void operator()(const f32x4 (&acc)[2][2][4][2], const Unit& u, int wr, int wc, int fr, int fq) const {
        const int c0 = 256 * u.pn + 32 * wc + 8 * fq;
#pragma unroll
        for (int ai = 0; ai < 2; ++ai) {
            f32x4 pre[4][2][2];
#pragma unroll
            for (int m = 0; m < 4; ++m)
#pragma unroll
                for (int bj = 0; bj < 2; ++bj) { const unsigned off = (unsigned)(u.pm * 256 + ai * 128 + wr * 64 + m * 16 + fr) * D + c0 + 128 * bj;
                    pre[m][bj][0] = *(const f32x4*)(base + off); pre[m][bj][1] = *(const f32x4*)(base + off + 4); }
#pragma unroll
            for (int m = 0; m < 4; ++m) { const int row = u.pm * 256 + ai * 128 + wr * 64 + m * 16 + fr; float ss = 0.f;
#pragma unroll
                for (int bj = 0; bj < 2; ++bj) { const unsigned off = (unsigned)row * D + c0 + 128 * bj;
                    const f32x4 v0 = pre[m][bj][0] + acc[ai][bj][m][0], v1 = pre[m][bj][1] + acc[ai][bj][m][1];
                    *(f32x4*)(out + off) = v0; *(f32x4*)(out + off + 4) = v1; *(v4u*)(xb + off) = pack8(v0, v1);
                    ss += ((v0[0] * v0[0] + v0[1] * v0[1]) + (v0[2] * v0[2] + v0[3] * v0[3])) + ((v1[0] * v1[0] + v1[1] * v1[1]) + (v1[2] * v1[2] + v1[3] * v1[3])); }
                ss += __shfl_xor(ss, 16); ss += __shfl_xor(ss, 32);
                if (fq == 0) ssp[(unsigned)row * 16 + 4 * u.pn + wc] = ss; }
        }
    }
};
struct EpiFfnIn {
    static constexpr bool PERM = true, AFTER_DRAIN = false;
    const float* ssp; bf16* H;
    __device__ __forceinline__ void operator()(const f32x4 (&acc)[2][2][4][2], const Unit& u, int wr, int wc, int fr, int fq) const {
        const int c0 = 128 * u.pn + 32 * wc + 8 * fq;
        EPI_RS(rs)
        EPI_ROWS(f32x4 o[2];
            _Pragma("unroll") for (int n = 0; n < 2; ++n) _Pragma("unroll") for (int i = 0; i < 4; ++i) { const float g = acc[ai][0][m][n][i] * rs[ai][m], up = acc[ai][1][m][n][i] * rs[ai][m]; o[n][i] = fsilu(g) * up; }
            *(v4u*)(H + (unsigned)row * DFF + c0) = pack8(o[0], o[1]);)
    }
};
struct EpiLruIn {
    static constexpr bool PERM = true, AFTER_DRAIN = false;
    const float* ssp; bf16* YG; bf16* U;
    __device__ __forceinline__ void operator()(const f32x4 (&acc)[2][2][4][2], const Unit& u, int wr, int wc, int fr, int fq) const {
        const int cg = 256 * (u.pn & 3) + 32 * wc + 8 * fq;
        EPI_RS(rs)
        if (u.pn < 4) {
            EPI_ROWS(
                _Pragma("unroll") for (int bj = 0; bj < 2; ++bj) { f32x4 o[2];
                    _Pragma("unroll") for (int n = 0; n < 2; ++n) _Pragma("unroll") for (int i = 0; i < 4; ++i) { const float z = acc[ai][bj][m][n][i] * rs[ai][m];
                        o[n][i] = z * fsigmoid(1.5957691216057308f * (z + 0.044715f * z * z * z)); }
                    *(v4u*)(YG + (unsigned)row * D + cg + 128 * bj) = pack8(o[0], o[1]); })
        } else {
            EPI_ROWS(
                _Pragma("unroll") for (int bj = 0; bj < 2; ++bj)
                    *(v4u*)(U + (unsigned)row * D + cg + 128 * bj) = pack8(acc[ai][bj][m][0] * rs[ai][m], acc[ai][bj][m][1] * rs[ai][m]);)
        }
    }
};
struct EpiGates {
    static constexpr bool PERM = true, AFTER_DRAIN = false;
    const float* ba; const float* bx; const float* sp8  ; const bf16* UC; _Float16* LA; bf16* BI;
    __device__ __forceinline__ void operator()(const f32x4 (&acc)[2][2][4][2], const Unit& u, int wr, int wc, int fr, int fq) const {
        const int c0 = 128 * u.pn + 32 * wc + 8 * fq;
#pragma unroll
        for (int ai = 0; ai < 2; ++ai) {
            v4u uwq[4];
#pragma unroll
            for (int m = 0; m < 4; ++m) uwq[m] = *(const v4u*)(UC + (unsigned)(u.pm * 256 + ai * 128 + wr * 64 + m * 16 + fr) * D + c0);
#pragma unroll
            for (int n = 0; n < 2; ++n) { const f32x4 bav = *(const f32x4*)(ba + c0 + 4 * n), bxv = *(const f32x4*)(bx + c0 + 4 * n), spv = *(const f32x4*)(sp8 + c0 + 4 * n);
#pragma unroll
                for (int m = 0; m < 4; ++m) { const int row = u.pm * 256 + ai * 128 + wr * 64 + m * 16 + fr; f32x4 bi; typedef _Float16 h4 __attribute__((ext_vector_type(4))); h4 hv;
#pragma unroll
                    for (int i = 0; i < 4; ++i) { const unsigned w32 = uwq[m][2 * n + (i >> 1)]; const float ucv = __builtin_bit_cast(float, (i & 1) ? (w32 & 0xffff0000u) : (w32 << 16));
                        const float r = fsigmoid(acc[ai][0][m][n][i] + bav[i]), ig = fsigmoid(acc[ai][1][m][n][i] + bxv[i]);
                        const float lg = spv[i] * r, x = 2.0f * lg;
                        const float em = -x * (1.0f + x * (0.5f + x * (0.16666667f + x * (0.041666668f + x * (0.0083333338f + x * 0.0013888889f)))));
                        hv[i] = (_Float16)lg; bi[i] = sqrtf(fmaxf(em, 0.0f)) * (ig * ucv); }
                    *(h4*)(LA + (unsigned)row * D + c0 + 4 * n) = hv;
                    u32x2v pk; pk.x = pg8::cvt_pk_bf16(bi[0], bi[1]); pk.y = pg8::cvt_pk_bf16(bi[2], bi[3]);
                    *(u32x2v*)(BI + (unsigned)row * D + c0 + 4 * n) = pk; } }
        }
    }
};
struct EpiNull {
    static constexpr bool PERM = true, AFTER_DRAIN = false;
    __device__ __forceinline__ void operator()(const f32x4 (&acc)[2][2][4][2], const Unit& u, int wr, int wc, int fr, int fq) const {
#pragma unroll
        for (int ai = 0; ai < 2; ++ai)
#pragma unroll
            for (int bj = 0; bj < 2; ++bj)
#pragma unroll
                for (int m = 0; m < 4; ++m)
#pragma unroll
                    for (int n = 0; n < 2; ++n) asm volatile("" :: "v"(acc[ai][bj][m][n]));
    }
};
typedef short s16x4 __attribute__((ext_vector_type(4)));
struct Args { const float* in[19]; float* out; unsigned char* ws; int ph_lo, ph_hi; };
static_assert(sizeof(Args) == 19 * 8 + 8 + 8 + 8, "Args has no padding");
__device__ __forceinline__ LAS unsigned char* lds_base() { extern __shared__ __attribute__((aligned(16))) unsigned char lds_dyn[]; return (LAS unsigned char*)lds_dyn; }
#define TID ((int)threadIdx.x)
#define LANE (TID & 63)
#define WAVE (__builtin_amdgcn_readfirstlane(TID >> 6))
#define GSZ ((int)gridDim.x)
#define VCU ((GSZ % 8 == 0) ? ((int)blockIdx.x % 8) * (GSZ / 8) + (int)blockIdx.x / 8 : (int)blockIdx.x)
#define LDSB (lds_base())
#define WSP(T, off) ((T*)(F.ws + (off)))
__device__ __forceinline__ float wave_sum(float v) {
#pragma unroll
    for (int o = 1; o < 64; o <<= 1) v += __shfl_xor(v, o);
    return v;
}
__device__ __forceinline__ void tr_item(const float* W, int ldw, int k0, int ns0, bf16* WT, int ldt, int drow0, const float* ksc, LAS float* scr, int lane) {
#pragma unroll 8
    for (int i = 0; i < 32; ++i) { const int kk = 2 * i + (lane >> 5); float w = W[(size_t)(k0 + kk) * ldw + ns0 + (lane & 31)]; if (ksc) w *= ksc[k0 + kk]; scr[kk * 33 + (lane & 31)] = w; }
    LDS_WAIT(); asm volatile("" ::: "memory");
    const int c = lane & 7;
#pragma unroll
    for (int j = 0; j < 4; ++j) { const int n = (lane >> 3) + 8 * j; const LAS float* s = scr + (8 * c) * 33 + n;
        v4u o; o.x = pk2(s[0 * 33], s[1 * 33]); o.y = pk2(s[2 * 33], s[3 * 33]); o.z = pk2(s[4 * 33], s[5 * 33]); o.w = pk2(s[6 * 33], s[7 * 33]);
        *(GAS v4u*)(WT + (size_t)(drow0 + n) * ldt + k0 + 8 * c) = o; }
    LDS_WAIT(); asm volatile("" ::: "memory");
}
__device__ __forceinline__ void p0_prologue(const Args& F) {
    LAS float* scr = (LAS float*)(LDSB + WAVE * 16384);
    const int gw = VCU * NWAVES + WAVE, NGW = GSZ * NWAVES, lane = LANE;
    constexpr int I_A = 16 * 128, I_B = 16 * 32, I_C = 16 * 64, I_D = 16 * 32, I_E = 256, I_F = 16 * 176, I_G = 44 * 32;
    constexpr int NITEMS = I_A + I_B + I_C + I_D + I_E + 2 * I_F + 2 * I_G;
    for (int it = gw; it < NITEMS; it += NGW) {
        int r = it;
        if (r < I_A) { const int kb = r / 128, nb = r % 128; tr_item(F.in[4], 4096, 64 * kb, 32 * nb, WSP(bf16, WS_W_HIN), 1024, 32 * nb, F.in[1], scr, lane); continue; } r -= I_A;
        if (r < I_B) { const int kb = r / 32, nb = r % 32; tr_item(F.in[7], 1024, 64 * kb, 32 * nb, WSP(bf16, WS_W_HOUT), 1024, 32 * nb, nullptr, scr, lane); continue; } r -= I_B;
        if (r < I_C) { const int kb = r / 64, nb = r % 64; tr_item(F.in[8], 2048, 64 * kb, 32 * nb, WSP(bf16, WS_W_LIN), 1024, 32 * nb, F.in[1] + 1024, scr, lane); continue; } r -= I_C;
        if (r < I_D) { const int kb = r / 32, nb = r % 32; tr_item(F.in[16], 1024, 64 * kb, 32 * nb, WSP(bf16, WS_W_LOUT), 1024, 32 * nb, nullptr, scr, lane); continue; } r -= I_D;
        if (r < I_E) { const int isx = r >> 7, n = (r >> 5) & 3, kb = (r >> 3) & 3, nb = r & 7; const int ch0 = 256 * n + 32 * nb;
            tr_item((isx ? F.in[13] : F.in[11]) + (size_t)n * 65536, 256, 64 * kb, 32 * nb, WSP(bf16, WS_W_GATE), 256, 256 * (ch0 >> 7) + (ch0 & 127) + 128 * isx, nullptr, scr, lane); continue; } r -= I_E;
        if (r < 2 * I_F) { const int l = r / I_F, q = r % I_F, kb = q / 176, nb = q % 176, isup = nb >= 88 ? 1 : 0, j0 = 32 * (nb - 88 * isup);
            tr_item(F.in[17] + (size_t)l * 1024 * 5632, 5632, 64 * kb, 32 * nb, WSP(bf16, l ? WS_W_FIN1 : WS_W_FIN0), 1024, 256 * (j0 >> 7) + (j0 & 127) + 128 * isup, F.in[2] + l * 1024, scr, lane); continue; } r -= 2 * I_F;
        { const int l = r / I_G, q = r % I_G, kb = q / 32, nb = q % 32;
            tr_item(F.in[18] + (size_t)l * 2816 * 1024, 1024, 64 * kb, 32 * nb, WSP(bf16, l ? WS_W_FOUT1 : WS_W_FOUT0), 2816, 32 * nb, nullptr, scr, lane); }
    }
    for (int m = gw; m < M; m += NGW) {
        const GAS f32x4* xr = (const GAS f32x4*)(F.in[0] + (size_t)m * D) + lane; f32x4 v[4]; float s = 0.f;
#pragma unroll
        for (int j = 0; j < 4; ++j) { v[j] = xr[64 * j]; s += (v[j].x * v[j].x + v[j].y * v[j].y) + (v[j].z * v[j].z + v[j].w * v[j].w); }
        s = wave_sum(s);
        GAS unsigned long long* o8 = (GAS unsigned long long*)(WSP(bf16, WS_XB) + (size_t)m * D) + lane;
#pragma unroll
        for (int j = 0; j < 4; ++j) o8[64 * j] = (unsigned long long)pk2(v[j].x, v[j].y) | ((unsigned long long)pk2(v[j].z, v[j].w) << 32);
        if (lane < 16) WSP(float, WS_SSP)[(size_t)m * 16 + lane] = lane == 0 ? s : 0.f;
    }
    { const int g = blockIdx.x * (NWAVES * 64) + TID; if (g < 1024) { const float l0 = F.in[5][g], l1 = F.in[5][1024 + g];
        WSP(float, WS_TAB)[g] = __frcp_rn(1.0f + __expf(l1 - l0)); WSP(float, WS_TAB)[1024 + g] = __frcp_rn(1.0f + __expf(l0 - l1));
        WSP(float, WS_TAB)[2048 + g] = -8.0f * log1pf(__expf(-F.in[15][g])); } }
}
__device__ __forceinline__ void hgrn_prep(const Args& F) {
    bf16* QT = WSP(bf16, WS_QT); bf16* KT = WSP(bf16, WS_KT); const float* LF = F.out; float* DEC = WSP(float, WS_DEC);
    for (int idx = blockIdx.x * (NWAVES * 64) + TID; idx < NCHUNK * 1024; idx += GSZ * NWAVES * 64) {
        const int c = idx >> 10, col = idx & 1023; float b = 0.f; size_t off = (size_t)c * CH * D + col;
#pragma unroll 8
        for (int s = 0; s < CH; ++s, off += D) { b += LF[off]; const float eb = __expf(b), enb = __expf(-b);
            QT[off] = (bf16)f2bf(bf2f(QT[off]) * eb); KT[off] = (bf16)f2bf(bf2f(KT[off]) * enb); }
        DEC[idx] = __expf(b);
    }
}
constexpr int TP = 272  , AP_ = 144  ;
constexpr int L_Q = 0, L_K = 17408, L_V = 34816, L_A = 52224, L_ST = 61440, L_RS = 96256;
__device__ __forceinline__ void stage_tile(LAS unsigned char* img, const bf16* src, int tid) {
#pragma unroll
    for (int i = 0; i < 2; ++i) { const int piece = tid + 512 * i, row = piece >> 4, pc = piece & 15;
        const v4u x = *(const GAS v4u*)(src + (size_t)row * D + pc * 8); *(LAS v4u*)(img + row * TP + pc * 16) = x; }
}
__device__ __forceinline__ bf16x8 frag_row(const LAS unsigned char* img, int pitch, int row0, int k0, int fr, int fq) {
    return *(const LAS bf16x8*)(img + (row0 + fr) * pitch + (k0 + 8 * fq) * 2);
}
__device__ __forceinline__ bf16x8 frag_tr(const LAS unsigned char* img, int pitch, int n0, int k0, int fr, int fq) {
    const int q = fr >> 2, p = fr & 3;
    const s16x4 lo = __builtin_amdgcn_ds_read_tr16_b64_v4i16((LAS s16x4*)(img + (k0 + 8 * fq + q) * pitch + (n0 + 4 * p) * 2));
    const s16x4 hi = __builtin_amdgcn_ds_read_tr16_b64_v4i16((LAS s16x4*)(img + (k0 + 8 * fq + 4 + q) * pitch + (n0 + 4 * p) * 2));
    return __builtin_shufflevector(lo, hi, 0, 1, 2, 3, 4, 5, 6, 7);
}
#define MFMA16(a, b, c) __builtin_amdgcn_mfma_f32_16x16x32_bf16((a), (b), (c), 0, 0, 0)
__device__ __forceinline__ void state_update(f32x4 (&S)[8], const LAS unsigned char* Ki, const LAS unsigned char* Vi, const float* decp, int w, int fr, int fq) {
#pragma unroll
    for (int ks = 0; ks < 2; ++ks) { const bf16x8 X = frag_tr(Ki, TP, 16 * w, 32 * ks, fr, fq);
#pragma unroll
        for (int vb = 0; vb < 8; ++vb) S[vb] = MFMA16(X, frag_tr(Vi, TP, 16 * vb, 32 * ks, fr, fq), S[vb]); }
    const f32x4 dv = *(const f32x4*)(decp + 16 * w + 4 * fq);
#pragma unroll
    for (int vb = 0; vb < 8; ++vb) S[vb] = S[vb] * dv;
}
__device__ __forceinline__ void hgrn_seg_state(const Args& F) {
    LAS unsigned char* Ki = LDSB + L_K; LAS unsigned char* Vi = LDSB + L_V;
    const int w = WAVE, fr = LANE & 15, fq = LANE >> 4;
    for (int unit = VCU; unit < NUNIT; unit += GSZ) {
        const int b = unit / (NH * NSEG), h = (unit / NSEG) % NH, seg = unit % NSEG;
        f32x4 S[8];
#pragma unroll
        for (int vb = 0; vb < 8; ++vb) S[vb] = (f32x4){0.f, 0.f, 0.f, 0.f};
        for (int c = 0; c < CPS; ++c) {
            const int cg = b * CPB + seg * CPS + c; const size_t r0 = (size_t)cg * CH;
            __syncthreads();
            stage_tile(Ki, WSP(bf16, WS_KT) + r0 * D + h * DK, TID); stage_tile(Vi, WSP(bf16, WS_V) + r0 * D + h * DK, TID);
            __syncthreads();
            state_update(S, Ki, Vi, WSP(float, WS_DEC) + (size_t)cg * D + h * DK, w, fr, fq);
        }
        float* sl = WSP(float, WS_SLOC) + (size_t)unit * 16384;
#pragma unroll
        for (int vb = 0; vb < 8; ++vb)
#pragma unroll
            for (int r = 0; r < 4; ++r) sl[(16 * w + 4 * fq + r) * 128 + 16 * vb + fr] = S[vb][r];
    }
}
__device__ __forceinline__ void hgrn_seg_scan(const Args& F) {
    float* SL = WSP(float, WS_SLOC); const float* DEC = WSP(float, WS_DEC);
    for (int idx = blockIdx.x * (NWAVES * 64) + TID; idx < BATCH * NH * 16384; idx += GSZ * NWAVES * 64) {
        const int bh = idx >> 14, kv = idx & 16383, k = kv >> 7, b = bh / NH, h = bh % NH; float S = 0.f;
        for (int seg = 0; seg < NSEG; ++seg) { float* p = SL + ((size_t)(bh * NSEG + seg) << 14) + kv; const float t = *p; *p = S;
            float dsg = 1.f; const float* dp = DEC + (size_t)(b * CPB + seg * CPS) * D + h * DK + k;
#pragma unroll
            for (int c = 0; c < CPS; ++c) dsg *= dp[(size_t)c * D];
            S = dsg * S + t; }
    }
}
__device__ __forceinline__ void hgrn_out(const Args& F) {
    LAS unsigned char* Qi = LDSB + L_Q; LAS unsigned char* Ki = LDSB + L_K; LAS unsigned char* Vi = LDSB + L_V; LAS unsigned char* Ai = LDSB + L_A; LAS unsigned char* STi = LDSB + L_ST;
    LAS float* RS = (LAS float*)(LDSB + L_RS);
    const int w = WAVE, fr = LANE & 15, fq = LANE >> 4, tb = w & 3, wh = w >> 2;
    const float* nw = F.in[6];
    for (int unit = VCU; unit < NUNIT; unit += GSZ) {
        const int b = unit / (NH * NSEG), h = (unit / NSEG) % NH, seg = unit % NSEG;
        f32x4 S[8];
        { const float* sl = WSP(float, WS_SLOC) + (size_t)unit * 16384;
#pragma unroll
          for (int vb = 0; vb < 8; ++vb)
#pragma unroll
            for (int r = 0; r < 4; ++r) S[vb][r] = sl[(16 * w + 4 * fq + r) * 128 + 16 * vb + fr]; }
        __syncthreads();
#pragma unroll
        for (int vb = 0; vb < 8; ++vb) { u32x2v pk; pk.x = pg8::cvt_pk_bf16(S[vb][0], S[vb][1]); pk.y = pg8::cvt_pk_bf16(S[vb][2], S[vb][3]);
            *(LAS u32x2v*)(STi + (16 * vb + fr) * TP + (16 * w + 4 * fq) * 2) = pk; }
        for (int c = 0; c < CPS; ++c) {
            const int cg = b * CPB + seg * CPS + c; const size_t r0 = (size_t)cg * CH;
            bf16* qg = WSP(bf16, WS_QT) + r0 * D + h * DK;
            stage_tile(Qi, qg, TID); stage_tile(Ki, WSP(bf16, WS_KT) + r0 * D + h * DK, TID); stage_tile(Vi, WSP(bf16, WS_V) + r0 * D + h * DK, TID);
            __syncthreads();
            bf16x8 Yq[4];
#pragma unroll
            for (int ks = 0; ks < 4; ++ks) Yq[ks] = frag_row(Qi, TP, 16 * tb, 32 * ks, fr, fq);
#pragma unroll
            for (int sbi = 0; sbi < 2; ++sbi) { const int sb = 2 * wh + sbi; f32x4 a = (f32x4){0.f, 0.f, 0.f, 0.f};
                if (sb <= tb) {
#pragma unroll
                    for (int ks = 0; ks < 4; ++ks) a = MFMA16(frag_row(Ki, TP, 16 * sb, 32 * ks, fr, fq), Yq[ks], a);
                }
                const int t = 16 * tb + fr, s0 = 16 * sb + 4 * fq;
#pragma unroll
                for (int r = 0; r < 4; ++r) a[r] = (s0 + r <= t) ? a[r] : 0.f;
                u32x2v pk; pk.x = pg8::cvt_pk_bf16(a[0], a[1]); pk.y = pg8::cvt_pk_bf16(a[2], a[3]);
                *(LAS u32x2v*)(Ai + t * AP_ + s0 * 2) = pk; }
            __syncthreads();
            bf16x8 Ya[2];
#pragma unroll
            for (int ks = 0; ks < 2; ++ks) Ya[ks] = frag_row(Ai, AP_, 16 * tb, 32 * ks, fr, fq);
            f32x4 o[4]; float ssq = 0.f;
#pragma unroll
            for (int j = 0; j < 4; ++j) { const int vb = 4 * wh + j; f32x4 a = (f32x4){0.f, 0.f, 0.f, 0.f};
#pragma unroll
                for (int ks = 0; ks < 4; ++ks) a = MFMA16(frag_row(STi, TP, 16 * vb, 32 * ks, fr, fq), Yq[ks], a);
#pragma unroll
                for (int ks = 0; ks < 2; ++ks) a = MFMA16(frag_tr(Vi, TP, 16 * vb, 32 * ks, fr, fq), Ya[ks], a);
                o[j] = a; ssq += (a[0] * a[0] + a[1] * a[1]) + (a[2] * a[2] + a[3] * a[3]); }
            ssq += __shfl_xor(ssq, 16); ssq += __shfl_xor(ssq, 32);
            if (fq == 0) RS[(16 * tb + fr) * 2 + wh] = ssq;
            state_update(S, Ki, Vi, WSP(float, WS_DEC) + (size_t)cg * D + h * DK, w, fr, fq);
            __syncthreads();
            { const int t = 16 * tb + fr; const float rstd = rsqrtf((RS[t * 2] + RS[t * 2 + 1]) * (1.0f / DK) + EPS);
              const bf16* sgp = WSP(bf16, WS_SG) + (r0 + t) * D + h * DK;
#pragma unroll
              for (int j = 0; j < 4; ++j) { const int v0 = 16 * (4 * wh + j) + 4 * fq; const u32x2v sgw = *(const GAS u32x2v*)(sgp + v0); const f32x4 nv = *(const f32x4*)(nw + v0);
                  const float g0 = __builtin_bit_cast(float, sgw.x << 16), g1 = __builtin_bit_cast(float, sgw.x & 0xffff0000u), g2 = __builtin_bit_cast(float, sgw.y << 16), g3 = __builtin_bit_cast(float, sgw.y & 0xffff0000u);
                  u32x2v pk; pk.x = pg8::cvt_pk_bf16(o[j][0] * rstd * nv[0] * g0, o[j][1] * rstd * nv[1] * g1); pk.y = pg8::cvt_pk_bf16(o[j][2] * rstd * nv[2] * g2, o[j][3] * rstd * nv[3] * g3);
                  *(GAS u32x2v*)(qg + (size_t)t * D + v0) = pk; } }
#pragma unroll
            for (int vb = 0; vb < 8; ++vb) { u32x2v pk; pk.x = pg8::cvt_pk_bf16(S[vb][0], S[vb][1]); pk.y = pg8::cvt_pk_bf16(S[vb][2], S[vb][3]);
                *(LAS u32x2v*)(STi + (16 * vb + fr) * TP + (16 * w + 4 * fq) * 2) = pk; }
            __syncthreads();
        }
    }
}
__device__ __forceinline__ void lru_conv(const Args& F) {
    const bf16* U = WSP(bf16, WS_U); bf16* UC = WSP(bf16, WS_UC); const float* cw = F.in[9]; const float* cb = F.in[10];
    for (int idx = blockIdx.x * (NWAVES * 64) + TID; idx < M * (D / 8); idx += GSZ * NWAVES * 64) {
        const int row = idx >> 7, c0 = (idx & 127) * 8, t = row & (SEQ - 1); float a[8];
#pragma unroll
        for (int j = 0; j < 8; ++j) a[j] = cb[c0 + j];
#pragma unroll
        for (int tap = 0; tap < 4; ++tap) { const int dt = 3 - tap; if (t - dt >= 0) { const v4u uw = *(const GAS v4u*)(U + (size_t)(row - dt) * D + c0);
#pragma unroll
            for (int j = 0; j < 8; ++j) { const unsigned w32 = uw[j >> 1]; const float uv = __builtin_bit_cast(float, (j & 1) ? (w32 & 0xffff0000u) : (w32 << 16)); a[j] += uv * cw[tap * D + c0 + j]; } } }
        v4u o; o.x = pk2(a[0], a[1]); o.y = pk2(a[2], a[3]); o.z = pk2(a[4], a[5]); o.w = pk2(a[6], a[7]);
        *(GAS v4u*)(UC + (size_t)row * D + c0) = o;
    }
}
__device__ __forceinline__ void lru_scan_local(const Args& F) {
    const _Float16* LA = WSP(_Float16, WS_U); const bf16* BI = WSP(bf16, WS_BI); float* AP = WSP(float, WS_AP); float* HE = WSP(float, WS_HE);
    for (int idx = blockIdx.x * (NWAVES * 64) + TID; idx < NSC * D; idx += GSZ * NWAVES * 64) {
        const int sc = idx >> 10, ch = idx & 1023; size_t off = (size_t)sc * SCH * D + ch; float h = 0.f, sl = 0.f;
#pragma unroll 8
        for (int r = 0; r < SCH; ++r, off += D) { const float la = (float)LA[off]; h = __expf(la) * h + bf2f(BI[off]); sl += la; }
        AP[idx] = __expf(sl); HE[idx] = h;
    }
}
__device__ __forceinline__ void lru_scan_apply(const Args& F) {
    const _Float16* LA = WSP(_Float16, WS_U); const bf16* BI = WSP(bf16, WS_BI); const bf16* YG = WSP(bf16, WS_YG); bf16* HY = WSP(bf16, WS_UC);
    const float* AP = WSP(float, WS_AP); const float* HE = WSP(float, WS_HE);
    for (int idx = blockIdx.x * (NWAVES * 64) + TID; idx < NSC * D; idx += GSZ * NWAVES * 64) {
        const int sc = idx >> 10, ch = idx & 1023, sc0 = (sc / SCPB) * SCPB; float h = 0.f;
        for (int j = sc0; j < sc; ++j) h = AP[j * D + ch] * h + HE[j * D + ch];
        size_t off = (size_t)sc * SCH * D + ch;
#pragma unroll 8
        for (int r = 0; r < SCH; ++r, off += D) { h = __expf((float)LA[off]) * h + bf2f(BI[off]); HY[off] = (bf16)f2bf(h * bf2f(YG[off])); }
    }
}
__device__ __forceinline__ void final_norm(const Args& F) {
    const int gw = VCU * NWAVES + WAVE, NGW = GSZ * NWAVES; const float* nf = F.in[3];
    for (int m = gw; m < M; m += NGW) { const float rs = row_rstd(WSP(float, WS_SSP), m); GAS f32x4* xr = (GAS f32x4*)(F.out + (size_t)m * D) + LANE;
#pragma unroll
        for (int j = 0; j < 4; ++j) { const f32x4 w = *((const f32x4*)nf + LANE + 64 * j); xr[64 * j] = xr[64 * j] * rs * w; } }
}
#ifndef MK_N_LAUNCHES
#define MK_N_LAUNCHES 1
#endif
constexpr int N_PHASES = 18;
#ifndef ONLY_PHASE
#define ONLY_PHASE -1
#endif
#ifndef EXTRA_PHASE
#define EXTRA_PHASE 0
#endif
#ifndef PROBE_MASK
#define PROBE_MASK 0u
#endif
#ifndef PROBE_MASK2
#define PROBE_MASK2 0u
#endif
#define GEMM_RUN(EPI, g, nM_, nN_, E) do { pg8::StaticOrder S_; S_.init(nM_, nN_, GSZ, (int)blockIdx.x); pg8::gemm_phase<EPI, pg8::StaticOrder, true, true>(LDSB, g, S_, E); } while (0)
__global__ void __launch_bounds__(NWAVES * 64, 2) trunk_fwd(Args args) {
    const Args& F = args;
    volatile LAS unsigned* MISC = (volatile LAS unsigned*)(LDSB + MISC_OFF);
    gu32* ctl = (gu32*)(args.ws + WS_CTL);
    for (int u = TID; u < (LDS_BYTES - LDSCTL_OFF) / 4; u += NWAVES * 64) ((LAS unsigned*)(LDSB + LDSCTL_OFF))[u] = 0u;
    __syncthreads();
    XcdBarrier bar; bar.bar = (unsigned*)(ctl + CW_BAR); bar.x = 0; bar.st = nullptr;
    if (MK_N_LAUNCHES == 1) bar = xcd_barrier_post((unsigned*)(ctl + CW_BAR), MISC + 8);
    const int lo = args.ph_lo, hi = args.ph_hi;
#define IN(k) ((ONLY_PHASE < 0 || ONLY_PHASE == (k)) && lo <= (k) && (k) < hi)
    unsigned long long tacc = 0ull, tacc2 = 0ull, tph = 0ull;
#define PB(k) do { if (((PROBE_MASK | PROBE_MASK2) >> (k)) & 1u) tph = rt(); } while (0)
#define SEAM(k) do { if (IN(k) && IN((k) + 1)) xcd_barrier(bar); if ((PROBE_MASK >> (k)) & 1u) tacc += rt() - tph; if ((PROBE_MASK2 >> (k)) & 1u) tacc2 += rt() - tph; } while (0)
    bf16* XB = WSP(bf16, WS_XB); float* SSP = WSP(float, WS_SSP);
    PB(0); if (IN(0)) { p0_prologue(F); } SEAM(0);
    PB(1); if (IN(1)) { pg8::Gemm g{XB, WSP(bf16, WS_W_HIN), D, D, D, 0};
        EpiHgrnIn E{SSP, WSP(float, WS_TAB), WSP(float, WS_TAB) + 1024, WSP(bf16, WS_QT), WSP(bf16, WS_KT), WSP(bf16, WS_V), WSP(bf16, WS_SG), F.out};
        GEMM_RUN(EpiHgrnIn, g, M / 256, 16, E); } SEAM(1);
    PB(2); if (IN(2)) { hgrn_prep(F); } SEAM(2);
    PB(3); if (IN(3)) { hgrn_seg_state(F); } SEAM(3);
    PB(4); if (IN(4)) { hgrn_seg_scan(F); } SEAM(4);
    PB(5); if (IN(5)) { hgrn_out(F); } SEAM(5);
    PB(6); if (IN(6)) { pg8::Gemm g{WSP(bf16, WS_QT), WSP(bf16, WS_W_HOUT), D, D, D, 0}; EpiRes E{F.in[0], F.out, XB, SSP}; GEMM_RUN(EpiRes, g, M / 256, 4, E); } SEAM(6);
    PB(7); if (IN(7)) { pg8::Gemm g{XB, WSP(bf16, WS_W_FIN0), D, D, D, 0}; EpiFfnIn E{SSP, WSP(bf16, WS_H)}; GEMM_RUN(EpiFfnIn, g, M / 256, 22, E); } SEAM(7);
    PB(8); if (IN(8)) { pg8::Gemm g{WSP(bf16, WS_H), WSP(bf16, WS_W_FOUT0), DFF, DFF, DFF, 0}; EpiRes E{F.out, F.out, XB, SSP}; GEMM_RUN(EpiRes, g, M / 256, 4, E); } SEAM(8);
    PB(9); if (IN(9)) { pg8::Gemm g{XB, WSP(bf16, WS_W_LIN), D, D, D, 0}; EpiLruIn E{SSP, WSP(bf16, WS_YG), WSP(bf16, WS_U)}; GEMM_RUN(EpiLruIn, g, M / 256, 8, E); } SEAM(9);
    PB(10); if (IN(10)) { lru_conv(F); } SEAM(10);
    PB(11); if (IN(11)) { int kg = 256; asm volatile("" : "+s"(kg));
        pg8::Gemm g{WSP(bf16, WS_UC), WSP(bf16, WS_W_GATE), D, 256, kg, 1};
        EpiGates E{F.in[12], F.in[14], WSP(float, WS_TAB) + 2048, WSP(bf16, WS_UC), WSP(_Float16, WS_U), WSP(bf16, WS_BI)}; GEMM_RUN(EpiGates, g, M / 256, 8, E); } SEAM(11);
    PB(12); if (IN(12)) { lru_scan_local(F); } SEAM(12);
    PB(13); if (IN(13)) { lru_scan_apply(F); } SEAM(13);
    PB(14); if (IN(14)) { pg8::Gemm g{WSP(bf16, WS_UC), WSP(bf16, WS_W_LOUT), D, D, D, 0}; EpiRes E{F.out, F.out, XB, SSP}; GEMM_RUN(EpiRes, g, M / 256, 4, E); } SEAM(14);
    PB(15); if (IN(15)) { pg8::Gemm g{XB, WSP(bf16, WS_W_FIN1), D, D, D, 0}; EpiFfnIn E{SSP, WSP(bf16, WS_H)}; GEMM_RUN(EpiFfnIn, g, M / 256, 22, E); } SEAM(15);
    PB(16); if (IN(16)) { pg8::Gemm g{WSP(bf16, WS_H), WSP(bf16, WS_W_FOUT1), DFF, DFF, DFF, 0}; EpiRes E{F.out, F.out, XB, SSP}; GEMM_RUN(EpiRes, g, M / 256, 4, E); } SEAM(16);
    PB(17); if (IN(17)) { final_norm(F); }
    if ((PROBE_MASK >> 17) & 1u) tacc += rt() - tph;
    if ((PROBE_MASK2 >> 17) & 1u) tacc2 += rt() - tph;
    if (EXTRA_PHASE != 0) { xcd_barrier(bar); tph = rt();
        if (EXTRA_PHASE == 1) { pg8::Gemm g{XB, WSP(bf16, WS_W_FIN1), D, D, D, 0}; EpiNull E{}; GEMM_RUN(EpiNull, g, M / 256, 22, E); }
        if (EXTRA_PHASE == 2) { pg8::Gemm g{XB, WSP(bf16, WS_W_FIN1), D, D, D, 0}; EpiFfnIn E{SSP, WSP(bf16, WS_H)}; GEMM_RUN(EpiFfnIn, g, M / 256, 22, E); }
        if (EXTRA_PHASE == 3) { pg8::Gemm g{XB, WSP(bf16, WS_W_FIN1), D, D, D, 0}; EpiNull E{}; GEMM_RUN(EpiNull, g, M / 256, 20, E); }
        xcd_barrier(bar); tacc += rt() - tph; }
    if ((PROBE_MASK | PROBE_MASK2 | (unsigned)EXTRA_PHASE) != 0u && blockIdx.x == 0 && TID == 0) { const unsigned long long te = rt() + 4ull * tacc + 100000ull * ((tacc2 + 50ull) / 100ull); while (rt() < te) __builtin_amdgcn_s_sleep(32); }
#undef IN
#undef SEAM
}

extern "C" void kernel_launch(void* const* d_in, const int* in_sizes, int n_in, void* d_out, int out_size, void* d_ws, size_t ws_size, hipStream_t stream) {
    static int grid = 0;
    if (grid == 0) {
        if (n_in != 19 || in_sizes[0] != M * D || out_size != M * D || ws_size < WS_END) { fprintf(stderr, "kernel_launch: unexpected shapes: n_in %d in0 %d out %d ws %zu (need %zu); nothing launched\n", n_in, n_in > 0 ? in_sizes[0] : -1, out_size, ws_size, (size_t)WS_END); grid = -1; return; }
        int dev = 0, cus = 0, per_cu = 0;
        if (hipGetDevice(&dev) != hipSuccess || hipDeviceGetAttribute(&cus, hipDeviceAttributeMultiprocessorCount, dev) != hipSuccess) { fprintf(stderr, "kernel_launch: device query failed\n"); grid = -1; return; }
        if (hipFuncSetAttribute((const void*)trunk_fwd, hipFuncAttributeMaxDynamicSharedMemorySize, LDS_BYTES) != hipSuccess) { fprintf(stderr, "kernel_launch: hipFuncSetAttribute failed\n"); grid = -1; return; }
        if (hipOccupancyMaxActiveBlocksPerMultiprocessor(&per_cu, (const void*)trunk_fwd, NWAVES * 64, LDS_BYTES) != hipSuccess || per_cu < 1) { fprintf(stderr, "kernel_launch: occupancy query says %d blocks per CU\n", per_cu); }
        (void)hipGetLastError();
        grid = cus;
        fprintf(stderr, "kernel_launch: grid %d, per_cu %d, ws %zu\n", grid, per_cu, ws_size);
    }
    if (grid < 0) return;
    if (hipMemsetAsync((char*)d_ws + WS_CTL, 0, CTL_ZERO_BYTES, stream) != hipSuccess) { fprintf(stderr, "kernel_launch: memset failed\n"); return; }
    Args a{};
    for (int i = 0; i < 19; ++i) a.in[i] = (const float*)d_in[i];
    a.out = (float*)d_out; a.ws = (unsigned char*)d_ws;
    for (int li = 0; li < MK_N_LAUNCHES; ++li) {
        a.ph_lo = (MK_N_LAUNCHES == 1) ? 0 : li; a.ph_hi = (MK_N_LAUNCHES == 1) ? N_PHASES : li + 1;
        hipLaunchKernelGGL(trunk_fwd, dim3(grid), dim3(NWAVES * 64), LDS_BYTES, stream, a);
        const hipError_t le = hipPeekAtLastError();
        if (le != hipSuccess) { fprintf(stderr, "kernel_launch: launch %d failed: %s\n", li, hipGetErrorName(le)); break; }
    }
}
```

```cpp
#include <hip/hip_runtime.h>
#include <cstdio>
#include <cstdint>
namespace pg8 {
#define PG8_LAS __attribute__((address_space(3)))
typedef unsigned short bf16_t;
typedef short bf16x8 __attribute__((ext_vector_type(8)));
typedef float f32x4 __attribute__((ext_vector_type(4)));
typedef unsigned u32x4 __attribute__((ext_vector_type(4)));
constexpr int BM = 256, BK = 64, HALF = 128, HTB = HALF * BK * 2  , STAGE_BYTES = 8 * HTB, NXCD = 8, WGM = 8;

__host__ __device__ __forceinline__ int lds_byte(int r, int c) { const int st = (r >> 4) * 2 + (c >> 5), rr = r & 15, cc = c & 31, ob = rr * 64 + cc * 2; return st * 1024 + (ob ^ (((ob >> 9) & 1) << 5)); }
__host__ __device__ __forceinline__ void stage_rc(int b, int& R, int& C) { const int st = b / 1024, sb = b % 1024, swz = sb ^ (((sb >> 9) & 1) << 5); R = (st >> 1) * 16 + swz / 64; C = (st & 1) * 32 + (swz % 64) / 2; }
__host__ __device__ __forceinline__ int perm32(int rho) { const int n = rho >> 4, i = rho & 15; return 8 * (i >> 2) + 4 * n + (i & 3); }

struct Unit { int pm, pn; };
struct Gemm { const bf16_t* A; const bf16_t* Bt; int lda, ldb, K, ablk; };

struct StaticOrder {
    int nM, nN, nwg, G, c;
    __host__ __device__ void init(int nM_, int nN_, int G_, int c_) { nM = nM_; nN = nN_; nwg = nM * nN; G = G_; c = c_; }
    __host__ __device__ bool next(int i, Unit& u) const {
        const long L = (long)i * G + c; if (L >= nwg) return false;
        int wgid = (int)L; { const int q = nwg / NXCD, r = nwg % NXCD, xcd = wgid % NXCD, off = wgid / NXCD; wgid = (xcd < r ? xcd * (q + 1) : r * (q + 1) + (xcd - r) * q) + off; }
        const int nig = WGM * nN, gid = wgid / nig, fm = gid * WGM, gsz = (nM - fm) < WGM ? (nM - fm) : WGM;
        u.pm = fm + ((wgid % nig) % gsz); u.pn = (wgid % nig) / gsz; return true;
    }
    __device__ __forceinline__ void a_ready(const Unit&) const {}
    __device__ __forceinline__ void done(const Unit&) const {}
};
__device__ __forceinline__ unsigned cvt_pk_bf16(float lo, float hi) { unsigned r; asm volatile("v_cvt_pk_bf16_f32 %0, %1, %2" : "=v"(r) : "v"(lo), "v"(hi)); return r; }
template <class Epi, class Sched, bool ALIGN_EPI = false, bool SP2 = false>
__device__ __forceinline__ void gemm_phase(PG8_LAS unsigned char* lds, const Gemm g, const Sched& S, const Epi& E) {
    const int tid = threadIdx.x, wid = __builtin_amdgcn_readfirstlane(tid >> 6), lane = tid & 63, wr = wid >> 2, wc = wid & 3, fr = lane & 15, fq = lane >> 4;
    const int K = g.K, nt = K / BK;
    unsigned voffA[2], voffB[2];
#pragma unroll
    for (int i = 0; i < 2; ++i) { int R, C; stage_rc(tid * 16 + i * 8192, R, C); const int Rb = Epi::PERM ? ((R & ~31) + perm32(R & 31)) : R;
        voffA[i] = (unsigned)(R * g.lda + C) * 2u; voffB[i] = (unsigned)(Rb * g.ldb + C) * 2u; }
    const size_t kstep = (size_t)(BK * 2);
    const size_t hstepA = (size_t)HALF * g.lda * 2, hstepB = (size_t)HALF * g.ldb * 2;
    const unsigned ldsw = (unsigned)wid * 1024u;
    const int aoff = lds_byte(wr * 64 + fr, fq * 8), boff = lds_byte(wc * 32 + fr, fq * 8);
#define PG8_UA(u) ((const char*)g.A + (size_t)(u).pm * 2 * hstepA + (g.ablk ? (size_t)((u).pn >> 1) * 512 : (size_t)0))
#define PG8_UB(u) ((const char*)g.Bt + (size_t)(u).pn * 2 * hstepB)
#define PG8_SA(b, h) (((b) * 2 + (h)) * HTB)
#define PG8_SB(b, h) ((4 + (b) * 2 + (h)) * HTB)
#define PG8_STAGE(bufoff, gbase, voff) do { _Pragma("unroll") for (int _i = 0; _i < 2; ++_i) \
        __builtin_amdgcn_global_load_lds((const unsigned*)((const char*)(gbase) + (voff)[_i]), (PG8_LAS unsigned*)(lds + (bufoff) + ldsw + _i * 8192), 16, 0, 0); } while (0)
#define PG8_LDA(dst, b, h) do { _Pragma("unroll") for (int m = 0; m < 4; ++m) _Pragma("unroll") for (int k = 0; k < 2; ++k) dst[m][k] = *(const PG8_LAS bf16x8*)(lds + PG8_SA(b, h) + aoff + m * 2048 + k * 1024); } while (0)
#define PG8_LDB(dst, b, h) do { _Pragma("unroll") for (int n = 0; n < 2; ++n) _Pragma("unroll") for (int k = 0; k < 2; ++k) dst[n][k] = *(const PG8_LAS bf16x8*)(lds + PG8_SB(b, h) + boff + n * 2048 + k * 1024); } while (0)
#define PG8_MMA(ai, bj, At, Bt) do { __builtin_amdgcn_s_setprio(1); _Pragma("unroll") for (int m = 0; m < 4; ++m) _Pragma("unroll") for (int n = 0; n < 2; ++n) _Pragma("unroll") for (int k = 0; k < 2; ++k) \
        acc[ai][bj][m][n] = __builtin_amdgcn_mfma_f32_16x16x32_bf16(Bt[n][k], At[m][k], acc[ai][bj][m][n], 0, 0, 0); __builtin_amdgcn_s_setprio(0); } while (0)
#define PG8_WAIT_V(n) asm volatile("s_waitcnt vmcnt(" #n ")" ::: "memory")
#define PG8_WAIT_L(n) asm volatile("s_waitcnt lgkmcnt(" #n ")" ::: "memory")
#define PG8_BAR __builtin_amdgcn_s_barrier()
#define PG8_SCHED __builtin_amdgcn_sched_barrier(0)
    Unit cur, nxt; int ui = 0;
    if (!S.next(0, cur)) return;
    f32x4 acc[2][2][4][2];
#pragma unroll
    for (int a = 0; a < 2; ++a)
#pragma unroll
        for (int b = 0; b < 2; ++b)
#pragma unroll
            for (int m = 0; m < 4; ++m)
#pragma unroll
                for (int n = 0; n < 2; ++n) acc[a][b][m][n] = (f32x4){0.f, 0.f, 0.f, 0.f};
    bf16x8 At[4][2], B0[2][2], B1[2][2];
    const char* cA = PG8_UA(cur); const char* cB = PG8_UB(cur);
    S.a_ready(cur);
    if constexpr (SP2) {
        PG8_STAGE(PG8_SB(0, 0), cB, voffB); PG8_STAGE(PG8_SB(0, 1), cB + hstepB, voffB); PG8_STAGE(PG8_SA(0, 0), cA, voffA); PG8_STAGE(PG8_SA(0, 1), cA + hstepA, voffA);
        if (wr == 1) PG8_BAR;
        PG8_WAIT_V(2); PG8_BAR;
        PG8_STAGE(PG8_SB(1, 0), cB + kstep, voffB); PG8_STAGE(PG8_SA(1, 0), cA + kstep, voffA); PG8_STAGE(PG8_SB(1, 1), cB + hstepB + kstep, voffB);
        PG8_WAIT_V(6); PG8_BAR;
    } else {
        PG8_STAGE(PG8_SB(0, 0), cB, voffB); PG8_STAGE(PG8_SA(0, 0), cA, voffA); PG8_STAGE(PG8_SB(0, 1), cB + hstepB, voffB); PG8_STAGE(PG8_SA(0, 1), cA + hstepA, voffA);
        if (wr == 1) PG8_BAR;
        PG8_WAIT_V(4); PG8_BAR;
        PG8_STAGE(PG8_SB(1, 0), cB + kstep, voffB); PG8_STAGE(PG8_SA(1, 0), cA + kstep, voffA); PG8_STAGE(PG8_SB(1, 1), cB + hstepB + kstep, voffB);
        PG8_WAIT_V(6); PG8_BAR;
    }
    for (;;) {
        const bool has_next = S.next(ui + 1, nxt);
        const char* nA = has_next ? PG8_UA(nxt) : cA; const char* nB = has_next ? PG8_UB(nxt) : cB;
        for (int t = 0; t < nt; t += 2) {
            const bool last = (t == nt - 2);
            const char* a1 = cA + (size_t)(t + 1) * kstep;
            const char* a2 = last ? nA : cA + (size_t)(t + 2) * kstep; const char* b2 = last ? nB : cB + (size_t)(t + 2) * kstep;
            const char* a3 = a2 + kstep; const char* b3 = b2 + kstep;
            if (last && has_next) S.a_ready(nxt);
            if constexpr (SP2) {
            PG8_LDB(B0, 0, 0); PG8_LDB(B1, 0, 1); PG8_SCHED; PG8_LDA(At, 0, 0); PG8_STAGE(PG8_SA(1, 1), a1 + hstepA, voffA);
            PG8_WAIT_V(8); PG8_WAIT_L(0); PG8_BAR; PG8_MMA(0, 0, At, B0); PG8_MMA(0, 1, At, B1); PG8_BAR; PG8_SCHED;
            PG8_LDA(At, 0, 1); PG8_STAGE(PG8_SB(0, 0), b2, voffB); PG8_STAGE(PG8_SB(0, 1), b2 + hstepB, voffB); PG8_STAGE(PG8_SA(0, 0), a2, voffA);
            PG8_WAIT_V(8); PG8_WAIT_L(0); PG8_BAR; PG8_MMA(1, 0, At, B0); PG8_MMA(1, 1, At, B1); PG8_BAR; PG8_SCHED;
            PG8_LDB(B0, 1, 0); PG8_LDB(B1, 1, 1); PG8_SCHED; PG8_LDA(At, 1, 0); PG8_STAGE(PG8_SA(0, 1), a2 + hstepA, voffA);
            PG8_WAIT_V(8); PG8_WAIT_L(0); PG8_BAR; PG8_MMA(0, 0, At, B0); PG8_MMA(0, 1, At, B1); PG8_BAR; PG8_SCHED;
            PG8_LDA(At, 1, 1); PG8_STAGE(PG8_SB(1, 0), b3, voffB); PG8_STAGE(PG8_SB(1, 1), b3 + hstepB, voffB); PG8_STAGE(PG8_SA(1, 0), a3, voffA);
            PG8_WAIT_V(8); PG8_WAIT_L(0); PG8_BAR; PG8_MMA(1, 0, At, B0); PG8_MMA(1, 1, At, B1); PG8_BAR; PG8_SCHED;
            } else {
            PG8_LDB(B0, 0, 0); PG8_SCHED; PG8_LDA(At, 0, 0); PG8_STAGE(PG8_SA(1, 1), a1 + hstepA, voffA);
            PG8_WAIT_L(8); PG8_BAR; PG8_WAIT_L(0); PG8_MMA(0, 0, At, B0); PG8_BAR; PG8_SCHED;
            PG8_LDB(B1, 0, 1); PG8_STAGE(PG8_SB(0, 0), b2, voffB);
            PG8_BAR; PG8_WAIT_L(0); PG8_MMA(0, 1, At, B1); PG8_BAR;
            PG8_LDA(At, 0, 1); PG8_STAGE(PG8_SA(0, 0), a2, voffA);
            PG8_BAR; PG8_WAIT_L(0); PG8_MMA(1, 0, At, B0); PG8_BAR; PG8_SCHED;
            PG8_STAGE(PG8_SB(0, 1), b2 + hstepB, voffB);
            PG8_WAIT_V(6); PG8_BAR; PG8_MMA(1, 1, At, B1); PG8_BAR;
            PG8_LDB(B0, 1, 0); PG8_SCHED; PG8_LDA(At, 1, 0); PG8_STAGE(PG8_SA(0, 1), a2 + hstepA, voffA);
            PG8_WAIT_L(8); PG8_BAR; PG8_WAIT_L(0); PG8_MMA(0, 0, At, B0); PG8_BAR; PG8_SCHED;
            PG8_LDB(B1, 1, 1); PG8_STAGE(PG8_SB(1, 0), b3, voffB);
            PG8_BAR; PG8_WAIT_L(0); PG8_MMA(0, 1, At, B1); PG8_BAR;
            PG8_LDA(At, 1, 1); PG8_STAGE(PG8_SA(1, 0), a3, voffA);
            PG8_BAR; PG8_WAIT_L(0); PG8_MMA(1, 0, At, B0); PG8_BAR; PG8_SCHED;
            PG8_STAGE(PG8_SB(1, 1), b3 + hstepB, voffB);
            PG8_WAIT_V(6); PG8_BAR; PG8_MMA(1, 1, At, B1); PG8_BAR;
            }
        }
        if constexpr (ALIGN_EPI) { if (wr == 0) PG8_BAR; }
        if constexpr (!Epi::AFTER_DRAIN) { E(acc, cur, wr, wc, fr, fq); S.done(cur); }
        if (!has_next) break;
#pragma unroll
        for (int a = 0; a < 2; ++a)
#pragma unroll
            for (int b = 0; b < 2; ++b)
#pragma unroll
                for (int m = 0; m < 4; ++m)
#pragma unroll
                    for (int n = 0; n < 2; ++n) acc[a][b][m][n] = (f32x4){0.f, 0.f, 0.f, 0.f};
        cur = nxt; cA = nA; cB = nB; ++ui;
        if constexpr (ALIGN_EPI) { if (wr == 1) PG8_BAR; }
    }
    PG8_WAIT_V(0);
    if constexpr (!ALIGN_EPI) { if (wr == 0) PG8_BAR; }
    PG8_BAR;
    if constexpr (Epi::AFTER_DRAIN) { E.fused(acc, cur, wr, wc, fr, fq, lds, wid, lane); S.done(cur); }
#undef PG8_UA
#undef PG8_UB
#undef PG8_SA
#undef PG8_SB
#undef PG8_STAGE
#undef PG8_LDA
#undef PG8_LDB
#undef PG8_MMA
#undef PG8_WAIT_V
#undef PG8_WAIT_L
#undef PG8_BAR
#undef PG8_SCHED
}
}
#define GAS __attribute__((address_space(1)))
#define LAS __attribute__((address_space(3)))
typedef unsigned short bf16;
typedef unsigned v4u __attribute__((ext_vector_type(4)));
typedef float f32x4 __attribute__((ext_vector_type(4)));
typedef short bf16x8 __attribute__((ext_vector_type(8)));
typedef GAS unsigned gu32;
typedef GAS unsigned long long gu64;
#define RLX_AGENT __ATOMIC_RELAXED, __HIP_MEMORY_SCOPE_AGENT
#define LDS_WAIT() asm volatile("s_waitcnt lgkmcnt(0)" ::: "memory")
#define VM_WAIT() asm volatile("s_waitcnt vmcnt(0)" ::: "memory")
__device__ __forceinline__ unsigned long long rt() { return __builtin_amdgcn_s_memrealtime(); }
__device__ __forceinline__ unsigned f2bf(float f) { unsigned u = __builtin_bit_cast(unsigned, f); return (u + 0x7fffu + ((u >> 16) & 1u)) >> 16; }
__device__ __forceinline__ unsigned pk2(float lo, float hi) { return f2bf(lo) | (f2bf(hi) << 16); }

#define XB_TMO      128
#define XB_XCNT(j)  (256  + 64 * (j))
#define XB_XSUB(j)  (1280 + 64 * (j))
#define XB_XGEN(j)  (2304 + 64 * (j))
#define XB_TOP      3328
#define XB_TOPGEN   3392
#define XCD_BAR_WORDS 3456
#define XB_SPIN_CAP (1u << 18)

__device__ __forceinline__ unsigned xb_ld(unsigned* p)              { return __hip_atomic_load(p, __ATOMIC_RELAXED, __HIP_MEMORY_SCOPE_AGENT); }
__device__ __forceinline__ unsigned xb_add(unsigned* p, unsigned v) { return __hip_atomic_fetch_add(p, v, __ATOMIC_RELAXED, __HIP_MEMORY_SCOPE_AGENT); }
__device__ __forceinline__ unsigned xb_xcc_id() { return (unsigned)__builtin_amdgcn_s_getreg((3 << 11) | 20) & 0xFu; }
#define XB_SPIN(cond, bar) do { unsigned _sp = 0; while (cond) { __builtin_amdgcn_s_sleep(1); \
    if ((++_sp & 255u) == 0u) { if (xb_ld(&(bar)[XB_TMO])) break; if (_sp > XB_SPIN_CAP) { atomicAdd(&(bar)[XB_TMO], 1u); break; } } } } while (0)

struct XcdBarrier {
    unsigned* bar; unsigned x;
    volatile LAS unsigned* st;
};

__device__ __forceinline__ XcdBarrier xcd_barrier_post(unsigned* bar, volatile LAS unsigned* st) {
    XcdBarrier b; b.bar = bar; b.x = xb_xcc_id(); b.st = st;
    if (threadIdx.x == 0) (void)xb_add(&bar[XB_XCNT(b.x)], 1u);
    return b;
}
__device__ __forceinline__ void xcd_barrier_complete(unsigned* bar, unsigned x, unsigned& nloc, unsigned& nx) {
    const unsigned G = gridDim.x * gridDim.y * gridDim.z;
    unsigned sum, cnt, mine, sp = 0u;
    for (;;) {
        sum = 0u; cnt = 0u; mine = 0u;
#pragma unroll
        for (unsigned j = 0; j < 16; ++j) { const unsigned c = xb_ld(&bar[XB_XCNT(j)]); sum += c; cnt += (c > 0u) ? 1u : 0u; mine = (j == x) ? c : mine; }
        if (sum == G) break;
        __builtin_amdgcn_s_sleep(1);
        if ((++sp & 255u) == 0u) { if (xb_ld(&bar[XB_TMO])) break; if (sp > XB_SPIN_CAP) { atomicAdd(&bar[XB_TMO], 1u); break; } }
    }
    nloc = mine > 0u ? mine : 1u; nx = cnt > 0u ? cnt : 1u;
}

__device__ __forceinline__ void xcd_barrier(const XcdBarrier& b) {
    asm volatile("s_waitcnt vmcnt(0)" ::: "memory");
    __syncthreads();
    if (threadIdx.x == 0) {
        unsigned* bar = b.bar;
        __builtin_amdgcn_s_waitcnt(0);
        unsigned nloc = b.st[0], nx = b.st[1];
        if (nloc == 0u) { xcd_barrier_complete(bar, b.x, nloc, nx); b.st[0] = nloc; b.st[1] = nx; }
        const unsigned old = xb_add(&bar[XB_XSUB(b.x)], 1u);
        const unsigned gen = old / nloc;
        if (old + 1u == (gen + 1u) * nloc) {
            __builtin_amdgcn_fence(__ATOMIC_RELEASE, "agent");
            asm volatile("s_waitcnt vmcnt(0)" ::: "memory");
            const unsigned og = xb_add(&bar[XB_TOP], 1u);
            const unsigned tg = og / nx;
            if (og + 1u == (tg + 1u) * nx) xb_add(&bar[XB_TOPGEN], 1u);
            else XB_SPIN(xb_ld(&bar[XB_TOPGEN]) == tg, bar);
            __builtin_amdgcn_fence(__ATOMIC_ACQUIRE, "agent");
            xb_add(&bar[XB_XGEN(b.x)], 1u);
            asm volatile("s_waitcnt vmcnt(0)" ::: "memory");
        } else {
            XB_SPIN(xb_ld(&bar[XB_XGEN(b.x)]) == gen, bar);
            __builtin_amdgcn_fence(__ATOMIC_ACQUIRE, "agent");
            asm volatile("s_waitcnt vmcnt(0)" ::: "memory");
        }
    }
    __syncthreads();
}
constexpr int NWAVES = 8;
constexpr int BATCH = 2, SEQ = 8192, D = 1024, M = BATCH * SEQ, DFF = 2816;
constexpr int NH = 8, DK = 128, CH = 64, NCHUNK = M / CH  , CPB = SEQ / CH  , NSEG = 16, CPS = 8  , NUNIT = BATCH * NH * NSEG  ;
constexpr int SCH = 128  , NSC = M / SCH  , SCPB = SEQ / SCH  ;
constexpr float EPS = 1e-6f;
constexpr size_t MiB = 1u << 20;
constexpr size_t WS_CTL = 0, CTL_ZERO_BYTES = 1 * MiB;
constexpr size_t WS_SSP = 1 * MiB;
constexpr size_t WS_DEC = 2 * MiB;
constexpr size_t WS_TAB = 3 * MiB;
constexpr size_t WS_AP = 3 * MiB + 65536, WS_HE = WS_AP + 524288;
constexpr size_t WS_W_HIN = 5 * MiB, WS_W_HOUT = 13 * MiB, WS_W_LIN = 15 * MiB, WS_W_LOUT = 19 * MiB, WS_W_GATE = 21 * MiB;
constexpr size_t WS_W_FIN0 = 22 * MiB, WS_W_FIN1 = 33 * MiB, WS_W_FOUT0 = 44 * MiB, WS_W_FOUT1 = 44 * MiB + 5632 * 1024, WS_XB = 56 * MiB, WS_SLOC = 88 * MiB;
constexpr size_t WS_ACT = 104 * MiB;
constexpr size_t WS_QT = WS_ACT, WS_KT = WS_ACT + 32 * MiB, WS_V = WS_ACT + 64 * MiB, WS_SG = WS_ACT + 96 * MiB;
constexpr size_t WS_H = WS_ACT;
constexpr size_t WS_YG = WS_ACT, WS_U = WS_ACT + 32 * MiB, WS_UC = WS_ACT + 64 * MiB, WS_BI = WS_ACT + 96 * MiB;
constexpr size_t WS_END = WS_ACT + 128 * MiB;
static_assert(WS_W_FOUT1 + 5632 * 1024 <= WS_XB && WS_HE + 524288 <= WS_W_HIN && WS_END <= 256 * MiB, "d_ws map");
constexpr int CW_BAR = 4096;
constexpr int RING_BYTES = 131072, LDSCTL_OFF = RING_BYTES, MISC_OFF = LDSCTL_OFF + 320, LDS_BYTES = 147456;
using pg8::Unit;
typedef unsigned u32x2v __attribute__((ext_vector_type(2)));
__device__ __forceinline__ float bf2f(unsigned short h) { return __builtin_bit_cast(float, (unsigned)h << 16); }
__device__ __forceinline__ float fsigmoid(float x) { return __builtin_amdgcn_rcpf(1.0f + __expf(-x)); }
__device__ __forceinline__ float fsilu(float x) { return x * fsigmoid(x); }
__device__ __forceinline__ float row_rstd(const float* ssp, int row) {
    const f32x4* p = (const f32x4*)(ssp + (unsigned)row * 16);
    const f32x4 a = p[0], b = p[1], c = p[2], d = p[3];
    const float s = ((a.x + a.y) + (a.z + a.w)) + ((b.x + b.y) + (b.z + b.w)) + ((c.x + c.y) + (c.z + c.w)) + ((d.x + d.y) + (d.z + d.w));
    return __builtin_amdgcn_rsqf(s * (1.0f / D) + EPS);
}
__device__ __forceinline__ v4u pack8(const f32x4 a, const f32x4 b) { v4u w; w.x = pg8::cvt_pk_bf16(a[0], a[1]); w.y = pg8::cvt_pk_bf16(a[2], a[3]); w.z = pg8::cvt_pk_bf16(b[0], b[1]); w.w = pg8::cvt_pk_bf16(b[2], b[3]); return w; }
#define EPI_ROWS(...) _Pragma("unroll") for (int ai = 0; ai < 2; ++ai) _Pragma("unroll") for (int m = 0; m < 4; ++m) { const int row = u.pm * 256 + ai * 128 + wr * 64 + m * 16 + fr; __VA_ARGS__ }

#define EPI_RS(rs) float rs[2][4]; _Pragma("unroll") for (int ai = 0; ai < 2; ++ai) _Pragma("unroll") for (int m = 0; m < 4; ++m) rs[ai][m] = row_rstd(ssp, u.pm * 256 + ai * 128 + wr * 64 + m * 16 + fr);
struct EpiHgrnIn {
    static constexpr bool PERM = true, AFTER_DRAIN = false;
    const float* ssp; const float* lbv; const float* oml; bf16* QT; bf16* KT; bf16* V; bf16* SG; float* LF;
    __device__ __forceinline__ void operator()(const f32x4 (&acc)[2][2][4][2], const Unit& u, int wr, int wc, int fr, int fq) const {
        const int type = u.pn >> 2, cg = 256 * (u.pn & 3) + 32 * wc + 8 * fq;
        EPI_RS(rs)
        if (type == 1) {
            f32x4 lbq[2][2], omq[2][2];
#pragma unroll
            for (int bj = 0; bj < 2; ++bj)
#pragma unroll
                for (int n = 0; n < 2; ++n) { lbq[bj][n] = *(const f32x4*)(lbv + cg + 128 * bj + 4 * n); omq[bj][n] = *(const f32x4*)(oml + cg + 128 * bj + 4 * n); }
            EPI_ROWS(
                _Pragma("unroll") for (int bj = 0; bj < 2; ++bj) { const int col = cg + 128 * bj; f32x4 lf[2], kk[2];
                    _Pragma("unroll") for (int n = 0; n < 2; ++n) {
                        _Pragma("unroll") for (int i = 0; i < 4; ++i) { const float z = acc[ai][bj][m][n][i] * rs[ai][m]; const float e = __expf(-z), sg = __builtin_amdgcn_rcpf(1.0f + e);
                            const float f = lbq[bj][n][i] + omq[bj][n][i] * sg; lf[n][i] = __logf(f); kk[n][i] = omq[bj][n][i] * (e * sg); } }
                    *(f32x4*)(LF + (unsigned)row * D + col) = lf[0]; *(f32x4*)(LF + (unsigned)row * D + col + 4) = lf[1];
                    *(v4u*)(KT + (unsigned)row * D + col) = pack8(kk[0], kk[1]); })
        } else {
            bf16* O = QT + (size_t)type * (16u << 20); const bool act = type != 2;
            EPI_ROWS(
                _Pragma("unroll") for (int bj = 0; bj < 2; ++bj) { const int col = cg + 128 * bj; f32x4 o[2];
                    _Pragma("unroll") for (int n = 0; n < 2; ++n) _Pragma("unroll") for (int i = 0; i < 4; ++i) { const float z = acc[ai][bj][m][n][i] * rs[ai][m]; o[n][i] = act ? fsilu(z) : z; }
                    *(v4u*)(O + (unsigned)row * D + col) = pack8(o[0], o[1]); })
        }
    }
};
struct EpiRes {
    static constexpr bool PERM = true, AFTER_DRAIN = false;
    const float* base; float* out; bf16* xb; float* ssp;
    __device__ __forceinline__ void operator()(const f32x4 (&acc)[2][2][4][2], const Unit& u, int wr, int wc, int fr, int fq) const {
        const int c0 = 256 * u.pn + 32 * wc + 8 * fq;
#pragma unroll
        for (int ai = 0; ai < 2; ++ai) {
            f32x4 pre[4][2][2];
#pragma unroll
            for (int m = 0; m < 4; ++m)
#pragma unroll
                for (int bj = 0; bj < 2; ++bj) { const unsigned off = (unsigned)(u.pm * 256 + ai * 128 + wr * 64 + m * 16 + fr) * D + c0 + 128 * bj;
                    pre[m][bj][0] = *(const f32x4*)(base + off); pre[m][bj][1] = *(const f32x4*)(base + off + 4); }
#pragma unroll
            for (int m = 0; m < 4; ++m) { const int row = u.pm * 256 + ai * 128 + wr * 64 + m * 16 + fr; float ss = 0.f;
#pragma unroll
                for (int bj = 0; bj < 2; ++bj) { const unsigned off = (unsigned)row * D + c0 + 128 * bj;
                    const f32x4 v0 = pre[m][bj][0] + acc[ai][bj][m][0], v1 = pre[m][bj][1] + acc[ai][bj][m][1];
                    *(f32x4*)(out + off) = v0; *(f32x4*)(out + off + 4) = v1; *(v4u*)(xb + off) = pack8(v0, v1);
                    ss += ((v0[0] * v0[0] + v0[1] * v0[1]) + (v0[2] * v0[2] + v0[3] * v0[3])) + ((v1[0] * v1[0] + v1[1] * v1[1]) + (v1[2] * v1[2] + v1[3] * v1[3])); }
                ss += __shfl_xor(ss, 16); ss += __shfl_xor(ss, 32);
                if (fq == 0) ssp[(unsigned)row * 16 + 4 * u.pn + wc] = ss; }
        }
    }
};
struct EpiFfnIn {
    static constexpr bool PERM = true, AFTER_DRAIN = false;
    const float* ssp; bf16* H;
    __device__ __forceinline__ void operator()(const f32x4 (&acc)[2][2][4][2], const Unit& u, int wr, int wc, int fr, int fq) const {
        const int c0 = 128 * u.pn + 32 * wc + 8 * fq;
        EPI_RS(rs)
        EPI_ROWS(f32x4 o[2];
            _Pragma("unroll") for (int n = 0; n < 2; ++n) _Pragma("unroll") for (int i = 0; i < 4; ++i) { const float g = acc[ai][0][m][n][i] * rs[ai][m], up = acc[ai][1][m][n][i] * rs[ai][m]; o[n][i] = fsilu(g) * up; }
            *(v4u*)(H + (unsigned)row * DFF + c0) = pack8(o[0], o[1]);)
    }
};
struct EpiLruIn {
    static constexpr bool PERM = true, AFTER_DRAIN = false;
    const float* ssp; bf16* YG; bf16* U;
    __device__ __forceinline__ void operator()(const f32x4 (&acc)[2][2][4][2], const Unit& u, int wr, int wc, int fr, int fq) const {
        const int cg = 256 * (u.pn & 3) + 32 * wc + 8 * fq;
        EPI_RS(rs)
        if (u.pn < 4) {
            EPI_ROWS(
                _Pragma("unroll") for (int bj = 0; bj < 2; ++bj) { f32x4 o[2];
                    _Pragma("unroll") for (int n = 0; n < 2; ++n) _Pragma("unroll") for (int i = 0; i < 4; ++i) { const float z = acc[ai][bj][m][n][i] * rs[ai][m];
                        o[n][i] = z * fsigmoid(1.5957691216057308f * (z + 0.044715f * z * z * z)); }
                    *(v4u*)(YG + (unsigned)row * D + cg + 128 * bj) = pack8(o[0], o[1]); })
        } else {
            EPI_ROWS(
                _Pragma("unroll") for (int bj = 0; bj < 2; ++bj)
                    *(v4u*)(U + (unsigned)row * D + cg + 128 * bj) = pack8(acc[ai][bj][m][0] * rs[ai][m], acc[ai][bj][m][1] * rs[ai][m]);)
        }
    }
};
struct EpiGates {
    static constexpr bool PERM = true, AFTER_DRAIN = false;
    const float* ba; const float* bx; const float* sp8  ; const bf16* UC; _Float16* LA; bf16* BI;
    __device__ __forceinline__ void operator()(const f32x4 (&acc)[2][2][4][2], const Unit& u, int wr, int wc, int fr, int fq) const {
        const int c0 = 128 * u.pn + 32 * wc + 8 * fq;
#pragma unroll
        for (int ai = 0; ai < 2; ++ai) {
            v4u uwq[4];
#pragma unroll
            for (int m = 0; m < 4; ++m) uwq[m] = *(const v4u*)(UC + (unsigned)(u.pm * 256 + ai * 128 + wr * 64 + m * 16 + fr) * D + c0);
#pragma unroll
            for (int n = 0; n < 2; ++n) { const f32x4 bav = *(const f32x4*)(ba + c0 + 4 * n), bxv = *(const f32x4*)(bx + c0 + 4 * n), spv = *(const f32x4*)(sp8 + c0 + 4 * n);
#pragma unroll
                for (int m = 0; m < 4; ++m) { const int row = u.pm * 256 + ai * 128 + wr * 64 + m * 16 + fr; f32x4 bi; typedef _Float16 h4 __attribute__((ext_vector_type(4))); h4 hv;
#pragma unroll
                    for (int i = 0; i < 4; ++i) { const unsigned w32 = uwq[m][2 * n + (i >> 1)]; const float ucv = __builtin_bit_cast(float, (i & 1) ? (w32 & 0xffff0000u) : (w32 << 16));
                        const float r = fsigmoid(acc[ai][0][m][n][i] + bav[i]), ig = fsigmoid(acc[ai][1][m][n][i] + bxv[i]);
                        const float lg = spv[i] * r, x = 2.0f * lg;
                        const float em = -x * (1.0f + x * (0.5f + x * (0.16666667f + x * (0.041666668f + x * (0.0083333338f + x * 0.0013888889f)))));
                        hv[i] = (_Float16)lg; bi[i] = __builtin_amdgcn_sqrtf(fmaxf(em, 0.0f)) * (ig * ucv); }
                    *(h4*)(LA + (unsigned)row * D + c0 + 4 * n) = hv;
                    u32x2v pk; pk.x = pg8::cvt_pk_bf16(bi[0], bi[1]); pk.y = pg8::cvt_pk_bf16(bi[2], bi[3]);
                    *(u32x2v*)(BI + (unsigned)row * D + c0 + 4 * n) = pk; } }
        }
    }
};
struct EpiNull {
    static constexpr bool PERM = true, AFTER_DRAIN = false;
    __device__ __forceinline__ void operator()(const f32x4 (&acc)[2][2][4][2], const Unit& u, int wr, int wc, int fr, int fq) const {
#pragma unroll
        for (int ai = 0; ai < 2; ++ai)
#pragma unroll
            for (int bj = 0; bj < 2; ++bj)
#pragma unroll
                for (int m = 0; m < 4; ++m)
#pragma unroll
                    for (int n = 0; n < 2; ++n) asm volatile("" :: "v"(acc[ai][bj][m][n]));
    }
};

template <int MODE> struct EpiFfnX {
    static constexpr bool PERM = true, AFTER_DRAIN = false;
    const float* ssp; bf16* H;
    __device__ __forceinline__ void operator()(const f32x4 (&acc)[2][2][4][2], const Unit& u, int wr, int wc, int fr, int fq) const {
        const int c0 = 128 * u.pn + 32 * wc + 8 * fq;
        float rs[2][4];
#pragma unroll
        for (int ai = 0; ai < 2; ++ai)
#pragma unroll
            for (int m = 0; m < 4; ++m) rs[ai][m] = MODE == 2 ? 1.0f : row_rstd(ssp, u.pm * 256 + ai * 128 + wr * 64 + m * 16 + fr);
        EPI_ROWS(f32x4 o[2];
            _Pragma("unroll") for (int n = 0; n < 2; ++n) _Pragma("unroll") for (int i = 0; i < 4; ++i) { const float g = acc[ai][0][m][n][i] * rs[ai][m], up = acc[ai][1][m][n][i] * rs[ai][m]; o[n][i] = MODE == 3 ? g + up : fsilu(g) * up; }
            const v4u w = pack8(o[0], o[1]);
            if (MODE == 1) asm volatile("" :: "v"(w)); else *(v4u*)(H + (unsigned)row * DFF + c0) = w;)
    }
};
typedef short s16x4 __attribute__((ext_vector_type(4)));
struct Args { const float* in[19]; float* out; unsigned char* ws; int ph_lo, ph_hi; };
static_assert(sizeof(Args) == 19 * 8 + 8 + 8 + 8, "Args has no padding");
__device__ __forceinline__ LAS unsigned char* lds_base() { extern __shared__ __attribute__((aligned(16))) unsigned char lds_dyn[]; return (LAS unsigned char*)lds_dyn; }
#define TID ((int)threadIdx.x)
#define LANE (TID & 63)
#define WAVE (__builtin_amdgcn_readfirstlane(TID >> 6))
#define GSZ ((int)gridDim.x)
#define VCU ((GSZ % 8 == 0) ? ((int)blockIdx.x % 8) * (GSZ / 8) + (int)blockIdx.x / 8 : (int)blockIdx.x)
#define LDSB (lds_base())
#define WSP(T, off) ((T*)(F.ws + (off)))
__device__ __forceinline__ float wave_sum(float v) {
#pragma unroll
    for (int o = 1; o < 64; o <<= 1) v += __shfl_xor(v, o);
    return v;
}
__device__ __forceinline__ void tr_item(const float* W, int ldw, int k0, int ns0, bf16* WT, int ldt, int drow0, const float* ksc, LAS float* scr, int lane) {
#pragma unroll 8
    for (int i = 0; i < 32; ++i) { const int kk = 2 * i + (lane >> 5); float w = W[(size_t)(k0 + kk) * ldw + ns0 + (lane & 31)]; if (ksc) w *= ksc[k0 + kk]; scr[kk * 33 + (lane & 31)] = w; }
    LDS_WAIT(); asm volatile("" ::: "memory");
    const int c = lane & 7;
#pragma unroll
    for (int j = 0; j < 4; ++j) { const int n = (lane >> 3) + 8 * j; const LAS float* s = scr + (8 * c) * 33 + n;
        v4u o; o.x = pk2(s[0 * 33], s[1 * 33]); o.y = pk2(s[2 * 33], s[3 * 33]); o.z = pk2(s[4 * 33], s[5 * 33]); o.w = pk2(s[6 * 33], s[7 * 33]);
        *(GAS v4u*)(WT + (size_t)(drow0 + n) * ldt + k0 + 8 * c) = o; }
    LDS_WAIT(); asm volatile("" ::: "memory");
}
__device__ __forceinline__ void p0_prologue(const Args& F) {
    LAS float* scr = (LAS float*)(LDSB + WAVE * 16384);
    const int gw = VCU * NWAVES + WAVE, NGW = GSZ * NWAVES, lane = LANE;
    constexpr int I_A = 16 * 128, I_B = 16 * 32, I_C = 16 * 64, I_D = 16 * 32, I_E = 256, I_F = 16 * 176, I_G = 44 * 32;
    constexpr int NITEMS = I_A + I_B + I_C + I_D + I_E + 2 * I_F + 2 * I_G;
    for (int it = gw; it < NITEMS; it += NGW) {
        int r = it;
        if (r < I_A) { const int kb = r / 128, nb = r % 128; tr_item(F.in[4], 4096, 64 * kb, 32 * nb, WSP(bf16, WS_W_HIN), 1024, 32 * nb, F.in[1], scr, lane); continue; } r -= I_A;
        if (r < I_B) { const int kb = r / 32, nb = r % 32; tr_item(F.in[7], 1024, 64 * kb, 32 * nb, WSP(bf16, WS_W_HOUT), 1024, 32 * nb, nullptr, scr, lane); continue; } r -= I_B;
        if (r < I_C) { const int kb = r / 64, nb = r % 64; tr_item(F.in[8], 2048, 64 * kb, 32 * nb, WSP(bf16, WS_W_LIN), 1024, 32 * nb, F.in[1] + 1024, scr, lane); continue; } r -= I_C;
        if (r < I_D) { const int kb = r / 32, nb = r % 32; tr_item(F.in[16], 1024, 64 * kb, 32 * nb, WSP(bf16, WS_W_LOUT), 1024, 32 * nb, nullptr, scr, lane); continue; } r -= I_D;
        if (r < I_E) { const int isx = r >> 7, n = (r >> 5) & 3, kb = (r >> 3) & 3, nb = r & 7; const int ch0 = 256 * n + 32 * nb;
            tr_item((isx ? F.in[13] : F.in[11]) + (size_t)n * 65536, 256, 64 * kb, 32 * nb, WSP(bf16, WS_W_GATE), 256, 256 * (ch0 >> 7) + (ch0 & 127) + 128 * isx, nullptr, scr, lane); continue; } r -= I_E;
        if (r < 2 * I_F) { const int l = r / I_F, q = r % I_F, kb = q / 176, nb = q % 176, isup = nb >= 88 ? 1 : 0, j0 = 32 * (nb - 88 * isup);
            tr_item(F.in[17] + (size_t)l * 1024 * 5632, 5632, 64 * kb, 32 * nb, WSP(bf16, l ? WS_W_FIN1 : WS_W_FIN0), 1024, 256 * (j0 >> 7) + (j0 & 127) + 128 * isup, F.in[2] + l * 1024, scr, lane); continue; } r -= 2 * I_F;
        { const int l = r / I_G, q = r % I_G, kb = q / 32, nb = q % 32;
            tr_item(F.in[18] + (size_t)l * 2816 * 1024, 1024, 64 * kb, 32 * nb, WSP(bf16, l ? WS_W_FOUT1 : WS_W_FOUT0), 2816, 32 * nb, nullptr, scr, lane); }
    }
    for (int m = gw; m < M; m += NGW) {
        const GAS f32x4* xr = (const GAS f32x4*)(F.in[0] + (size_t)m * D) + lane; f32x4 v[4]; float s = 0.f;
#pragma unroll
        for (int j = 0; j < 4; ++j) { v[j] = xr[64 * j]; s += (v[j].x * v[j].x + v[j].y * v[j].y) + (v[j].z * v[j].z + v[j].w * v[j].w); }
        s = wave_sum(s);
        GAS unsigned long long* o8 = (GAS unsigned long long*)(WSP(bf16, WS_XB) + (size_t)m * D) + lane;
#pragma unroll
        for (int j = 0; j < 4; ++j) o8[64 * j] = (unsigned long long)pk2(v[j].x, v[j].y) | ((unsigned long long)pk2(v[j].z, v[j].w) << 32);
        if (lane < 16) WSP(float, WS_SSP)[(size_t)m * 16 + lane] = lane == 0 ? s : 0.f;
    }
    { const int g = blockIdx.x * (NWAVES * 64) + TID; if (g < 1024) { const float l0 = F.in[5][g], l1 = F.in[5][1024 + g];
        WSP(float, WS_TAB)[g] = __builtin_amdgcn_rcpf(1.0f + __expf(l1 - l0)); WSP(float, WS_TAB)[1024 + g] = __builtin_amdgcn_rcpf(1.0f + __expf(l0 - l1));
        WSP(float, WS_TAB)[2048 + g] = -8.0f * log1pf(__expf(-F.in[15][g])); } }
}
__device__ __forceinline__ void hgrn_prep(const Args& F) {
    bf16* QT = WSP(bf16, WS_QT); bf16* KT = WSP(bf16, WS_KT); const float* LF = F.out; float* DEC = WSP(float, WS_DEC);
    for (int idx = blockIdx.x * (NWAVES * 64) + TID; idx < NCHUNK * 1024; idx += GSZ * NWAVES * 64) {
        const int c = idx >> 10, col = idx & 1023; float b = 0.f; size_t off = (size_t)c * CH * D + col;
#pragma unroll 8
        for (int s = 0; s < CH; ++s, off += D) { b += LF[off]; const float eb = __expf(b), enb = __expf(-b);
            QT[off] = (bf16)f2bf(bf2f(QT[off]) * eb); KT[off] = (bf16)f2bf(bf2f(KT[off]) * enb); }
        DEC[idx] = __expf(b);
    }
}
constexpr int TP = 272  , AP_ = 144  ;
constexpr int L_Q = 0, L_K = 17408, L_V = 34816, L_A = 52224, L_ST = 61440, L_RS = 96256;
__device__ __forceinline__ void stage_tile(LAS unsigned char* img, const bf16* src, int tid) {
#pragma unroll
    for (int i = 0; i < 2; ++i) { const int piece = tid + 512 * i, row = piece >> 4, pc = piece & 15;
        const v4u x = *(const GAS v4u*)(src + (size_t)row * D + pc * 8); *(LAS v4u*)(img + row * TP + pc * 16) = x; }
}
__device__ __forceinline__ bf16x8 frag_row(const LAS unsigned char* img, int pitch, int row0, int k0, int fr, int fq) {
    return *(const LAS bf16x8*)(img + (row0 + fr) * pitch + (k0 + 8 * fq) * 2);
}
__device__ __forceinline__ bf16x8 frag_tr(const LAS unsigned char* img, int pitch, int n0, int k0, int fr, int fq) {
    const int q = fr >> 2, p = fr & 3;
    const s16x4 lo = __builtin_amdgcn_ds_read_tr16_b64_v4i16((LAS s16x4*)(img + (k0 + 8 * fq + q) * pitch + (n0 + 4 * p) * 2));
    const s16x4 hi = __builtin_amdgcn_ds_read_tr16_b64_v4i16((LAS s16x4*)(img + (k0 + 8 * fq + 4 + q) * pitch + (n0 + 4 * p) * 2));
    return __builtin_shufflevector(lo, hi, 0, 1, 2, 3, 4, 5, 6, 7);
}
#define MFMA16(a, b, c) __builtin_amdgcn_mfma_f32_16x16x32_bf16((a), (b), (c), 0, 0, 0)
__device__ __forceinline__ void state_update(f32x4 (&S)[8], const LAS unsigned char* Ki, const LAS unsigned char* Vi, const float* decp, int w, int fr, int fq) {
#pragma unroll
    for (int ks = 0; ks < 2; ++ks) { const bf16x8 X = frag_tr(Ki, TP, 16 * w, 32 * ks, fr, fq);
#pragma unroll
        for (int vb = 0; vb < 8; ++vb) S[vb] = MFMA16(X, frag_tr(Vi, TP, 16 * vb, 32 * ks, fr, fq), S[vb]); }
    const f32x4 dv = *(const f32x4*)(decp + 16 * w + 4 * fq);
#pragma unroll
    for (int vb = 0; vb < 8; ++vb) S[vb] = S[vb] * dv;
}
__device__ __forceinline__ void hgrn_seg_state(const Args& F) {
    LAS unsigned char* Ki = LDSB + L_K; LAS unsigned char* Vi = LDSB + L_V;
    const int w = WAVE, fr = LANE & 15, fq = LANE >> 4;
    for (int unit = VCU; unit < NUNIT; unit += GSZ) {
        const int b = unit / (NH * NSEG), h = (unit / NSEG) % NH, seg = unit % NSEG;
        f32x4 S[8];
#pragma unroll
        for (int vb = 0; vb < 8; ++vb) S[vb] = (f32x4){0.f, 0.f, 0.f, 0.f};
        for (int c = 0; c < CPS; ++c) {
            const int cg = b * CPB + seg * CPS + c; const size_t r0 = (size_t)cg * CH;
            __syncthreads();
            stage_tile(Ki, WSP(bf16, WS_KT) + r0 * D + h * DK, TID); stage_tile(Vi, WSP(bf16, WS_V) + r0 * D + h * DK, TID);
            __syncthreads();
            state_update(S, Ki, Vi, WSP(float, WS_DEC) + (size_t)cg * D + h * DK, w, fr, fq);
        }
        float* sl = WSP(float, WS_SLOC) + (size_t)unit * 16384;
#pragma unroll
        for (int vb = 0; vb < 8; ++vb)
#pragma unroll
            for (int r = 0; r < 4; ++r) sl[(16 * w + 4 * fq + r) * 128 + 16 * vb + fr] = S[vb][r];
    }
}
__device__ __forceinline__ void hgrn_seg_scan(const Args& F) {
    float* SL = WSP(float, WS_SLOC); const float* DEC = WSP(float, WS_DEC);
    for (int idx = blockIdx.x * (NWAVES * 64) + TID; idx < BATCH * NH * 16384; idx += GSZ * NWAVES * 64) {
        const int bh = idx >> 14, kv = idx & 16383, k = kv >> 7, b = bh / NH, h = bh % NH; float S = 0.f;
        for (int seg = 0; seg < NSEG; ++seg) { float* p = SL + ((size_t)(bh * NSEG + seg) << 14) + kv; const float t = *p; *p = S;
            float dsg = 1.f; const float* dp = DEC + (size_t)(b * CPB + seg * CPS) * D + h * DK + k;
#pragma unroll
            for (int c = 0; c < CPS; ++c) dsg *= dp[(size_t)c * D];
            S = dsg * S + t; }
    }
}
__device__ __forceinline__ void hgrn_out(const Args& F) {
    LAS unsigned char* Qi = LDSB + L_Q; LAS unsigned char* Ki = LDSB + L_K; LAS unsigned char* Vi = LDSB + L_V; LAS unsigned char* Ai = LDSB + L_A; LAS unsigned char* STi = LDSB + L_ST;
    LAS float* RS = (LAS float*)(LDSB + L_RS);
    const int w = WAVE, fr = LANE & 15, fq = LANE >> 4, tb = w & 3, wh = w >> 2;
    const float* nw = F.in[6];
    for (int unit = VCU; unit < NUNIT; unit += GSZ) {
        const int b = unit / (NH * NSEG), h = (unit / NSEG) % NH, seg = unit % NSEG;
        f32x4 S[8];
        { const float* sl = WSP(float, WS_SLOC) + (size_t)unit * 16384;
#pragma unroll
          for (int vb = 0; vb < 8; ++vb)
#pragma unroll
            for (int r = 0; r < 4; ++r) S[vb][r] = sl[(16 * w + 4 * fq + r) * 128 + 16 * vb + fr]; }
        __syncthreads();
#pragma unroll
        for (int vb = 0; vb < 8; ++vb) { u32x2v pk; pk.x = pg8::cvt_pk_bf16(S[vb][0], S[vb][1]); pk.y = pg8::cvt_pk_bf16(S[vb][2], S[vb][3]);
            *(LAS u32x2v*)(STi + (16 * vb + fr) * TP + (16 * w + 4 * fq) * 2) = pk; }
        for (int c = 0; c < CPS; ++c) {
            const int cg = b * CPB + seg * CPS + c; const size_t r0 = (size_t)cg * CH;
            bf16* qg = WSP(bf16, WS_QT) + r0 * D + h * DK;
            stage_tile(Qi, qg, TID); stage_tile(Ki, WSP(bf16, WS_KT) + r0 * D + h * DK, TID); stage_tile(Vi, WSP(bf16, WS_V) + r0 * D + h * DK, TID);
            __syncthreads();
            bf16x8 Yq[4];
#pragma unroll
            for (int ks = 0; ks < 4; ++ks) Yq[ks] = frag_row(Qi, TP, 16 * tb, 32 * ks, fr, fq);
#pragma unroll
            for (int sbi = 0; sbi < 2; ++sbi) { const int sb = 2 * wh + sbi; f32x4 a = (f32x4){0.f, 0.f, 0.f, 0.f};
                if (sb <= tb) {
#pragma unroll
                    for (int ks = 0; ks < 4; ++ks) a = MFMA16(frag_row(Ki, TP, 16 * sb, 32 * ks, fr, fq), Yq[ks], a);
                }
                const int t = 16 * tb + fr, s0 = 16 * sb + 4 * fq;
#pragma unroll
                for (int r = 0; r < 4; ++r) a[r] = (s0 + r <= t) ? a[r] : 0.f;
                u32x2v pk; pk.x = pg8::cvt_pk_bf16(a[0], a[1]); pk.y = pg8::cvt_pk_bf16(a[2], a[3]);
                *(LAS u32x2v*)(Ai + t * AP_ + s0 * 2) = pk; }
            __syncthreads();
            bf16x8 Ya[2];
#pragma unroll
            for (int ks = 0; ks < 2; ++ks) Ya[ks] = frag_row(Ai, AP_, 16 * tb, 32 * ks, fr, fq);
            f32x4 o[4]; float ssq = 0.f;
#pragma unroll
            for (int j = 0; j < 4; ++j) { const int vb = 4 * wh + j; f32x4 a = (f32x4){0.f, 0.f, 0.f, 0.f};
#pragma unroll
                for (int ks = 0; ks < 4; ++ks) a = MFMA16(frag_row(STi, TP, 16 * vb, 32 * ks, fr, fq), Yq[ks], a);
#pragma unroll
                for (int ks = 0; ks < 2; ++ks) a = MFMA16(frag_tr(Vi, TP, 16 * vb, 32 * ks, fr, fq), Ya[ks], a);
                o[j] = a; ssq += (a[0] * a[0] + a[1] * a[1]) + (a[2] * a[2] + a[3] * a[3]); }
            ssq += __shfl_xor(ssq, 16); ssq += __shfl_xor(ssq, 32);
            if (fq == 0) RS[(16 * tb + fr) * 2 + wh] = ssq;
            state_update(S, Ki, Vi, WSP(float, WS_DEC) + (size_t)cg * D + h * DK, w, fr, fq);
            __syncthreads();
            { const int t = 16 * tb + fr; const float rstd = __builtin_amdgcn_rsqf((RS[t * 2] + RS[t * 2 + 1]) * (1.0f / DK) + EPS);
              const bf16* sgp = WSP(bf16, WS_SG) + (r0 + t) * D + h * DK;
#pragma unroll
              for (int j = 0; j < 4; ++j) { const int v0 = 16 * (4 * wh + j) + 4 * fq; const u32x2v sgw = *(const GAS u32x2v*)(sgp + v0); const f32x4 nv = *(const f32x4*)(nw + v0);
                  const float g0 = __builtin_bit_cast(float, sgw.x << 16), g1 = __builtin_bit_cast(float, sgw.x & 0xffff0000u), g2 = __builtin_bit_cast(float, sgw.y << 16), g3 = __builtin_bit_cast(float, sgw.y & 0xffff0000u);
                  u32x2v pk; pk.x = pg8::cvt_pk_bf16(o[j][0] * rstd * nv[0] * g0, o[j][1] * rstd * nv[1] * g1); pk.y = pg8::cvt_pk_bf16(o[j][2] * rstd * nv[2] * g2, o[j][3] * rstd * nv[3] * g3);
                  *(GAS u32x2v*)(qg + (size_t)t * D + v0) = pk; } }
#pragma unroll
            for (int vb = 0; vb < 8; ++vb) { u32x2v pk; pk.x = pg8::cvt_pk_bf16(S[vb][0], S[vb][1]); pk.y = pg8::cvt_pk_bf16(S[vb][2], S[vb][3]);
                *(LAS u32x2v*)(STi + (16 * vb + fr) * TP + (16 * w + 4 * fq) * 2) = pk; }
            __syncthreads();
        }
    }
}
__device__ __forceinline__ void lru_conv(const Args& F) {
    const bf16* U = WSP(bf16, WS_U); bf16* UC = WSP(bf16, WS_UC); const float* cw = F.in[9]; const float* cb = F.in[10];
    for (int idx = blockIdx.x * (NWAVES * 64) + TID; idx < M * (D / 8); idx += GSZ * NWAVES * 64) {
        const int row = idx >> 7, c0 = (idx & 127) * 8, t = row & (SEQ - 1); float a[8];
#pragma unroll
        for (int j = 0; j < 8; ++j) a[j] = cb[c0 + j];
#pragma unroll
        for (int tap = 0; tap < 4; ++tap) { const int dt = 3 - tap; if (t - dt >= 0) { const v4u uw = *(const GAS v4u*)(U + (size_t)(row - dt) * D + c0);
#pragma unroll
            for (int j = 0; j < 8; ++j) { const unsigned w32 = uw[j >> 1]; const float uv = __builtin_bit_cast(float, (j & 1) ? (w32 & 0xffff0000u) : (w32 << 16)); a[j] += uv * cw[tap * D + c0 + j]; } } }
        v4u o; o.x = pk2(a[0], a[1]); o.y = pk2(a[2], a[3]); o.z = pk2(a[4], a[5]); o.w = pk2(a[6], a[7]);
        *(GAS v4u*)(UC + (size_t)row * D + c0) = o;
    }
}
__device__ __forceinline__ void lru_scan_local(const Args& F) {
    const _Float16* LA = WSP(_Float16, WS_U); const bf16* BI = WSP(bf16, WS_BI); float* AP = WSP(float, WS_AP); float* HE = WSP(float, WS_HE);
    for (int idx = blockIdx.x * (NWAVES * 64) + TID; idx < NSC * D; idx += GSZ * NWAVES * 64) {
        const int sc = idx >> 10, ch = idx & 1023; size_t off = (size_t)sc * SCH * D + ch; float h = 0.f, sl = 0.f;
#pragma unroll 8
        for (int r = 0; r < SCH; ++r, off += D) { const float la = (float)LA[off]; h = __expf(la) * h + bf2f(BI[off]); sl += la; }
        AP[idx] = __expf(sl); HE[idx] = h;
    }
}
__device__ __forceinline__ void lru_scan_apply(const Args& F) {
    const _Float16* LA = WSP(_Float16, WS_U); const bf16* BI = WSP(bf16, WS_BI); const bf16* YG = WSP(bf16, WS_YG); bf16* HY = WSP(bf16, WS_UC);
    const float* AP = WSP(float, WS_AP); const float* HE = WSP(float, WS_HE);
    for (int idx = blockIdx.x * (NWAVES * 64) + TID; idx < NSC * D; idx += GSZ * NWAVES * 64) {
        const int sc = idx >> 10, ch = idx & 1023, sc0 = (sc / SCPB) * SCPB; float h = 0.f;
        for (int j = sc0; j < sc; ++j) h = AP[j * D + ch] * h + HE[j * D + ch];
        size_t off = (size_t)sc * SCH * D + ch;
#pragma unroll 8
        for (int r = 0; r < SCH; ++r, off += D) { h = __expf((float)LA[off]) * h + bf2f(BI[off]); HY[off] = (bf16)f2bf(h * bf2f(YG[off])); }
    }
}
__device__ __forceinline__ void final_norm(const Args& F) {
    const int gw = VCU * NWAVES + WAVE, NGW = GSZ * NWAVES; const float* nf = F.in[3];
    for (int m = gw; m < M; m += NGW) { const float rs = row_rstd(WSP(float, WS_SSP), m); GAS f32x4* xr = (GAS f32x4*)(F.out + (size_t)m * D) + LANE;
#pragma unroll
        for (int j = 0; j < 4; ++j) { const f32x4 w = *((const f32x4*)nf + LANE + 64 * j); xr[64 * j] = xr[64 * j] * rs * w; } }
}
#ifndef MK_N_LAUNCHES
#define MK_N_LAUNCHES 1
#endif
constexpr int N_PHASES = 18;
#ifndef ONLY_PHASE
#define ONLY_PHASE -1
#endif
#ifndef EXTRA_PHASE
#define EXTRA_PHASE 0
#endif
#ifndef PROBE_MASK
#define PROBE_MASK 0u
#endif
#ifndef PROBE_MASK2
#define PROBE_MASK2 0u
#endif
#define GEMM_RUN(EPI, g, nM_, nN_, E) do { pg8::StaticOrder S_; S_.init(nM_, nN_, GSZ, (int)blockIdx.x); pg8::gemm_phase<EPI, pg8::StaticOrder, true, true>(LDSB, g, S_, E); } while (0)
__global__ void __launch_bounds__(NWAVES * 64, 2) trunk_fwd(Args args) {
    const Args& F = args;
    volatile LAS unsigned* MISC = (volatile LAS unsigned*)(LDSB + MISC_OFF);
    gu32* ctl = (gu32*)(args.ws + WS_CTL);
    for (int u = TID; u < (LDS_BYTES - LDSCTL_OFF) / 4; u += NWAVES * 64) ((LAS unsigned*)(LDSB + LDSCTL_OFF))[u] = 0u;
    __syncthreads();
    XcdBarrier bar; bar.bar = (unsigned*)(ctl + CW_BAR); bar.x = 0; bar.st = nullptr;
    if (MK_N_LAUNCHES == 1) bar = xcd_barrier_post((unsigned*)(ctl + CW_BAR), MISC + 8);
    const int lo = args.ph_lo, hi = args.ph_hi;
#define IN(k) ((ONLY_PHASE < 0 || ONLY_PHASE == (k)) && lo <= (k) && (k) < hi)
    unsigned long long tacc = 0ull, tacc2 = 0ull, tph = 0ull;
#define PB(k) do { if (((PROBE_MASK | PROBE_MASK2) >> (k)) & 1u) tph = rt(); } while (0)
#define SEAM(k) do { if (IN(k) && IN((k) + 1)) xcd_barrier(bar); if ((PROBE_MASK >> (k)) & 1u) tacc += rt() - tph; if ((PROBE_MASK2 >> (k)) & 1u) tacc2 += rt() - tph; } while (0)
    bf16* XB = WSP(bf16, WS_XB); float* SSP = WSP(float, WS_SSP);
    PB(0); if (IN(0)) { p0_prologue(F); } SEAM(0);
    PB(1); if (IN(1)) { pg8::Gemm g{XB, WSP(bf16, WS_W_HIN), D, D, D, 0};
        EpiHgrnIn E{SSP, WSP(float, WS_TAB), WSP(float, WS_TAB) + 1024, WSP(bf16, WS_QT), WSP(bf16, WS_KT), WSP(bf16, WS_V), WSP(bf16, WS_SG), F.out};
        GEMM_RUN(EpiHgrnIn, g, M / 256, 16, E); } SEAM(1);
    PB(2); if (IN(2)) { hgrn_prep(F); } SEAM(2);
    PB(3); if (IN(3)) { hgrn_seg_state(F); } SEAM(3);
    PB(4); if (IN(4)) { hgrn_seg_scan(F); } SEAM(4);
    PB(5); if (IN(5)) { hgrn_out(F); } SEAM(5);
    PB(6); if (IN(6)) { pg8::Gemm g{WSP(bf16, WS_QT), WSP(bf16, WS_W_HOUT), D, D, D, 0}; EpiRes E{F.in[0], F.out, XB, SSP}; GEMM_RUN(EpiRes, g, M / 256, 4, E); } SEAM(6);
    PB(7); if (IN(7)) { pg8::Gemm g{XB, WSP(bf16, WS_W_FIN0), D, D, D, 0}; EpiFfnIn E{SSP, WSP(bf16, WS_H)}; GEMM_RUN(EpiFfnIn, g, M / 256, 22, E); } SEAM(7);
    PB(8); if (IN(8)) { pg8::Gemm g{WSP(bf16, WS_H), WSP(bf16, WS_W_FOUT0), DFF, DFF, DFF, 0}; EpiRes E{F.out, F.out, XB, SSP}; GEMM_RUN(EpiRes, g, M / 256, 4, E); } SEAM(8);
    PB(9); if (IN(9)) { pg8::Gemm g{XB, WSP(bf16, WS_W_LIN), D, D, D, 0}; EpiLruIn E{SSP, WSP(bf16, WS_YG), WSP(bf16, WS_U)}; GEMM_RUN(EpiLruIn, g, M / 256, 8, E); } SEAM(9);
    PB(10); if (IN(10)) { lru_conv(F); } SEAM(10);
    PB(11); if (IN(11)) { int kg = 256; asm volatile("" : "+s"(kg));
        pg8::Gemm g{WSP(bf16, WS_UC), WSP(bf16, WS_W_GATE), D, 256, kg, 1};
        EpiGates E{F.in[12], F.in[14], WSP(float, WS_TAB) + 2048, WSP(bf16, WS_UC), WSP(_Float16, WS_U), WSP(bf16, WS_BI)}; GEMM_RUN(EpiGates, g, M / 256, 8, E); } SEAM(11);
    PB(12); if (IN(12)) { lru_scan_local(F); } SEAM(12);
    PB(13); if (IN(13)) { lru_scan_apply(F); } SEAM(13);
    PB(14); if (IN(14)) { pg8::Gemm g{WSP(bf16, WS_UC), WSP(bf16, WS_W_LOUT), D, D, D, 0}; EpiRes E{F.out, F.out, XB, SSP}; GEMM_RUN(EpiRes, g, M / 256, 4, E); } SEAM(14);
    PB(15); if (IN(15)) { pg8::Gemm g{XB, WSP(bf16, WS_W_FIN1), D, D, D, 0}; EpiFfnIn E{SSP, WSP(bf16, WS_H)}; GEMM_RUN(EpiFfnIn, g, M / 256, 22, E); } SEAM(15);
    PB(16); if (IN(16)) { pg8::Gemm g{WSP(bf16, WS_H), WSP(bf16, WS_W_FOUT1), DFF, DFF, DFF, 0}; EpiRes E{F.out, F.out, XB, SSP}; GEMM_RUN(EpiRes, g, M / 256, 4, E); } SEAM(16);
    PB(17); if (IN(17)) { final_norm(F); }
    if ((PROBE_MASK >> 17) & 1u) tacc += rt() - tph;
    if ((PROBE_MASK2 >> 17) & 1u) tacc2 += rt() - tph;
    if (EXTRA_PHASE != 0) { xcd_barrier(bar); tph = rt();
        if (EXTRA_PHASE == 1) { pg8::Gemm g{XB, WSP(bf16, WS_W_FIN1), D, D, D, 0}; EpiNull E{}; GEMM_RUN(EpiNull, g, M / 256, 22, E); }
        if (EXTRA_PHASE == 2) { pg8::Gemm g{XB, WSP(bf16, WS_W_FIN1), D, D, D, 0}; EpiFfnIn E{SSP, WSP(bf16, WS_H)}; GEMM_RUN(EpiFfnIn, g, M / 256, 22, E); }
        if (EXTRA_PHASE == 3) { pg8::Gemm g{XB, WSP(bf16, WS_W_FIN1), D, D, D, 0}; EpiNull E{}; GEMM_RUN(EpiNull, g, M / 256, 20, E); }
        if (EXTRA_PHASE == 4) { pg8::Gemm g{XB, WSP(bf16, WS_W_FIN1), D, D, D, 0}; EpiFfnX<1> E{SSP, WSP(bf16, WS_H)}; GEMM_RUN(EpiFfnX<1>, g, M / 256, 22, E); }
        if (EXTRA_PHASE == 5) { pg8::Gemm g{XB, WSP(bf16, WS_W_FIN1), D, D, D, 0}; EpiFfnX<2> E{SSP, WSP(bf16, WS_H)}; GEMM_RUN(EpiFfnX<2>, g, M / 256, 22, E); }
        if (EXTRA_PHASE == 6) { pg8::Gemm g{XB, WSP(bf16, WS_W_FIN1), D, D, D, 0}; EpiFfnX<3> E{SSP, WSP(bf16, WS_H)}; GEMM_RUN(EpiFfnX<3>, g, M / 256, 22, E); }
        xcd_barrier(bar); tacc += rt() - tph; }
    if ((PROBE_MASK | PROBE_MASK2 | (unsigned)EXTRA_PHASE) != 0u && blockIdx.x == 0 && TID == 0) { const unsigned long long te = rt() + 4ull * tacc + 100000ull * ((tacc2 + 50ull) / 100ull); while (rt() < te) __builtin_amdgcn_s_sleep(32); }
#undef IN
#undef SEAM
}

extern "C" void kernel_launch(void* const* d_in, const int* in_sizes, int n_in, void* d_out, int out_size, void* d_ws, size_t ws_size, hipStream_t stream) {
    static int grid = 0;
    if (grid == 0) {
        if (n_in != 19 || in_sizes[0] != M * D || out_size != M * D || ws_size < WS_END) { fprintf(stderr, "kernel_launch: unexpected shapes: n_in %d in0 %d out %d ws %zu (need %zu); nothing launched\n", n_in, n_in > 0 ? in_sizes[0] : -1, out_size, ws_size, (size_t)WS_END); grid = -1; return; }
        int dev = 0, cus = 0, per_cu = 0;
        if (hipGetDevice(&dev) != hipSuccess || hipDeviceGetAttribute(&cus, hipDeviceAttributeMultiprocessorCount, dev) != hipSuccess) { fprintf(stderr, "kernel_launch: device query failed\n"); grid = -1; return; }
        if (hipFuncSetAttribute((const void*)trunk_fwd, hipFuncAttributeMaxDynamicSharedMemorySize, LDS_BYTES) != hipSuccess) { fprintf(stderr, "kernel_launch: hipFuncSetAttribute failed\n"); grid = -1; return; }
        if (hipOccupancyMaxActiveBlocksPerMultiprocessor(&per_cu, (const void*)trunk_fwd, NWAVES * 64, LDS_BYTES) != hipSuccess || per_cu < 1) { fprintf(stderr, "kernel_launch: occupancy query says %d blocks per CU\n", per_cu); }
        (void)hipGetLastError();
        grid = cus;
        fprintf(stderr, "kernel_launch: grid %d, per_cu %d, ws %zu\n", grid, per_cu, ws_size);
    }
    if (grid < 0) return;
    if (hipMemsetAsync((char*)d_ws + WS_CTL, 0, CTL_ZERO_BYTES, stream) != hipSuccess) { fprintf(stderr, "kernel_launch: memset failed\n"); return; }
    Args a{};
    for (int i = 0; i < 19; ++i) a.in[i] = (const float*)d_in[i];
    a.out = (float*)d_out; a.ws = (unsigned char*)d_ws;
    for (int li = 0; li < MK_N_LAUNCHES; ++li) {
        a.ph_lo = (MK_N_LAUNCHES == 1) ? 0 : li; a.ph_hi = (MK_N_LAUNCHES == 1) ? N_PHASES : li + 1;
        hipLaunchKernelGGL(trunk_fwd, dim3(grid), dim3(NWAVES * 64), LDS_BYTES, stream, a);
        const hipError_t le = hipPeekAtLastError();
        if (le != hipSuccess) { fprintf(stderr, "kernel_launch: launch %d failed: %s\n", li, hipGetErrorName(le)); break; }
    }
}
```

```cpp
#include <hip/hip_runtime.h>
#include <cstdio>
#include <cstdint>
namespace pg8 {
#define PG8_LAS __attribute__((address_space(3)))
typedef unsigned short bf16_t;
typedef short bf16x8 __attribute__((ext_vector_type(8)));
typedef float f32x4 __attribute__((ext_vector_type(4)));
typedef unsigned u32x4 __attribute__((ext_vector_type(4)));
constexpr int BM = 256, BK = 64, HALF = 128, HTB = HALF * BK * 2  , STAGE_BYTES = 8 * HTB, NXCD = 8, WGM = 8;

__host__ __device__ __forceinline__ int lds_byte(int r, int c) { const int st = (r >> 4) * 2 + (c >> 5), rr = r & 15, cc = c & 31, ob = rr * 64 + cc * 2; return st * 1024 + (ob ^ (((ob >> 9) & 1) << 5)); }
__host__ __device__ __forceinline__ void stage_rc(int b, int& R, int& C) { const int st = b / 1024, sb = b % 1024, swz = sb ^ (((sb >> 9) & 1) << 5); R = (st >> 1) * 16 + swz / 64; C = (st & 1) * 32 + (swz % 64) / 2; }
__host__ __device__ __forceinline__ int perm32(int rho) { const int n = rho >> 4, i = rho & 15; return 8 * (i >> 2) + 4 * n + (i & 3); }

struct Unit { int pm, pn; };
struct Gemm { const bf16_t* A; const bf16_t* Bt; int lda, ldb, K, ablk; };

struct StaticOrder {
    int nM, nN, nwg, G, c;
    __host__ __device__ void init(int nM_, int nN_, int G_, int c_) { nM = nM_; nN = nN_; nwg = nM * nN; G = G_; c = c_; }
    __host__ __device__ bool next(int i, Unit& u) const {
        const long L = (long)i * G + c; if (L >= nwg) return false;
        int wgid = (int)L; { const int q = nwg / NXCD, r = nwg % NXCD, xcd = wgid % NXCD, off = wgid / NXCD; wgid = (xcd < r ? xcd * (q + 1) : r * (q + 1) + (xcd - r) * q) + off; }
        const int nig = WGM * nN, gid = wgid / nig, fm = gid * WGM, gsz = (nM - fm) < WGM ? (nM - fm) : WGM;
        u.pm = fm + ((wgid % nig) % gsz); u.pn = (wgid % nig) / gsz; return true;
    }
    __device__ __forceinline__ void a_ready(const Unit&) const {}
    __device__ __forceinline__ void done(const Unit&) const {}
};
__device__ __forceinline__ unsigned cvt_pk_bf16(float lo, float hi) { unsigned r; asm volatile("v_cvt_pk_bf16_f32 %0, %1, %2" : "=v"(r) : "v"(lo), "v"(hi)); return r; }
template <class Epi, class Sched, bool ALIGN_EPI = false, bool SP2 = false>
__device__ __forceinline__ void gemm_phase(PG8_LAS unsigned char* lds, const Gemm g, const Sched& S, const Epi& E) {
    const int tid = threadIdx.x, wid = __builtin_amdgcn_readfirstlane(tid >> 6), lane = tid & 63, wr = wid >> 2, wc = wid & 3, fr = lane & 15, fq = lane >> 4;
    const int K = g.K, nt = K / BK;
    unsigned voffA[2], voffB[2];
#pragma unroll
    for (int i = 0; i < 2; ++i) { int R, C; stage_rc(tid * 16 + i * 8192, R, C); const int Rb = Epi::PERM ? ((R & ~31) + perm32(R & 31)) : R;
        voffA[i] = (unsigned)(R * g.lda + C) * 2u; voffB[i] = (unsigned)(Rb * g.ldb + C) * 2u; }
    const size_t kstep = (size_t)(BK * 2);
    const size_t hstepA = (size_t)HALF * g.lda * 2, hstepB = (size_t)HALF * g.ldb * 2;
    const unsigned ldsw = (unsigned)wid * 1024u;
    const int aoff = lds_byte(wr * 64 + fr, fq * 8), boff = lds_byte(wc * 32 + fr, fq * 8);
#define PG8_UA(u) ((const char*)g.A + (size_t)(u).pm * 2 * hstepA + (g.ablk ? (size_t)((u).pn >> 1) * 512 : (size_t)0))
#define PG8_UB(u) ((const char*)g.Bt + (size_t)(u).pn * 2 * hstepB)
#define PG8_SA(b, h) (((b) * 2 + (h)) * HTB)
#define PG8_SB(b, h) ((4 + (b) * 2 + (h)) * HTB)
#define PG8_STAGE(bufoff, gbase, voff) do { _Pragma("unroll") for (int _i = 0; _i < 2; ++_i) \
        __builtin_amdgcn_global_load_lds((const unsigned*)((const char*)(gbase) + (voff)[_i]), (PG8_LAS unsigned*)(lds + (bufoff) + ldsw + _i * 8192), 16, 0, 0); } while (0)
#define PG8_LDA(dst, b, h) do { _Pragma("unroll") for (int m = 0; m < 4; ++m) _Pragma("unroll") for (int k = 0; k < 2; ++k) dst[m][k] = *(const PG8_LAS bf16x8*)(lds + PG8_SA(b, h) + aoff + m * 2048 + k * 1024); } while (0)
#define PG8_LDB(dst, b, h) do { _Pragma("unroll") for (int n = 0; n < 2; ++n) _Pragma("unroll") for (int k = 0; k < 2; ++k) dst[n][k] = *(const PG8_LAS bf16x8*)(lds + PG8_SB(b, h) + boff + n * 2048 + k * 1024); } while (0)
#define PG8_MMA(ai, bj, At, Bt) do { __builtin_amdgcn_s_setprio(1); _Pragma("unroll") for (int m = 0; m < 4; ++m) _Pragma("unroll") for (int n = 0; n < 2; ++n) _Pragma("unroll") for (int k = 0; k < 2; ++k) \
        acc[ai][bj][m][n] = __builtin_amdgcn_mfma_f32_16x16x32_bf16(Bt[n][k], At[m][k], acc[ai][bj][m][n], 0, 0, 0); __builtin_amdgcn_s_setprio(0); } while (0)
#define PG8_WAIT_V(n) asm volatile("s_waitcnt vmcnt(" #n ")" ::: "memory")
#define PG8_WAIT_L(n) asm volatile("s_waitcnt lgkmcnt(" #n ")" ::: "memory")
#define PG8_BAR __builtin_amdgcn_s_barrier()
#define PG8_SCHED __builtin_amdgcn_sched_barrier(0)
    Unit cur, nxt; int ui = 0;
    if (!S.next(0, cur)) return;
    f32x4 acc[2][2][4][2];
#pragma unroll
    for (int a = 0; a < 2; ++a)
#pragma unroll
        for (int b = 0; b < 2; ++b)
#pragma unroll
            for (int m = 0; m < 4; ++m)
#pragma unroll
                for (int n = 0; n < 2; ++n) acc[a][b][m][n] = (f32x4){0.f, 0.f, 0.f, 0.f};
    bf16x8 At[4][2], B0[2][2], B1[2][2];
    const char* cA = PG8_UA(cur); const char* cB = PG8_UB(cur);
    S.a_ready(cur);
    if constexpr (SP2) {
        PG8_STAGE(PG8_SB(0, 0), cB, voffB); PG8_STAGE(PG8_SB(0, 1), cB + hstepB, voffB); PG8_STAGE(PG8_SA(0, 0), cA, voffA); PG8_STAGE(PG8_SA(0, 1), cA + hstepA, voffA);
        if (wr == 1) PG8_BAR;
        PG8_WAIT_V(2); PG8_BAR;
        PG8_STAGE(PG8_SB(1, 0), cB + kstep, voffB); PG8_STAGE(PG8_SA(1, 0), cA + kstep, voffA); PG8_STAGE(PG8_SB(1, 1), cB + hstepB + kstep, voffB);
        PG8_WAIT_V(6); PG8_BAR;
    } else {
        PG8_STAGE(PG8_SB(0, 0), cB, voffB); PG8_STAGE(PG8_SA(0, 0), cA, voffA); PG8_STAGE(PG8_SB(0, 1), cB + hstepB, voffB); PG8_STAGE(PG8_SA(0, 1), cA + hstepA, voffA);
        if (wr == 1) PG8_BAR;
        PG8_WAIT_V(4); PG8_BAR;
        PG8_STAGE(PG8_SB(1, 0), cB + kstep, voffB); PG8_STAGE(PG8_SA(1, 0), cA + kstep, voffA); PG8_STAGE(PG8_SB(1, 1), cB + hstepB + kstep, voffB);
        PG8_WAIT_V(6); PG8_BAR;
    }
    for (;;) {
        const bool has_next = S.next(ui + 1, nxt);
        const char* nA = has_next ? PG8_UA(nxt) : cA; const char* nB = has_next ? PG8_UB(nxt) : cB;
        for (int t = 0; t < nt; t += 2) {
            const bool last = (t == nt - 2);
            const char* a1 = cA + (size_t)(t + 1) * kstep;
            const char* a2 = last ? nA : cA + (size_t)(t + 2) * kstep; const char* b2 = last ? nB : cB + (size_t)(t + 2) * kstep;
            const char* a3 = a2 + kstep; const char* b3 = b2 + kstep;
            if (last && has_next) S.a_ready(nxt);
            if constexpr (SP2) {
            PG8_LDB(B0, 0, 0); PG8_LDB(B1, 0, 1); PG8_SCHED; PG8_LDA(At, 0, 0); PG8_STAGE(PG8_SA(1, 1), a1 + hstepA, voffA);
            PG8_WAIT_V(8); PG8_WAIT_L(0); PG8_BAR; PG8_MMA(0, 0, At, B0); PG8_MMA(0, 1, At, B1); PG8_BAR; PG8_SCHED;
            PG8_LDA(At, 0, 1); PG8_STAGE(PG8_SB(0, 0), b2, voffB); PG8_STAGE(PG8_SB(0, 1), b2 + hstepB, voffB); PG8_STAGE(PG8_SA(0, 0), a2, voffA);
            PG8_WAIT_V(8); PG8_WAIT_L(0); PG8_BAR; PG8_MMA(1, 0, At, B0); PG8_MMA(1, 1, At, B1); PG8_BAR; PG8_SCHED;
            PG8_LDB(B0, 1, 0); PG8_LDB(B1, 1, 1); PG8_SCHED; PG8_LDA(At, 1, 0); PG8_STAGE(PG8_SA(0, 1), a2 + hstepA, voffA);
            PG8_WAIT_V(8); PG8_WAIT_L(0); PG8_BAR; PG8_MMA(0, 0, At, B0); PG8_MMA(0, 1, At, B1); PG8_BAR; PG8_SCHED;
            PG8_LDA(At, 1, 1); PG8_STAGE(PG8_SB(1, 0), b3, voffB); PG8_STAGE(PG8_SB(1, 1), b3 + hstepB, voffB); PG8_STAGE(PG8_SA(1, 0), a3, voffA);
            PG8_WAIT_V(8); PG8_WAIT_L(0); PG8_BAR; PG8_MMA(1, 0, At, B0); PG8_MMA(1, 1, At, B1); PG8_BAR; PG8_SCHED;
            } else {
            PG8_LDB(B0, 0, 0); PG8_SCHED; PG8_LDA(At, 0, 0); PG8_STAGE(PG8_SA(1, 1), a1 + hstepA, voffA);
            PG8_WAIT_L(8); PG8_BAR; PG8_WAIT_L(0); PG8_MMA(0, 0, At, B0); PG8_BAR; PG8_SCHED;
            PG8_LDB(B1, 0, 1); PG8_STAGE(PG8_SB(0, 0), b2, voffB);
            PG8_BAR; PG8_WAIT_L(0); PG8_MMA(0, 1, At, B1); PG8_BAR;
            PG8_LDA(At, 0, 1); PG8_STAGE(PG8_SA(0, 0), a2, voffA);
            PG8_BAR; PG8_WAIT_L(0); PG8_MMA(1, 0, At, B0); PG8_BAR; PG8_SCHED;
            PG8_STAGE(PG8_SB(0, 1), b2 + hstepB, voffB);
            PG8_WAIT_V(6); PG8_BAR; PG8_MMA(1, 1, At, B1); PG8_BAR;
            PG8_LDB(B0, 1, 0); PG8_SCHED; PG8_LDA(At, 1, 0); PG8_STAGE(PG8_SA(0, 1), a2 + hstepA, voffA);
            PG8_WAIT_L(8); PG8_BAR; PG8_WAIT_L(0); PG8_MMA(0, 0, At, B0); PG8_BAR; PG8_SCHED;
            PG8_LDB(B1, 1, 1); PG8_STAGE(PG8_SB(1, 0), b3, voffB);
            PG8_BAR; PG8_WAIT_L(0); PG8_MMA(0, 1, At, B1); PG8_BAR;
            PG8_LDA(At, 1, 1); PG8_STAGE(PG8_SA(1, 0), a3, voffA);
            PG8_BAR; PG8_WAIT_L(0); PG8_MMA(1, 0, At, B0); PG8_BAR; PG8_SCHED;
            PG8_STAGE(PG8_SB(1, 1), b3 + hstepB, voffB);
            PG8_WAIT_V(6); PG8_BAR; PG8_MMA(1, 1, At, B1); PG8_BAR;
            }
        }
        if constexpr (ALIGN_EPI) { if (wr == 0) PG8_BAR; }
        if constexpr (!Epi::AFTER_DRAIN) { E(acc, cur, wr, wc, fr, fq); S.done(cur); }
        if (!has_next) break;
#pragma unroll
        for (int a = 0; a < 2; ++a)
#pragma unroll
            for (int b = 0; b < 2; ++b)
#pragma unroll
                for (int m = 0; m < 4; ++m)
#pragma unroll
                    for (int n = 0; n < 2; ++n) acc[a][b][m][n] = (f32x4){0.f, 0.f, 0.f, 0.f};
        cur = nxt; cA = nA; cB = nB; ++ui;
        if constexpr (ALIGN_EPI) { if (wr == 1) PG8_BAR; }
    }
    PG8_WAIT_V(0);
    if constexpr (!ALIGN_EPI) { if (wr == 0) PG8_BAR; }
    PG8_BAR;
    if constexpr (Epi::AFTER_DRAIN) { E.fused(acc, cur, wr, wc, fr, fq, lds, wid, lane); S.done(cur); }
#undef PG8_UA
#undef PG8_UB
#undef PG8_SA
#undef PG8_SB
#undef PG8_STAGE
#undef PG8_LDA
#undef PG8_LDB
#undef PG8_MMA
#undef PG8_WAIT_V
#undef PG8_WAIT_L
#undef PG8_BAR
#undef PG8_SCHED
}
}
#define GAS __attribute__((address_space(1)))
#define LAS __attribute__((address_space(3)))
typedef unsigned short bf16;
typedef unsigned v4u __attribute__((ext_vector_type(4)));
typedef float f32x4 __attribute__((ext_vector_type(4)));
typedef short bf16x8 __attribute__((ext_vector_type(8)));
typedef GAS unsigned gu32;
typedef GAS unsigned long long gu64;
#define RLX_AGENT __ATOMIC_RELAXED, __HIP_MEMORY_SCOPE_AGENT
#define LDS_WAIT() asm volatile("s_waitcnt lgkmcnt(0)" ::: "memory")
#define VM_WAIT() asm volatile("s_waitcnt vmcnt(0)" ::: "memory")
__device__ __forceinline__ unsigned long long rt() { return __builtin_amdgcn_s_memrealtime(); }
__device__ __forceinline__ unsigned f2bf(float f) { unsigned u = __builtin_bit_cast(unsigned, f); return (u + 0x7fffu + ((u >> 16) & 1u)) >> 16; }
__device__ __forceinline__ unsigned pk2(float lo, float hi) { return f2bf(lo) | (f2bf(hi) << 16); }

#define XB_TMO      128
#define XB_XCNT(j)  (256  + 64 * (j))
#define XB_XSUB(j)  (1280 + 64 * (j))
#define XB_XGEN(j)  (2304 + 64 * (j))
#define XB_TOP      3328
#define XB_TOPGEN   3392
#define XCD_BAR_WORDS 3456
#define XB_SPIN_CAP (1u << 18)

__device__ __forceinline__ unsigned xb_ld(unsigned* p)              { return __hip_atomic_load(p, __ATOMIC_RELAXED, __HIP_MEMORY_SCOPE_AGENT); }
__device__ __forceinline__ unsigned xb_add(unsigned* p, unsigned v) { return __hip_atomic_fetch_add(p, v, __ATOMIC_RELAXED, __HIP_MEMORY_SCOPE_AGENT); }
__device__ __forceinline__ unsigned xb_xcc_id() { return (unsigned)__builtin_amdgcn_s_getreg((3 << 11) | 20) & 0xFu; }
#define XB_SPIN(cond, bar) do { unsigned _sp = 0; while (cond) { __builtin_amdgcn_s_sleep(1); \
    if ((++_sp & 255u) == 0u) { if (xb_ld(&(bar)[XB_TMO])) break; if (_sp > XB_SPIN_CAP) { atomicAdd(&(bar)[XB_TMO], 1u); break; } } } } while (0)

struct XcdBarrier {
    unsigned* bar; unsigned x;
    volatile LAS unsigned* st;
};

__device__ __forceinline__ XcdBarrier xcd_barrier_post(unsigned* bar, volatile LAS unsigned* st) {
    XcdBarrier b; b.bar = bar; b.x = xb_xcc_id(); b.st = st;
    if (threadIdx.x == 0) (void)xb_add(&bar[XB_XCNT(b.x)], 1u);
    return b;
}
__device__ __forceinline__ void xcd_barrier_complete(unsigned* bar, unsigned x, unsigned& nloc, unsigned& nx) {
    const unsigned G = gridDim.x * gridDim.y * gridDim.z;
    unsigned sum, cnt, mine, sp = 0u;
    for (;;) {
        sum = 0u; cnt = 0u; mine = 0u;
#pragma unroll
        for (unsigned j = 0; j < 16; ++j) { const unsigned c = xb_ld(&bar[XB_XCNT(j)]); sum += c; cnt += (c > 0u) ? 1u : 0u; mine = (j == x) ? c : mine; }
        if (sum == G) break;
        __builtin_amdgcn_s_sleep(1);
        if ((++sp & 255u) == 0u) { if (xb_ld(&bar[XB_TMO])) break; if (sp > XB_SPIN_CAP) { atomicAdd(&bar[XB_TMO], 1u); break; } }
    }
    nloc = mine > 0u ? mine : 1u; nx = cnt > 0u ? cnt : 1u;
}

__device__ __forceinline__ void xcd_barrier(const XcdBarrier& b) {
    asm volatile("s_waitcnt vmcnt(0)" ::: "memory");
    __syncthreads();
    if (threadIdx.x == 0) {
        unsigned* bar = b.bar;
        __builtin_amdgcn_s_waitcnt(0);
        unsigned nloc = b.st[0], nx = b.st[1];
        if (nloc == 0u) { xcd_barrier_complete(bar, b.x, nloc, nx); b.st[0] = nloc; b.st[1] = nx; }
        const unsigned old = xb_add(&bar[XB_XSUB(b.x)], 1u);
        const unsigned gen = old / nloc;
        if (old + 1u == (gen + 1u) * nloc) {
            __builtin_amdgcn_fence(__ATOMIC_RELEASE, "agent");
            asm volatile("s_waitcnt vmcnt(0)" ::: "memory");
            const unsigned og = xb_add(&bar[XB_TOP], 1u);
            const unsigned tg = og / nx;
            if (og + 1u == (tg + 1u) * nx) xb_add(&bar[XB_TOPGEN], 1u);
            else XB_SPIN(xb_ld(&bar[XB_TOPGEN]) == tg, bar);
            __builtin_amdgcn_fence(__ATOMIC_ACQUIRE, "agent");
            xb_add(&bar[XB_XGEN(b.x)], 1u);
            asm volatile("s_waitcnt vmcnt(0)" ::: "memory");
        } else {
            XB_SPIN(xb_ld(&bar[XB_XGEN(b.x)]) == gen, bar);
            __builtin_amdgcn_fence(__ATOMIC_ACQUIRE, "agent");
            asm volatile("s_waitcnt vmcnt(0)" ::: "memory");
        }
    }
    __syncthreads();
}
constexpr int NWAVES = 8;
constexpr int BATCH = 2, SEQ = 8192, D = 1024, M = BATCH * SEQ, DFF = 2816;
constexpr int NH = 8, DK = 128, CH = 64, NCHUNK = M / CH  , CPB = SEQ / CH  , NSEG = 16, CPS = 8  , NUNIT = BATCH * NH * NSEG  ;
constexpr int SCH = 128  , NSC = M / SCH  , SCPB = SEQ / SCH  ;
constexpr float EPS = 1e-6f;
constexpr size_t MiB = 1u << 20;
constexpr size_t WS_CTL = 0, CTL_ZERO_BYTES = 1 * MiB;
constexpr size_t WS_SSQ = 65536;
constexpr size_t WS_DEC = 2 * MiB;
constexpr size_t WS_TAB = 3 * MiB;
constexpr size_t WS_AP = 3 * MiB + 65536, WS_HE = WS_AP + 524288;
constexpr size_t WS_W_HIN = 5 * MiB, WS_W_HOUT = 13 * MiB, WS_W_LIN = 15 * MiB, WS_W_LOUT = 19 * MiB, WS_W_GATE = 21 * MiB;
constexpr size_t WS_W_FIN0 = 22 * MiB, WS_W_FIN1 = 33 * MiB, WS_W_FOUT0 = 44 * MiB, WS_W_FOUT1 = 44 * MiB + 5632 * 1024, WS_XB = 56 * MiB, WS_SLOC = 88 * MiB;
constexpr size_t WS_ACT = 104 * MiB;
constexpr size_t WS_QT = WS_ACT, WS_KT = WS_ACT + 32 * MiB, WS_V = WS_ACT + 64 * MiB, WS_SG = WS_ACT + 96 * MiB;
constexpr size_t WS_H = WS_ACT;
constexpr size_t WS_YG = WS_ACT, WS_U = WS_ACT + 32 * MiB, WS_UC = WS_ACT + 64 * MiB, WS_BI = WS_ACT + 96 * MiB;
constexpr size_t WS_END = WS_ACT + 128 * MiB;
static_assert(WS_W_FOUT1 + 5632 * 1024 <= WS_XB && WS_HE + 524288 <= WS_W_HIN && WS_END <= 256 * MiB, "d_ws map");
constexpr int CW_BAR = 4096;
constexpr int RING_BYTES = 131072, LDSCTL_OFF = RING_BYTES, MISC_OFF = LDSCTL_OFF + 320, LDS_BYTES = 147456;
using pg8::Unit;
typedef unsigned u32x2v __attribute__((ext_vector_type(2)));
__device__ __forceinline__ float bf2f(unsigned short h) { return __builtin_bit_cast(float, (unsigned)h << 16); }
__device__ __forceinline__ float fsigmoid(float x) { return __builtin_amdgcn_rcpf(1.0f + __expf(-x)); }
__device__ __forceinline__ float fsilu(float x) { return x * fsigmoid(x); }
__device__ __forceinline__ float row_rstd(const float* ssq, int row) { return __builtin_amdgcn_rsqf(ssq[row] * (1.0f / D) + EPS); }
__device__ __forceinline__ v4u pack8(const f32x4 a, const f32x4 b) { v4u w; w.x = pg8::cvt_pk_bf16(a[0], a[1]); w.y = pg8::cvt_pk_bf16(a[2], a[3]); w.z = pg8::cvt_pk_bf16(b[0], b[1]); w.w = pg8::cvt_pk_bf16(b[2], b[3]); return w; }
#define EPI_ROWS(...) _Pragma("unroll") for (int ai = 0; ai < 2; ++ai) _Pragma("unroll") for (int m = 0; m < 4; ++m) { const int row = u.pm * 256 + ai * 128 + wr * 64 + m * 16 + fr; __VA_ARGS__ }

#define EPI_RS(rs) float rs[2][4]; _Pragma("unroll") for (int ai = 0; ai < 2; ++ai) _Pragma("unroll") for (int m = 0; m < 4; ++m) rs[ai][m] = row_rstd(ssq, u.pm * 256 + ai * 128 + wr * 64 + m * 16 + fr);
struct EpiHgrnIn {
    static constexpr bool PERM = true, AFTER_DRAIN = false;
    const float* ssq; const float* lbv; const float* oml; bf16* QT; bf16* KT; bf16* V; bf16* SG; float* LF;
    __device__ __forceinline__ void operator()(const f32x4 (&acc)[2][2][4][2], const Unit& u, int wr, int wc, int fr, int fq) const {
        const int type = u.pn >> 2, cg = 256 * (u.pn & 3) + 32 * wc + 8 * fq;
        EPI_RS(rs)
        if (type == 1) {
            f32x4 lbq[2][2], omq[2][2];
#pragma unroll
            for (int bj = 0; bj < 2; ++bj)
#pragma unroll
                for (int n = 0; n < 2; ++n) { lbq[bj][n] = *(const f32x4*)(lbv + cg + 128 * bj + 4 * n); omq[bj][n] = *(const f32x4*)(oml + cg + 128 * bj + 4 * n); }
            EPI_ROWS(
                _Pragma("unroll") for (int bj = 0; bj < 2; ++bj) { const int col = cg + 128 * bj; f32x4 lf[2], kk[2];
                    _Pragma("unroll") for (int n = 0; n < 2; ++n) {
                        _Pragma("unroll") for (int i = 0; i < 4; ++i) { const float z = acc[ai][bj][m][n][i] * rs[ai][m]; const float e = __expf(-z), sg = __builtin_amdgcn_rcpf(1.0f + e);
                            const float f = lbq[bj][n][i] + omq[bj][n][i] * sg; lf[n][i] = __logf(f); kk[n][i] = omq[bj][n][i] * (e * sg); } }
                    *(f32x4*)(LF + (unsigned)row * D + col) = lf[0]; *(f32x4*)(LF + (unsigned)row * D + col + 4) = lf[1];
                    *(v4u*)(KT + (unsigned)row * D + col) = pack8(kk[0], kk[1]); })
        } else {
            bf16* O = QT + (size_t)type * (16u << 20); const bool act = type != 2;
            EPI_ROWS(
                _Pragma("unroll") for (int bj = 0; bj < 2; ++bj) { const int col = cg + 128 * bj; f32x4 o[2];
                    _Pragma("unroll") for (int n = 0; n < 2; ++n) _Pragma("unroll") for (int i = 0; i < 4; ++i) { const float z = acc[ai][bj][m][n][i] * rs[ai][m]; o[n][i] = act ? fsilu(z) : z; }
                    *(v4u*)(O + (unsigned)row * D + col) = pack8(o[0], o[1]); })
        }
    }
};
struct EpiRes {
    static constexpr bool PERM = true, AFTER_DRAIN = false;
    const float* base; float* out; bf16* xb; float* ssq;
    __device__ __forceinline__ void operator()(const f32x4 (&acc)[2][2][4][2], const Unit& u, int wr, int wc, int fr, int fq) const {
        const int c0 = 256 * u.pn + 32 * wc + 8 * fq;
#pragma unroll
        for (int ai = 0; ai < 2; ++ai) {
            f32x4 pre[4][2][2];
#pragma unroll
            for (int m = 0; m < 4; ++m)
#pragma unroll
                for (int bj = 0; bj < 2; ++bj) { const unsigned off = (unsigned)(u.pm * 256 + ai * 128 + wr * 64 + m * 16 + fr) * D + c0 + 128 * bj;
                    pre[m][bj][0] = *(const f32x4*)(base + off); pre[m][bj][1] = *(const f32x4*)(base + off + 4); }
#pragma unroll
            for (int m = 0; m < 4; ++m) { const int row = u.pm * 256 + ai * 128 + wr * 64 + m * 16 + fr; float ss = 0.f;
#pragma unroll
                for (int bj = 0; bj < 2; ++bj) { const unsigned off = (unsigned)row * D + c0 + 128 * bj;
                    const f32x4 v0 = pre[m][bj][0] + acc[ai][bj][m][0], v1 = pre[m][bj][1] + acc[ai][bj][m][1];
                    *(f32x4*)(out + off) = v0; *(f32x4*)(out + off + 4) = v1; *(v4u*)(xb + off) = pack8(v0, v1);
                    ss += ((v0[0] * v0[0] + v0[1] * v0[1]) + (v0[2] * v0[2] + v0[3] * v0[3])) + ((v1[0] * v1[0] + v1[1] * v1[1]) + (v1[2] * v1[2] + v1[3] * v1[3])); }
                ss += __shfl_xor(ss, 16); ss += __shfl_xor(ss, 32);
                if (fq == 0) atomicAdd(ssq + row, ss); }
        }
    }
};
struct EpiFfnIn {
    static constexpr bool PERM = true, AFTER_DRAIN = false;
    const float* ssq; bf16* H;
    __device__ __forceinline__ void operator()(const f32x4 (&acc)[2][2][4][2], const Unit& u, int wr, int wc, int fr, int fq) const {
        const int c0 = 128 * u.pn + 32 * wc + 8 * fq;
        EPI_RS(rs)
        EPI_ROWS(f32x4 o[2];
            _Pragma("unroll") for (int n = 0; n < 2; ++n) _Pragma("unroll") for (int i = 0; i < 4; ++i) { const float g = acc[ai][0][m][n][i] * rs[ai][m], up = acc[ai][1][m][n][i] * rs[ai][m]; o[n][i] = fsilu(g) * up; }
            *(v4u*)(H + (unsigned)row * DFF + c0) = pack8(o[0], o[1]);)
    }
};
struct EpiLruIn {
    static constexpr bool PERM = true, AFTER_DRAIN = false;
    const float* ssq; bf16* YG; bf16* U;
    __device__ __forceinline__ void operator()(const f32x4 (&acc)[2][2][4][2], const Unit& u, int wr, int wc, int fr, int fq) const {
        const int cg = 256 * (u.pn & 3) + 32 * wc + 8 * fq;
        EPI_RS(rs)
        if (u.pn < 4) {
            EPI_ROWS(
                _Pragma("unroll") for (int bj = 0; bj < 2; ++bj) { f32x4 o[2];
                    _Pragma("unroll") for (int n = 0; n < 2; ++n) _Pragma("unroll") for (int i = 0; i < 4; ++i) { const float z = acc[ai][bj][m][n][i] * rs[ai][m];
                        o[n][i] = z * fsigmoid(1.5957691216057308f * (z + 0.044715f * z * z * z)); }
                    *(v4u*)(YG + (unsigned)row * D + cg + 128 * bj) = pack8(o[0], o[1]); })
        } else {
            EPI_ROWS(
                _Pragma("unroll") for (int bj = 0; bj < 2; ++bj)
                    *(v4u*)(U + (unsigned)row * D + cg + 128 * bj) = pack8(acc[ai][bj][m][0] * rs[ai][m], acc[ai][bj][m][1] * rs[ai][m]);)
        }
    }
};
struct EpiGates {
    static constexpr bool PERM = true, AFTER_DRAIN = false;
    const float* ba; const float* bx; const float* sp8  ; const bf16* UC; _Float16* LA; bf16* BI;
    __device__ __forceinline__ void operator()(const f32x4 (&acc)[2][2][4][2], const Unit& u, int wr, int wc, int fr, int fq) const {
        const int c0 = 128 * u.pn + 32 * wc + 8 * fq;
#pragma unroll
        for (int ai = 0; ai < 2; ++ai) {
            v4u uwq[4];
#pragma unroll
            for (int m = 0; m < 4; ++m) uwq[m] = *(const v4u*)(UC + (unsigned)(u.pm * 256 + ai * 128 + wr * 64 + m * 16 + fr) * D + c0);
#pragma unroll
            for (int n = 0; n < 2; ++n) { const f32x4 bav = *(const f32x4*)(ba + c0 + 4 * n), bxv = *(const f32x4*)(bx + c0 + 4 * n), spv = *(const f32x4*)(sp8 + c0 + 4 * n);
#pragma unroll
                for (int m = 0; m < 4; ++m) { const int row = u.pm * 256 + ai * 128 + wr * 64 + m * 16 + fr; f32x4 bi; typedef _Float16 h4 __attribute__((ext_vector_type(4))); h4 hv;
#pragma unroll
                    for (int i = 0; i < 4; ++i) { const unsigned w32 = uwq[m][2 * n + (i >> 1)]; const float ucv = __builtin_bit_cast(float, (i & 1) ? (w32 & 0xffff0000u) : (w32 << 16));
                        const float r = fsigmoid(acc[ai][0][m][n][i] + bav[i]), ig = fsigmoid(acc[ai][1][m][n][i] + bxv[i]);
                        const float lg = spv[i] * r, x = 2.0f * lg;
                        const float em = -x * (1.0f + x * (0.5f + x * (0.16666667f + x * (0.041666668f + x * (0.0083333338f + x * 0.0013888889f)))));
                        hv[i] = (_Float16)lg; bi[i] = __builtin_amdgcn_sqrtf(fmaxf(em, 0.0f)) * (ig * ucv); }
                    *(h4*)(LA + (unsigned)row * D + c0 + 4 * n) = hv;
                    u32x2v pk; pk.x = pg8::cvt_pk_bf16(bi[0], bi[1]); pk.y = pg8::cvt_pk_bf16(bi[2], bi[3]);
                    *(u32x2v*)(BI + (unsigned)row * D + c0 + 4 * n) = pk; } }
        }
    }
};
struct EpiNull {
    static constexpr bool PERM = true, AFTER_DRAIN = false;
    __device__ __forceinline__ void operator()(const f32x4 (&acc)[2][2][4][2], const Unit& u, int wr, int wc, int fr, int fq) const {
#pragma unroll
        for (int ai = 0; ai < 2; ++ai)
#pragma unroll
            for (int bj = 0; bj < 2; ++bj)
#pragma unroll
                for (int m = 0; m < 4; ++m)
#pragma unroll
                    for (int n = 0; n < 2; ++n) asm volatile("" :: "v"(acc[ai][bj][m][n]));
    }
};

template <int MODE> struct EpiFfnX {
    static constexpr bool PERM = true, AFTER_DRAIN = false;
    const float* ssq; bf16* H;
    __device__ __forceinline__ void operator()(const f32x4 (&acc)[2][2][4][2], const Unit& u, int wr, int wc, int fr, int fq) const {
        const int c0 = 128 * u.pn + 32 * wc + 8 * fq;
        float rs[2][4];
#pragma unroll
        for (int ai = 0; ai < 2; ++ai)
#pragma unroll
            for (int m = 0; m < 4; ++m) rs[ai][m] = MODE == 2 ? 1.0f : row_rstd(ssq, u.pm * 256 + ai * 128 + wr * 64 + m * 16 + fr);
        EPI_ROWS(f32x4 o[2];
            _Pragma("unroll") for (int n = 0; n < 2; ++n) _Pragma("unroll") for (int i = 0; i < 4; ++i) { const float g = acc[ai][0][m][n][i] * rs[ai][m], up = acc[ai][1][m][n][i] * rs[ai][m]; o[n][i] = MODE == 3 ? g + up : fsilu(g) * up; }
            const v4u w = pack8(o[0], o[1]);
            if (MODE == 1) asm volatile("" :: "v"(w)); else *(v4u*)(H + (unsigned)row * DFF + c0) = w;)
    }
};
typedef short s16x4 __attribute__((ext_vector_type(4)));
struct Args { const float* in[19]; float* out; unsigned char* ws; int ph_lo, ph_hi; };
static_assert(sizeof(Args) == 19 * 8 + 8 + 8 + 8, "Args has no padding");
__device__ __forceinline__ LAS unsigned char* lds_base() { extern __shared__ __attribute__((aligned(16))) unsigned char lds_dyn[]; return (LAS unsigned char*)lds_dyn; }
#define TID ((int)threadIdx.x)
#define LANE (TID & 63)
#define WAVE (__builtin_amdgcn_readfirstlane(TID >> 6))
#define GSZ ((int)gridDim.x)
#define VCU ((GSZ % 8 == 0) ? ((int)blockIdx.x % 8) * (GSZ / 8) + (int)blockIdx.x / 8 : (int)blockIdx.x)
#define LDSB (lds_base())
#define WSP(T, off) ((T*)(F.ws + (off)))
__device__ __forceinline__ float wave_sum(float v) {
#pragma unroll
    for (int o = 1; o < 64; o <<= 1) v += __shfl_xor(v, o);
    return v;
}
__device__ __forceinline__ void tr_item(const float* W, int ldw, int k0, int ns0, bf16* WT, int ldt, int drow0, const float* ksc, LAS float* scr, int lane) {
#pragma unroll 8
    for (int i = 0; i < 32; ++i) { const int kk = 2 * i + (lane >> 5); float w = W[(size_t)(k0 + kk) * ldw + ns0 + (lane & 31)]; if (ksc) w *= ksc[k0 + kk]; scr[kk * 33 + (lane & 31)] = w; }
    LDS_WAIT(); asm volatile("" ::: "memory");
    const int c = lane & 7;
#pragma unroll
    for (int j = 0; j < 4; ++j) { const int n = (lane >> 3) + 8 * j; const LAS float* s = scr + (8 * c) * 33 + n;
        v4u o; o.x = pk2(s[0 * 33], s[1 * 33]); o.y = pk2(s[2 * 33], s[3 * 33]); o.z = pk2(s[4 * 33], s[5 * 33]); o.w = pk2(s[6 * 33], s[7 * 33]);
        *(GAS v4u*)(WT + (size_t)(drow0 + n) * ldt + k0 + 8 * c) = o; }
    LDS_WAIT(); asm volatile("" ::: "memory");
}
__device__ __forceinline__ void p0_prologue(const Args& F) {
    LAS float* scr = (LAS float*)(LDSB + WAVE * 16384);
    const int gw = VCU * NWAVES + WAVE, NGW = GSZ * NWAVES, lane = LANE;
    constexpr int I_A = 16 * 128, I_B = 16 * 32, I_C = 16 * 64, I_D = 16 * 32, I_E = 256, I_F = 16 * 176, I_G = 44 * 32;
    constexpr int NITEMS = I_A + I_B + I_C + I_D + I_E + 2 * I_F + 2 * I_G;
    for (int it = gw; it < NITEMS; it += NGW) {
        int r = it;
        if (r < I_A) { const int kb = r / 128, nb = r % 128; tr_item(F.in[4], 4096, 64 * kb, 32 * nb, WSP(bf16, WS_W_HIN), 1024, 32 * nb, F.in[1], scr, lane); continue; } r -= I_A;
        if (r < I_B) { const int kb = r / 32, nb = r % 32; tr_item(F.in[7], 1024, 64 * kb, 32 * nb, WSP(bf16, WS_W_HOUT), 1024, 32 * nb, nullptr, scr, lane); continue; } r -= I_B;
        if (r < I_C) { const int kb = r / 64, nb = r % 64; tr_item(F.in[8], 2048, 64 * kb, 32 * nb, WSP(bf16, WS_W_LIN), 1024, 32 * nb, F.in[1] + 1024, scr, lane); continue; } r -= I_C;
        if (r < I_D) { const int kb = r / 32, nb = r % 32; tr_item(F.in[16], 1024, 64 * kb, 32 * nb, WSP(bf16, WS_W_LOUT), 1024, 32 * nb, nullptr, scr, lane); continue; } r -= I_D;
        if (r < I_E) { const int isx = r >> 7, n = (r >> 5) & 3, kb = (r >> 3) & 3, nb = r & 7; const int ch0 = 256 * n + 32 * nb;
            tr_item((isx ? F.in[13] : F.in[11]) + (size_t)n * 65536, 256, 64 * kb, 32 * nb, WSP(bf16, WS_W_GATE), 256, 256 * (ch0 >> 7) + (ch0 & 127) + 128 * isx, nullptr, scr, lane); continue; } r -= I_E;
        if (r < 2 * I_F) { const int l = r / I_F, q = r % I_F, kb = q / 176, nb = q % 176, isup = nb >= 88 ? 1 : 0, j0 = 32 * (nb - 88 * isup);
            tr_item(F.in[17] + (size_t)l * 1024 * 5632, 5632, 64 * kb, 32 * nb, WSP(bf16, l ? WS_W_FIN1 : WS_W_FIN0), 1024, 256 * (j0 >> 7) + (j0 & 127) + 128 * isup, F.in[2] + l * 1024, scr, lane); continue; } r -= 2 * I_F;
        { const int l = r / I_G, q = r % I_G, kb = q / 32, nb = q % 32;
            tr_item(F.in[18] + (size_t)l * 2816 * 1024, 1024, 64 * kb, 32 * nb, WSP(bf16, l ? WS_W_FOUT1 : WS_W_FOUT0), 2816, 32 * nb, nullptr, scr, lane); }
    }
    for (int m = gw; m < M; m += NGW) {
        const GAS f32x4* xr = (const GAS f32x4*)(F.in[0] + (size_t)m * D) + lane; f32x4 v[4]; float s = 0.f;
#pragma unroll
        for (int j = 0; j < 4; ++j) { v[j] = xr[64 * j]; s += (v[j].x * v[j].x + v[j].y * v[j].y) + (v[j].z * v[j].z + v[j].w * v[j].w); }
        s = wave_sum(s);
        GAS unsigned long long* o8 = (GAS unsigned long long*)(WSP(bf16, WS_XB) + (size_t)m * D) + lane;
#pragma unroll
        for (int j = 0; j < 4; ++j) o8[64 * j] = (unsigned long long)pk2(v[j].x, v[j].y) | ((unsigned long long)pk2(v[j].z, v[j].w) << 32);
        if (lane == 0) WSP(float, WS_SSQ)[m] = s;
    }
    { const int g = blockIdx.x * (NWAVES * 64) + TID; if (g < 1024) { const float l0 = F.in[5][g], l1 = F.in[5][1024 + g];
        WSP(float, WS_TAB)[g] = __builtin_amdgcn_rcpf(1.0f + __expf(l1 - l0)); WSP(float, WS_TAB)[1024 + g] = __builtin_amdgcn_rcpf(1.0f + __expf(l0 - l1));
        WSP(float, WS_TAB)[2048 + g] = -8.0f * log1pf(__expf(-F.in[15][g])); } }
}
__device__ __forceinline__ void hgrn_prep(const Args& F) {
    bf16* QT = WSP(bf16, WS_QT); bf16* KT = WSP(bf16, WS_KT); const float* LF = F.out; float* DEC = WSP(float, WS_DEC);
    for (int idx = blockIdx.x * (NWAVES * 64) + TID; idx < NCHUNK * 1024; idx += GSZ * NWAVES * 64) {
        const int c = idx >> 10, col = idx & 1023; float b = 0.f; size_t off = (size_t)c * CH * D + col;
#pragma unroll 8
        for (int s = 0; s < CH; ++s, off += D) { b += LF[off]; const float eb = __expf(b), enb = __expf(-b);
            QT[off] = (bf16)f2bf(bf2f(QT[off]) * eb); KT[off] = (bf16)f2bf(bf2f(KT[off]) * enb); }
        DEC[idx] = __expf(b);
    }
}
constexpr int TP = 272  , AP_ = 144  ;
constexpr int L_Q = 0, L_K = 17408, L_V = 34816, L_A = 52224, L_ST = 61440, L_RS = 96256;
__device__ __forceinline__ void stage_tile(LAS unsigned char* img, const bf16* src, int tid) {
#pragma unroll
    for (int i = 0; i < 2; ++i) { const int piece = tid + 512 * i, row = piece >> 4, pc = piece & 15;
        const v4u x = *(const GAS v4u*)(src + (size_t)row * D + pc * 8); *(LAS v4u*)(img + row * TP + pc * 16) = x; }
}
__device__ __forceinline__ bf16x8 frag_row(const LAS unsigned char* img, int pitch, int row0, int k0, int fr, int fq) {
    return *(const LAS bf16x8*)(img + (row0 + fr) * pitch + (k0 + 8 * fq) * 2);
}
__device__ __forceinline__ bf16x8 frag_tr(const LAS unsigned char* img, int pitch, int n0, int k0, int fr, int fq) {
    const int q = fr >> 2, p = fr & 3;
    const s16x4 lo = __builtin_amdgcn_ds_read_tr16_b64_v4i16((LAS s16x4*)(img + (k0 + 8 * fq + q) * pitch + (n0 + 4 * p) * 2));
    const s16x4 hi = __builtin_amdgcn_ds_read_tr16_b64_v4i16((LAS s16x4*)(img + (k0 + 8 * fq + 4 + q) * pitch + (n0 + 4 * p) * 2));
    return __builtin_shufflevector(lo, hi, 0, 1, 2, 3, 4, 5, 6, 7);
}
#define MFMA16(a, b, c) __builtin_amdgcn_mfma_f32_16x16x32_bf16((a), (b), (c), 0, 0, 0)
__device__ __forceinline__ void state_update(f32x4 (&S)[8], const LAS unsigned char* Ki, const LAS unsigned char* Vi, const float* decp, int w, int fr, int fq) {
#pragma unroll
    for (int ks = 0; ks < 2; ++ks) { const bf16x8 X = frag_tr(Ki, TP, 16 * w, 32 * ks, fr, fq);
#pragma unroll
        for (int vb = 0; vb < 8; ++vb) S[vb] = MFMA16(X, frag_tr(Vi, TP, 16 * vb, 32 * ks, fr, fq), S[vb]); }
    const f32x4 dv = *(const f32x4*)(decp + 16 * w + 4 * fq);
#pragma unroll
    for (int vb = 0; vb < 8; ++vb) S[vb] = S[vb] * dv;
}
__device__ __forceinline__ void hgrn_seg_state(const Args& F) {
    LAS unsigned char* Ki = LDSB + L_K; LAS unsigned char* Vi = LDSB + L_V;
    const int w = WAVE, fr = LANE & 15, fq = LANE >> 4;
    for (int unit = VCU; unit < NUNIT; unit += GSZ) {
        const int b = unit / (NH * NSEG), h = (unit / NSEG) % NH, seg = unit % NSEG;
        f32x4 S[8];
#pragma unroll
        for (int vb = 0; vb < 8; ++vb) S[vb] = (f32x4){0.f, 0.f, 0.f, 0.f};
        for (int c = 0; c < CPS; ++c) {
            const int cg = b * CPB + seg * CPS + c; const size_t r0 = (size_t)cg * CH;
            __syncthreads();
            stage_tile(Ki, WSP(bf16, WS_KT) + r0 * D + h * DK, TID); stage_tile(Vi, WSP(bf16, WS_V) + r0 * D + h * DK, TID);
            __syncthreads();
            state_update(S, Ki, Vi, WSP(float, WS_DEC) + (size_t)cg * D + h * DK, w, fr, fq);
        }
        float* sl = WSP(float, WS_SLOC) + (size_t)unit * 16384;
#pragma unroll
        for (int vb = 0; vb < 8; ++vb)
#pragma unroll
            for (int r = 0; r < 4; ++r) sl[(16 * w + 4 * fq + r) * 128 + 16 * vb + fr] = S[vb][r];
    }
}
__device__ __forceinline__ void hgrn_seg_scan(const Args& F) {
    float* SL = WSP(float, WS_SLOC); const float* DEC = WSP(float, WS_DEC);
    for (int idx = blockIdx.x * (NWAVES * 64) + TID; idx < BATCH * NH * 16384; idx += GSZ * NWAVES * 64) {
        const int bh = idx >> 14, kv = idx & 16383, k = kv >> 7, b = bh / NH, h = bh % NH; float S = 0.f;
        for (int seg = 0; seg < NSEG; ++seg) { float* p = SL + ((size_t)(bh * NSEG + seg) << 14) + kv; const float t = *p; *p = S;
            float dsg = 1.f; const float* dp = DEC + (size_t)(b * CPB + seg * CPS) * D + h * DK + k;
#pragma unroll
            for (int c = 0; c < CPS; ++c) dsg *= dp[(size_t)c * D];
            S = dsg * S + t; }
    }
}
__device__ __forceinline__ void hgrn_out(const Args& F) {
    LAS unsigned char* Qi = LDSB + L_Q; LAS unsigned char* Ki = LDSB + L_K; LAS unsigned char* Vi = LDSB + L_V; LAS unsigned char* Ai = LDSB + L_A; LAS unsigned char* STi = LDSB + L_ST;
    LAS float* RS = (LAS float*)(LDSB + L_RS);
    const int w = WAVE, fr = LANE & 15, fq = LANE >> 4, tb = w & 3, wh = w >> 2;
    const float* nw = F.in[6];
    for (int unit = VCU; unit < NUNIT; unit += GSZ) {
        const int b = unit / (NH * NSEG), h = (unit / NSEG) % NH, seg = unit % NSEG;
        f32x4 S[8];
        { const float* sl = WSP(float, WS_SLOC) + (size_t)unit * 16384;
#pragma unroll
          for (int vb = 0; vb < 8; ++vb)
#pragma unroll
            for (int r = 0; r < 4; ++r) S[vb][r] = sl[(16 * w + 4 * fq + r) * 128 + 16 * vb + fr]; }
        __syncthreads();
#pragma unroll
        for (int vb = 0; vb < 8; ++vb) { u32x2v pk; pk.x = pg8::cvt_pk_bf16(S[vb][0], S[vb][1]); pk.y = pg8::cvt_pk_bf16(S[vb][2], S[vb][3]);
            *(LAS u32x2v*)(STi + (16 * vb + fr) * TP + (16 * w + 4 * fq) * 2) = pk; }
        for (int c = 0; c < CPS; ++c) {
            const int cg = b * CPB + seg * CPS + c; const size_t r0 = (size_t)cg * CH;
            bf16* qg = WSP(bf16, WS_QT) + r0 * D + h * DK;
            stage_tile(Qi, qg, TID); stage_tile(Ki, WSP(bf16, WS_KT) + r0 * D + h * DK, TID); stage_tile(Vi, WSP(bf16, WS_V) + r0 * D + h * DK, TID);
            __syncthreads();
            bf16x8 Yq[4];
#pragma unroll
            for (int ks = 0; ks < 4; ++ks) Yq[ks] = frag_row(Qi, TP, 16 * tb, 32 * ks, fr, fq);
#pragma unroll
            for (int sbi = 0; sbi < 2; ++sbi) { const int sb = 2 * wh + sbi; f32x4 a = (f32x4){0.f, 0.f, 0.f, 0.f};
                if (sb <= tb) {
#pragma unroll
                    for (int ks = 0; ks < 4; ++ks) a = MFMA16(frag_row(Ki, TP, 16 * sb, 32 * ks, fr, fq), Yq[ks], a);
                }
                const int t = 16 * tb + fr, s0 = 16 * sb + 4 * fq;
#pragma unroll
                for (int r = 0; r < 4; ++r) a[r] = (s0 + r <= t) ? a[r] : 0.f;
                u32x2v pk; pk.x = pg8::cvt_pk_bf16(a[0], a[1]); pk.y = pg8::cvt_pk_bf16(a[2], a[3]);
                *(LAS u32x2v*)(Ai + t * AP_ + s0 * 2) = pk; }
            __syncthreads();
            bf16x8 Ya[2];
#pragma unroll
            for (int ks = 0; ks < 2; ++ks) Ya[ks] = frag_row(Ai, AP_, 16 * tb, 32 * ks, fr, fq);
            f32x4 o[4]; float ssq = 0.f;
#pragma unroll
            for (int j = 0; j < 4; ++j) { const int vb = 4 * wh + j; f32x4 a = (f32x4){0.f, 0.f, 0.f, 0.f};
#pragma unroll
                for (int ks = 0; ks < 4; ++ks) a = MFMA16(frag_row(STi, TP, 16 * vb, 32 * ks, fr, fq), Yq[ks], a);
#pragma unroll
                for (int ks = 0; ks < 2; ++ks) a = MFMA16(frag_tr(Vi, TP, 16 * vb, 32 * ks, fr, fq), Ya[ks], a);
                o[j] = a; ssq += (a[0] * a[0] + a[1] * a[1]) + (a[2] * a[2] + a[3] * a[3]); }
            ssq += __shfl_xor(ssq, 16); ssq += __shfl_xor(ssq, 32);
            if (fq == 0) RS[(16 * tb + fr) * 2 + wh] = ssq;
            state_update(S, Ki, Vi, WSP(float, WS_DEC) + (size_t)cg * D + h * DK, w, fr, fq);
            __syncthreads();
            { const int t = 16 * tb + fr; const float rstd = __builtin_amdgcn_rsqf((RS[t * 2] + RS[t * 2 + 1]) * (1.0f / DK) + EPS);
              const bf16* sgp = WSP(bf16, WS_SG) + (r0 + t) * D + h * DK;
#pragma unroll
              for (int j = 0; j < 4; ++j) { const int v0 = 16 * (4 * wh + j) + 4 * fq; const u32x2v sgw = *(const GAS u32x2v*)(sgp + v0); const f32x4 nv = *(const f32x4*)(nw + v0);
                  const float g0 = __builtin_bit_cast(float, sgw.x << 16), g1 = __builtin_bit_cast(float, sgw.x & 0xffff0000u), g2 = __builtin_bit_cast(float, sgw.y << 16), g3 = __builtin_bit_cast(float, sgw.y & 0xffff0000u);
                  u32x2v pk; pk.x = pg8::cvt_pk_bf16(o[j][0] * rstd * nv[0] * g0, o[j][1] * rstd * nv[1] * g1); pk.y = pg8::cvt_pk_bf16(o[j][2] * rstd * nv[2] * g2, o[j][3] * rstd * nv[3] * g3);
                  *(GAS u32x2v*)(qg + (size_t)t * D + v0) = pk; } }
#pragma unroll
            for (int vb = 0; vb < 8; ++vb) { u32x2v pk; pk.x = pg8::cvt_pk_bf16(S[vb][0], S[vb][1]); pk.y = pg8::cvt_pk_bf16(S[vb][2], S[vb][3]);
                *(LAS u32x2v*)(STi + (16 * vb + fr) * TP + (16 * w + 4 * fq) * 2) = pk; }
            __syncthreads();
        }
    }
}
__device__ __forceinline__ void lru_conv(const Args& F) {
    const bf16* U = WSP(bf16, WS_U); bf16* UC = WSP(bf16, WS_UC); const float* cw = F.in[9]; const float* cb = F.in[10];
    for (int idx = blockIdx.x * (NWAVES * 64) + TID; idx < M * (D / 8); idx += GSZ * NWAVES * 64) {
        const int row = idx >> 7, c0 = (idx & 127) * 8, t = row & (SEQ - 1); float a[8];
#pragma unroll
        for (int j = 0; j < 8; ++j) a[j] = cb[c0 + j];
#pragma unroll
        for (int tap = 0; tap < 4; ++tap) { const int dt = 3 - tap; if (t - dt >= 0) { const v4u uw = *(const GAS v4u*)(U + (size_t)(row - dt) * D + c0);
#pragma unroll
            for (int j = 0; j < 8; ++j) { const unsigned w32 = uw[j >> 1]; const float uv = __builtin_bit_cast(float, (j & 1) ? (w32 & 0xffff0000u) : (w32 << 16)); a[j] += uv * cw[tap * D + c0 + j]; } } }
        v4u o; o.x = pk2(a[0], a[1]); o.y = pk2(a[2], a[3]); o.z = pk2(a[4], a[5]); o.w = pk2(a[6], a[7]);
        *(GAS v4u*)(UC + (size_t)row * D + c0) = o;
    }
}
__device__ __forceinline__ void lru_scan_local(const Args& F) {
    const _Float16* LA = WSP(_Float16, WS_U); const bf16* BI = WSP(bf16, WS_BI); float* AP = WSP(float, WS_AP); float* HE = WSP(float, WS_HE);
    for (int idx = blockIdx.x * (NWAVES * 64) + TID; idx < NSC * D; idx += GSZ * NWAVES * 64) {
        const int sc = idx >> 10, ch = idx & 1023; size_t off = (size_t)sc * SCH * D + ch; float h = 0.f, sl = 0.f;
#pragma unroll 8
        for (int r = 0; r < SCH; ++r, off += D) { const float la = (float)LA[off]; h = __expf(la) * h + bf2f(BI[off]); sl += la; }
        AP[idx] = __expf(sl); HE[idx] = h;
    }
}
__device__ __forceinline__ void lru_scan_apply(const Args& F) {
    const _Float16* LA = WSP(_Float16, WS_U); const bf16* BI = WSP(bf16, WS_BI); const bf16* YG = WSP(bf16, WS_YG); bf16* HY = WSP(bf16, WS_UC);
    const float* AP = WSP(float, WS_AP); const float* HE = WSP(float, WS_HE);
    for (int idx = blockIdx.x * (NWAVES * 64) + TID; idx < NSC * D; idx += GSZ * NWAVES * 64) {
        const int sc = idx >> 10, ch = idx & 1023, sc0 = (sc / SCPB) * SCPB; float h = 0.f;
        for (int j = sc0; j < sc; ++j) h = AP[j * D + ch] * h + HE[j * D + ch];
        size_t off = (size_t)sc * SCH * D + ch;
#pragma unroll 8
        for (int r = 0; r < SCH; ++r, off += D) { h = __expf((float)LA[off]) * h + bf2f(BI[off]); HY[off] = (bf16)f2bf(h * bf2f(YG[off])); }
    }
}
__device__ __forceinline__ void final_norm(const Args& F) {
    const int gw = VCU * NWAVES + WAVE, NGW = GSZ * NWAVES; const float* nf = F.in[3];
    for (int m = gw; m < M; m += NGW) { const float rs = row_rstd(WSP(float, WS_SSQ) + 4 * M, m); GAS f32x4* xr = (GAS f32x4*)(F.out + (size_t)m * D) + LANE;
#pragma unroll
        for (int j = 0; j < 4; ++j) { const f32x4 w = *((const f32x4*)nf + LANE + 64 * j); xr[64 * j] = xr[64 * j] * rs * w; } }
}
#ifndef MK_N_LAUNCHES
#define MK_N_LAUNCHES 1
#endif
constexpr int N_PHASES = 18;
#ifndef ONLY_PHASE
#define ONLY_PHASE -1
#endif
#ifndef EXTRA_PHASE
#define EXTRA_PHASE 0
#endif
#ifndef PROBE_MASK
#define PROBE_MASK 0u
#endif
#ifndef PROBE_MASK2
#define PROBE_MASK2 0u
#endif
#define GEMM_RUN(EPI, g, nM_, nN_, E) do { pg8::StaticOrder S_; S_.init(nM_, nN_, GSZ, (int)blockIdx.x); pg8::gemm_phase<EPI, pg8::StaticOrder, true, true>(LDSB, g, S_, E); } while (0)
__global__ void __launch_bounds__(NWAVES * 64, 2) trunk_fwd(Args args) {
    const Args& F = args;
    volatile LAS unsigned* MISC = (volatile LAS unsigned*)(LDSB + MISC_OFF);
    gu32* ctl = (gu32*)(args.ws + WS_CTL);
    for (int u = TID; u < (LDS_BYTES - LDSCTL_OFF) / 4; u += NWAVES * 64) ((LAS unsigned*)(LDSB + LDSCTL_OFF))[u] = 0u;
    __syncthreads();
    XcdBarrier bar; bar.bar = (unsigned*)(ctl + CW_BAR); bar.x = 0; bar.st = nullptr;
    if (MK_N_LAUNCHES == 1) bar = xcd_barrier_post((unsigned*)(ctl + CW_BAR), MISC + 8);
    const int lo = args.ph_lo, hi = args.ph_hi;
#define IN(k) ((ONLY_PHASE < 0 || ONLY_PHASE == (k)) && lo <= (k) && (k) < hi)
    unsigned long long tacc = 0ull, tacc2 = 0ull, tph = 0ull;
#define PB(k) do { if (((PROBE_MASK | PROBE_MASK2) >> (k)) & 1u) tph = rt(); } while (0)
#define SEAM(k) do { if (IN(k) && IN((k) + 1)) xcd_barrier(bar); if ((PROBE_MASK >> (k)) & 1u) tacc += rt() - tph; if ((PROBE_MASK2 >> (k)) & 1u) tacc2 += rt() - tph; } while (0)
    bf16* XB = WSP(bf16, WS_XB); float* SSQ = WSP(float, WS_SSQ);
    PB(0); if (IN(0)) { p0_prologue(F); } SEAM(0);
    PB(1); if (IN(1)) { pg8::Gemm g{XB, WSP(bf16, WS_W_HIN), D, D, D, 0};
        EpiHgrnIn E{SSQ, WSP(float, WS_TAB), WSP(float, WS_TAB) + 1024, WSP(bf16, WS_QT), WSP(bf16, WS_KT), WSP(bf16, WS_V), WSP(bf16, WS_SG), F.out};
        GEMM_RUN(EpiHgrnIn, g, M / 256, 16, E); } SEAM(1);
    PB(2); if (IN(2)) { hgrn_prep(F); } SEAM(2);
    PB(3); if (IN(3)) { hgrn_seg_state(F); } SEAM(3);
    PB(4); if (IN(4)) { hgrn_seg_scan(F); } SEAM(4);
    PB(5); if (IN(5)) { hgrn_out(F); } SEAM(5);
    PB(6); if (IN(6)) { pg8::Gemm g{WSP(bf16, WS_QT), WSP(bf16, WS_W_HOUT), D, D, D, 0}; EpiRes E{F.in[0], F.out, XB, SSQ + M}; GEMM_RUN(EpiRes, g, M / 256, 4, E); } SEAM(6);
    PB(7); if (IN(7)) { pg8::Gemm g{XB, WSP(bf16, WS_W_FIN0), D, D, D, 0}; EpiFfnIn E{SSQ + M, WSP(bf16, WS_H)}; GEMM_RUN(EpiFfnIn, g, M / 256, 22, E); } SEAM(7);
    PB(8); if (IN(8)) { pg8::Gemm g{WSP(bf16, WS_H), WSP(bf16, WS_W_FOUT0), DFF, DFF, DFF, 0}; EpiRes E{F.out, F.out, XB, SSQ + 2 * M}; GEMM_RUN(EpiRes, g, M / 256, 4, E); } SEAM(8);
    PB(9); if (IN(9)) { pg8::Gemm g{XB, WSP(bf16, WS_W_LIN), D, D, D, 0}; EpiLruIn E{SSQ + 2 * M, WSP(bf16, WS_YG), WSP(bf16, WS_U)}; GEMM_RUN(EpiLruIn, g, M / 256, 8, E); } SEAM(9);
    PB(10); if (IN(10)) { lru_conv(F); } SEAM(10);
    PB(11); if (IN(11)) { int kg = 256; asm volatile("" : "+s"(kg));
        pg8::Gemm g{WSP(bf16, WS_UC), WSP(bf16, WS_W_GATE), D, 256, kg, 1};
        EpiGates E{F.in[12], F.in[14], WSP(float, WS_TAB) + 2048, WSP(bf16, WS_UC), WSP(_Float16, WS_U), WSP(bf16, WS_BI)}; GEMM_RUN(EpiGates, g, M / 256, 8, E); } SEAM(11);
    PB(12); if (IN(12)) { lru_scan_local(F); } SEAM(12);
    PB(13); if (IN(13)) { lru_scan_apply(F); } SEAM(13);
    PB(14); if (IN(14)) { pg8::Gemm g{WSP(bf16, WS_UC), WSP(bf16, WS_W_LOUT), D, D, D, 0}; EpiRes E{F.out, F.out, XB, SSQ + 3 * M}; GEMM_RUN(EpiRes, g, M / 256, 4, E); } SEAM(14);
    PB(15); if (IN(15)) { pg8::Gemm g{XB, WSP(bf16, WS_W_FIN1), D, D, D, 0}; EpiFfnIn E{SSQ + 3 * M, WSP(bf16, WS_H)}; GEMM_RUN(EpiFfnIn, g, M / 256, 22, E); } SEAM(15);
    PB(16); if (IN(16)) { pg8::Gemm g{WSP(bf16, WS_H), WSP(bf16, WS_W_FOUT1), DFF, DFF, DFF, 0}; EpiRes E{F.out, F.out, XB, SSQ + 4 * M}; GEMM_RUN(EpiRes, g, M / 256, 4, E); } SEAM(16);
    PB(17); if (IN(17)) { final_norm(F); }
    if ((PROBE_MASK >> 17) & 1u) tacc += rt() - tph;
    if ((PROBE_MASK2 >> 17) & 1u) tacc2 += rt() - tph;
    if (EXTRA_PHASE != 0) { xcd_barrier(bar); tph = rt();
        if (EXTRA_PHASE == 1) { pg8::Gemm g{XB, WSP(bf16, WS_W_FIN1), D, D, D, 0}; EpiNull E{}; GEMM_RUN(EpiNull, g, M / 256, 22, E); }
        if (EXTRA_PHASE == 2) { pg8::Gemm g{XB, WSP(bf16, WS_W_FIN1), D, D, D, 0}; EpiFfnIn E{SSQ + 3 * M, WSP(bf16, WS_H)}; GEMM_RUN(EpiFfnIn, g, M / 256, 22, E); }
        if (EXTRA_PHASE == 3) { pg8::Gemm g{XB, WSP(bf16, WS_W_FIN1), D, D, D, 0}; EpiNull E{}; GEMM_RUN(EpiNull, g, M / 256, 20, E); }
        if (EXTRA_PHASE == 4) { pg8::Gemm g{XB, WSP(bf16, WS_W_FIN1), D, D, D, 0}; EpiFfnX<1> E{SSQ + 3 * M, WSP(bf16, WS_H)}; GEMM_RUN(EpiFfnX<1>, g, M / 256, 22, E); }
        if (EXTRA_PHASE == 5) { pg8::Gemm g{XB, WSP(bf16, WS_W_FIN1), D, D, D, 0}; EpiFfnX<2> E{SSQ + 3 * M, WSP(bf16, WS_H)}; GEMM_RUN(EpiFfnX<2>, g, M / 256, 22, E); }
        if (EXTRA_PHASE == 6) { pg8::Gemm g{XB, WSP(bf16, WS_W_FIN1), D, D, D, 0}; EpiFfnX<3> E{SSQ + 3 * M, WSP(bf16, WS_H)}; GEMM_RUN(EpiFfnX<3>, g, M / 256, 22, E); }
        xcd_barrier(bar); tacc += rt() - tph; }
    if ((PROBE_MASK | PROBE_MASK2 | (unsigned)EXTRA_PHASE) != 0u && blockIdx.x == 0 && TID == 0) { const unsigned long long te = rt() + 4ull * tacc + 100000ull * ((tacc2 + 50ull) / 100ull); while (rt() < te) __builtin_amdgcn_s_sleep(32); }
#undef IN
#undef SEAM
}

extern "C" void kernel_launch(void* const* d_in, const int* in_sizes, int n_in, void* d_out, int out_size, void* d_ws, size_t ws_size, hipStream_t stream) {
    static int grid = 0;
    if (grid == 0) {
        if (n_in != 19 || in_sizes[0] != M * D || out_size != M * D || ws_size < WS_END) { fprintf(stderr, "kernel_launch: unexpected shapes: n_in %d in0 %d out %d ws %zu (need %zu); nothing launched\n", n_in, n_in > 0 ? in_sizes[0] : -1, out_size, ws_size, (size_t)WS_END); grid = -1; return; }
        int dev = 0, cus = 0, per_cu = 0;
        if (hipGetDevice(&dev) != hipSuccess || hipDeviceGetAttribute(&cus, hipDeviceAttributeMultiprocessorCount, dev) != hipSuccess) { fprintf(stderr, "kernel_launch: device query failed\n"); grid = -1; return; }
        if (hipFuncSetAttribute((const void*)trunk_fwd, hipFuncAttributeMaxDynamicSharedMemorySize, LDS_BYTES) != hipSuccess) { fprintf(stderr, "kernel_launch: hipFuncSetAttribute failed\n"); grid = -1; return; }
        if (hipOccupancyMaxActiveBlocksPerMultiprocessor(&per_cu, (const void*)trunk_fwd, NWAVES * 64, LDS_BYTES) != hipSuccess || per_cu < 1) { fprintf(stderr, "kernel_launch: occupancy query says %d blocks per CU\n", per_cu); }
        (void)hipGetLastError();
        grid = cus;
        fprintf(stderr, "kernel_launch: grid %d, per_cu %d, ws %zu\n", grid, per_cu, ws_size);
    }
    if (grid < 0) return;
    if (hipMemsetAsync((char*)d_ws + WS_CTL, 0, CTL_ZERO_BYTES, stream) != hipSuccess) { fprintf(stderr, "kernel_launch: memset failed\n"); return; }
    Args a{};
    for (int i = 0; i < 19; ++i) a.in[i] = (const float*)d_in[i];
    a.out = (float*)d_out; a.ws = (unsigned char*)d_ws;
    for (int li = 0; li < MK_N_LAUNCHES; ++li) {
        a.ph_lo = (MK_N_LAUNCHES == 1) ? 0 : li; a.ph_hi = (MK_N_LAUNCHES == 1) ? N_PHASES : li + 1;
        hipLaunchKernelGGL(trunk_fwd, dim3(grid), dim3(NWAVES * 64), LDS_BYTES, stream, a);
        const hipError_t le = hipPeekAtLastError();
        if (le != hipSuccess) { fprintf(stderr, "kernel_launch: launch %d failed: %s\n", li, hipGetErrorName(le)); break; }
    }
}
```

```cpp
#include <hip/hip_runtime.h>
#include <cstdio>
#include <cstdint>
namespace pg8 {
#define PG8_LAS __attribute__((address_space(3)))
typedef unsigned short bf16_t;
typedef short bf16x8 __attribute__((ext_vector_type(8)));
typedef float f32x4 __attribute__((ext_vector_type(4)));
typedef unsigned u32x4 __attribute__((ext_vector_type(4)));
constexpr int BM = 256, BK = 64, HALF = 128, HTB = HALF * BK * 2  , STAGE_BYTES = 8 * HTB, NXCD = 8, WGM = 8;

__host__ __device__ __forceinline__ int lds_byte(int r, int c) { const int st = (r >> 4) * 2 + (c >> 5), rr = r & 15, cc = c & 31, ob = rr * 64 + cc * 2; return st * 1024 + (ob ^ (((ob >> 9) & 1) << 5)); }
__host__ __device__ __forceinline__ void stage_rc(int b, int& R, int& C) { const int st = b / 1024, sb = b % 1024, swz = sb ^ (((sb >> 9) & 1) << 5); R = (st >> 1) * 16 + swz / 64; C = (st & 1) * 32 + (swz % 64) / 2; }
__host__ __device__ __forceinline__ int perm32(int rho) { const int n = rho >> 4, i = rho & 15; return 8 * (i >> 2) + 4 * n + (i & 3); }

struct Unit { int pm, pn; };
struct Gemm { const bf16_t* A; const bf16_t* Bt; int lda, ldb, K, ablk; };

struct StaticOrder {
    int nM, nN, nwg, G, c;
    __host__ __device__ void init(int nM_, int nN_, int G_, int c_) { nM = nM_; nN = nN_; nwg = nM * nN; G = G_; c = c_; }
    __host__ __device__ bool next(int i, Unit& u) const {
        const long L = (long)i * G + c; if (L >= nwg) return false;
        int wgid = (int)L; { const int q = nwg / NXCD, r = nwg % NXCD, xcd = wgid % NXCD, off = wgid / NXCD; wgid = (xcd < r ? xcd * (q + 1) : r * (q + 1) + (xcd - r) * q) + off; }
        const int nig = WGM * nN, gid = wgid / nig, fm = gid * WGM, gsz = (nM - fm) < WGM ? (nM - fm) : WGM;
        u.pm = fm + ((wgid % nig) % gsz); u.pn = (wgid % nig) / gsz; return true;
    }
    __device__ __forceinline__ void a_ready(const Unit&) const {}
    __device__ __forceinline__ void done(const Unit&) const {}
};
__device__ __forceinline__ unsigned cvt_pk_bf16(float lo, float hi) { unsigned r; asm volatile("v_cvt_pk_bf16_f32 %0, %1, %2" : "=v"(r) : "v"(lo), "v"(hi)); return r; }
template <class Epi, class Sched, bool ALIGN_EPI = false, bool SP2 = false>
__device__ __forceinline__ void gemm_phase(PG8_LAS unsigned char* lds, const Gemm g, const Sched& S, const Epi& E) {
    const int tid = threadIdx.x, wid = __builtin_amdgcn_readfirstlane(tid >> 6), lane = tid & 63, wr = wid >> 2, wc = wid & 3, fr = lane & 15, fq = lane >> 4;
    const int K = g.K, nt = K / BK;
    unsigned voffA[2], voffB[2];
#pragma unroll
    for (int i = 0; i < 2; ++i) { int R, C; stage_rc(tid * 16 + i * 8192, R, C); const int Rb = Epi::PERM ? ((R & ~31) + perm32(R & 31)) : R;
        voffA[i] = (unsigned)(R * g.lda + C) * 2u; voffB[i] = (unsigned)(Rb * g.ldb + C) * 2u; }
    const size_t kstep = (size_t)(BK * 2);
    const size_t hstepA = (size_t)HALF * g.lda * 2, hstepB = (size_t)HALF * g.ldb * 2;
    const unsigned ldsw = (unsigned)wid * 1024u;
    const int aoff = lds_byte(wr * 64 + fr, fq * 8), boff = lds_byte(wc * 32 + fr, fq * 8);
#define PG8_UA(u) ((const char*)g.A + (size_t)(u).pm * 2 * hstepA + (g.ablk ? (size_t)((u).pn >> 1) * 512 : (size_t)0))
#define PG8_UB(u) ((const char*)g.Bt + (size_t)(u).pn * 2 * hstepB)
#define PG8_SA(b, h) (((b) * 2 + (h)) * HTB)
#define PG8_SB(b, h) ((4 + (b) * 2 + (h)) * HTB)
#define PG8_STAGE(bufoff, gbase, voff) do { _Pragma("unroll") for (int _i = 0; _i < 2; ++_i) \
        __builtin_amdgcn_global_load_lds((const unsigned*)((const char*)(gbase) + (voff)[_i]), (PG8_LAS unsigned*)(lds + (bufoff) + ldsw + _i * 8192), 16, 0, 0); } while (0)
#define PG8_LDA(dst, b, h) do { _Pragma("unroll") for (int m = 0; m < 4; ++m) _Pragma("unroll") for (int k = 0; k < 2; ++k) dst[m][k] = *(const PG8_LAS bf16x8*)(lds + PG8_SA(b, h) + aoff + m * 2048 + k * 1024); } while (0)
#define PG8_LDB(dst, b, h) do { _Pragma("unroll") for (int n = 0; n < 2; ++n) _Pragma("unroll") for (int k = 0; k < 2; ++k) dst[n][k] = *(const PG8_LAS bf16x8*)(lds + PG8_SB(b, h) + boff + n * 2048 + k * 1024); } while (0)
#define PG8_MMA(ai, bj, At, Bt) do { __builtin_amdgcn_s_setprio(1); _Pragma("unroll") for (int m = 0; m < 4; ++m) _Pragma("unroll") for (int n = 0; n < 2; ++n) _Pragma("unroll") for (int k = 0; k < 2; ++k) \
        acc[ai][bj][m][n] = __builtin_amdgcn_mfma_f32_16x16x32_bf16(Bt[n][k], At[m][k], acc[ai][bj][m][n], 0, 0, 0); __builtin_amdgcn_s_setprio(0); } while (0)
#define PG8_WAIT_V(n) asm volatile("s_waitcnt vmcnt(" #n ")" ::: "memory")
#define PG8_WAIT_L(n) asm volatile("s_waitcnt lgkmcnt(" #n ")" ::: "memory")
#define PG8_BAR __builtin_amdgcn_s_barrier()
#define PG8_SCHED __builtin_amdgcn_sched_barrier(0)
    Unit cur, nxt; int ui = 0;
    if (!S.next(0, cur)) return;
    f32x4 acc[2][2][4][2];
#pragma unroll
    for (int a = 0; a < 2; ++a)
#pragma unroll
        for (int b = 0; b < 2; ++b)
#pragma unroll
            for (int m = 0; m < 4; ++m)
#pragma unroll
                for (int n = 0; n < 2; ++n) acc[a][b][m][n] = (f32x4){0.f, 0.f, 0.f, 0.f};
    bf16x8 At[4][2], B0[2][2], B1[2][2];
    const char* cA = PG8_UA(cur); const char* cB = PG8_UB(cur);
    S.a_ready(cur);
    if constexpr (SP2) {
        PG8_STAGE(PG8_SB(0, 0), cB, voffB); PG8_STAGE(PG8_SB(0, 1), cB + hstepB, voffB); PG8_STAGE(PG8_SA(0, 0), cA, voffA); PG8_STAGE(PG8_SA(0, 1), cA + hstepA, voffA);
        if (wr == 1) PG8_BAR;
        PG8_WAIT_V(2); PG8_BAR;
        PG8_STAGE(PG8_SB(1, 0), cB + kstep, voffB); PG8_STAGE(PG8_SA(1, 0), cA + kstep, voffA); PG8_STAGE(PG8_SB(1, 1), cB + hstepB + kstep, voffB);
        PG8_WAIT_V(6); PG8_BAR;
    } else {
        PG8_STAGE(PG8_SB(0, 0), cB, voffB); PG8_STAGE(PG8_SA(0, 0), cA, voffA); PG8_STAGE(PG8_SB(0, 1), cB + hstepB, voffB); PG8_STAGE(PG8_SA(0, 1), cA + hstepA, voffA);
        if (wr == 1) PG8_BAR;
        PG8_WAIT_V(4); PG8_BAR;
        PG8_STAGE(PG8_SB(1, 0), cB + kstep, voffB); PG8_STAGE(PG8_SA(1, 0), cA + kstep, voffA); PG8_STAGE(PG8_SB(1, 1), cB + hstepB + kstep, voffB);
        PG8_WAIT_V(6); PG8_BAR;
    }
    for (;;) {
        const bool has_next = S.next(ui + 1, nxt);
        const char* nA = has_next ? PG8_UA(nxt) : cA; const char* nB = has_next ? PG8_UB(nxt) : cB;
        for (int t = 0; t < nt; t += 2) {
            const bool last = (t == nt - 2);
            const char* a1 = cA + (size_t)(t + 1) * kstep;
            const char* a2 = last ? nA : cA + (size_t)(t + 2) * kstep; const char* b2 = last ? nB : cB + (size_t)(t + 2) * kstep;
            const char* a3 = a2 + kstep; const char* b3 = b2 + kstep;
            if (last && has_next) S.a_ready(nxt);
            if constexpr (SP2) {
            PG8_LDB(B0, 0, 0); PG8_LDB(B1, 0, 1); PG8_SCHED; PG8_LDA(At, 0, 0); PG8_STAGE(PG8_SA(1, 1), a1 + hstepA, voffA);
            PG8_WAIT_V(8); PG8_WAIT_L(0); PG8_BAR; PG8_MMA(0, 0, At, B0); PG8_MMA(0, 1, At, B1); PG8_BAR; PG8_SCHED;
            PG8_LDA(At, 0, 1); PG8_STAGE(PG8_SB(0, 0), b2, voffB); PG8_STAGE(PG8_SB(0, 1), b2 + hstepB, voffB); PG8_STAGE(PG8_SA(0, 0), a2, voffA);
            PG8_WAIT_V(8); PG8_WAIT_L(0); PG8_BAR; PG8_MMA(1, 0, At, B0); PG8_MMA(1, 1, At, B1); PG8_BAR; PG8_SCHED;
            PG8_LDB(B0, 1, 0); PG8_LDB(B1, 1, 1); PG8_SCHED; PG8_LDA(At, 1, 0); PG8_STAGE(PG8_SA(0, 1), a2 + hstepA, voffA);
            PG8_WAIT_V(8); PG8_WAIT_L(0); PG8_BAR; PG8_MMA(0, 0, At, B0); PG8_MMA(0, 1, At, B1); PG8_BAR; PG8_SCHED;
            PG8_LDA(At, 1, 1); PG8_STAGE(PG8_SB(1, 0), b3, voffB); PG8_STAGE(PG8_SB(1, 1), b3 + hstepB, voffB); PG8_STAGE(PG8_SA(1, 0), a3, voffA);
            PG8_WAIT_V(8); PG8_WAIT_L(0); PG8_BAR; PG8_MMA(1, 0, At, B0); PG8_MMA(1, 1, At, B1); PG8_BAR; PG8_SCHED;
            } else {
            PG8_LDB(B0, 0, 0); PG8_SCHED; PG8_LDA(At, 0, 0); PG8_STAGE(PG8_SA(1, 1), a1 + hstepA, voffA);
            PG8_WAIT_L(8); PG8_BAR; PG8_WAIT_L(0); PG8_MMA(0, 0, At, B0); PG8_BAR; PG8_SCHED;
            PG8_LDB(B1, 0, 1); PG8_STAGE(PG8_SB(0, 0), b2, voffB);
            PG8_BAR; PG8_WAIT_L(0); PG8_MMA(0, 1, At, B1); PG8_BAR;
            PG8_LDA(At, 0, 1); PG8_STAGE(PG8_SA(0, 0), a2, voffA);
            PG8_BAR; PG8_WAIT_L(0); PG8_MMA(1, 0, At, B0); PG8_BAR; PG8_SCHED;
            PG8_STAGE(PG8_SB(0, 1), b2 + hstepB, voffB);
            PG8_WAIT_V(6); PG8_BAR; PG8_MMA(1, 1, At, B1); PG8_BAR;
            PG8_LDB(B0, 1, 0); PG8_SCHED; PG8_LDA(At, 1, 0); PG8_STAGE(PG8_SA(0, 1), a2 + hstepA, voffA);
            PG8_WAIT_L(8); PG8_BAR; PG8_WAIT_L(0); PG8_MMA(0, 0, At, B0); PG8_BAR; PG8_SCHED;
            PG8_LDB(B1, 1, 1); PG8_STAGE(PG8_SB(1, 0), b3, voffB);
            PG8_BAR; PG8_WAIT_L(0); PG8_MMA(0, 1, At, B1); PG8_BAR;
            PG8_LDA(At, 1, 1); PG8_STAGE(PG8_SA(1, 0), a3, voffA);
            PG8_BAR; PG8_WAIT_L(0); PG8_MMA(1, 0, At, B0); PG8_BAR; PG8_SCHED;
            PG8_STAGE(PG8_SB(1, 1), b3 + hstepB, voffB);
            PG8_WAIT_V(6); PG8_BAR; PG8_MMA(1, 1, At, B1); PG8_BAR;
            }
        }
        if constexpr (ALIGN_EPI) { if (wr == 0) PG8_BAR; }
        if constexpr (!Epi::AFTER_DRAIN) { E(acc, cur, wr, wc, fr, fq); S.done(cur); }
        if (!has_next) break;
#pragma unroll
        for (int a = 0; a < 2; ++a)
#pragma unroll
            for (int b = 0; b < 2; ++b)
#pragma unroll
                for (int m = 0; m < 4; ++m)
#pragma unroll
                    for (int n = 0; n < 2; ++n) acc[a][b][m][n] = (f32x4){0.f, 0.f, 0.f, 0.f};
        cur = nxt; cA = nA; cB = nB; ++ui;
        if constexpr (ALIGN_EPI) { if (wr == 1) PG8_BAR; }
    }
    PG8_WAIT_V(0);
    if constexpr (!ALIGN_EPI) { if (wr == 0) PG8_BAR; }
    PG8_BAR;
    if constexpr (Epi::AFTER_DRAIN) { E.fused(acc, cur, wr, wc, fr, fq, lds, wid, lane); S.done(cur); }
#undef PG8_UA
#undef PG8_UB
#undef PG8_SA
#undef PG8_SB
#undef PG8_STAGE
#undef PG8_LDA
#undef PG8_LDB
#undef PG8_MMA
#undef PG8_WAIT_V
#undef PG8_WAIT_L
#undef PG8_BAR
#undef PG8_SCHED
}
}
#define GAS __attribute__((address_space(1)))
#define LAS __attribute__((address_space(3)))
typedef unsigned short bf16;
typedef unsigned v4u __attribute__((ext_vector_type(4)));
typedef float f32x4 __attribute__((ext_vector_type(4)));
typedef short bf16x8 __attribute__((ext_vector_type(8)));
typedef GAS unsigned gu32;
typedef GAS unsigned long long gu64;
#define RLX_AGENT __ATOMIC_RELAXED, __HIP_MEMORY_SCOPE_AGENT
#define LDS_WAIT() asm volatile("s_waitcnt lgkmcnt(0)" ::: "memory")
#define VM_WAIT() asm volatile("s_waitcnt vmcnt(0)" ::: "memory")
__device__ __forceinline__ unsigned long long rt() { return __builtin_amdgcn_s_memrealtime(); }
__device__ __forceinline__ unsigned f2bf(float f) { unsigned u = __builtin_bit_cast(unsigned, f); return (u + 0x7fffu + ((u >> 16) & 1u)) >> 16; }
__device__ __forceinline__ unsigned pk2(float lo, float hi) { return f2bf(lo) | (f2bf(hi) << 16); }

#define XB_TMO      128
#define XB_XCNT(j)  (256  + 64 * (j))
#define XB_XSUB(j)  (1280 + 64 * (j))
#define XB_XGEN(j)  (2304 + 64 * (j))
#define XB_TOP      3328
#define XB_TOPGEN   3392
#define XCD_BAR_WORDS 3456
#define XB_SPIN_CAP (1u << 18)

__device__ __forceinline__ unsigned xb_ld(unsigned* p)              { return __hip_atomic_load(p, __ATOMIC_RELAXED, __HIP_MEMORY_SCOPE_AGENT); }
__device__ __forceinline__ unsigned xb_add(unsigned* p, unsigned v) { return __hip_atomic_fetch_add(p, v, __ATOMIC_RELAXED, __HIP_MEMORY_SCOPE_AGENT); }
__device__ __forceinline__ unsigned xb_xcc_id() { return (unsigned)__builtin_amdgcn_s_getreg((3 << 11) | 20) & 0xFu; }
#define XB_SPIN(cond, bar) do { unsigned _sp = 0; while (cond) { __builtin_amdgcn_s_sleep(1); \
    if ((++_sp & 255u) == 0u) { if (xb_ld(&(bar)[XB_TMO])) break; if (_sp > XB_SPIN_CAP) { atomicAdd(&(bar)[XB_TMO], 1u); break; } } } } while (0)

struct XcdBarrier {
    unsigned* bar; unsigned x;
    volatile LAS unsigned* st;
};

__device__ __forceinline__ XcdBarrier xcd_barrier_post(unsigned* bar, volatile LAS unsigned* st) {
    XcdBarrier b; b.bar = bar; b.x = xb_xcc_id(); b.st = st;
    if (threadIdx.x == 0) (void)xb_add(&bar[XB_XCNT(b.x)], 1u);
    return b;
}
__device__ __forceinline__ void xcd_barrier_complete(unsigned* bar, unsigned x, unsigned& nloc, unsigned& nx) {
    const unsigned G = gridDim.x * gridDim.y * gridDim.z;
    unsigned sum, cnt, mine, sp = 0u;
    for (;;) {
        sum = 0u; cnt = 0u; mine = 0u;
#pragma unroll
        for (unsigned j = 0; j < 16; ++j) { const unsigned c = xb_ld(&bar[XB_XCNT(j)]); sum += c; cnt += (c > 0u) ? 1u : 0u; mine = (j == x) ? c : mine; }
        if (sum == G) break;
        __builtin_amdgcn_s_sleep(1);
        if ((++sp & 255u) == 0u) { if (xb_ld(&bar[XB_TMO])) break; if (sp > XB_SPIN_CAP) { atomicAdd(&bar[XB_TMO], 1u); break; } }
    }
    nloc = mine > 0u ? mine : 1u; nx = cnt > 0u ? cnt : 1u;
}

__device__ __forceinline__ void xcd_barrier(const XcdBarrier& b) {
    asm volatile("s_waitcnt vmcnt(0)" ::: "memory");
    __syncthreads();
    if (threadIdx.x == 0) {
        unsigned* bar = b.bar;
        __builtin_amdgcn_s_waitcnt(0);
        unsigned nloc = b.st[0], nx = b.st[1];
        if (nloc == 0u) { xcd_barrier_complete(bar, b.x, nloc, nx); b.st[0] = nloc; b.st[1] = nx; }
        const unsigned old = xb_add(&bar[XB_XSUB(b.x)], 1u);
        const unsigned gen = old / nloc;
        if (old + 1u == (gen + 1u) * nloc) {
            __builtin_amdgcn_fence(__ATOMIC_RELEASE, "agent");
            asm volatile("s_waitcnt vmcnt(0)" ::: "memory");
            const unsigned og = xb_add(&bar[XB_TOP], 1u);
            const unsigned tg = og / nx;
            if (og + 1u == (tg + 1u) * nx) xb_add(&bar[XB_TOPGEN], 1u);
            else XB_SPIN(xb_ld(&bar[XB_TOPGEN]) == tg, bar);
            __builtin_amdgcn_fence(__ATOMIC_ACQUIRE, "agent");
            xb_add(&bar[XB_XGEN(b.x)], 1u);
            asm volatile("s_waitcnt vmcnt(0)" ::: "memory");
        } else {
            XB_SPIN(xb_ld(&bar[XB_XGEN(b.x)]) == gen, bar);
            __builtin_amdgcn_fence(__ATOMIC_ACQUIRE, "agent");
            asm volatile("s_waitcnt vmcnt(0)" ::: "memory");
        }
    }
    __syncthreads();
}
constexpr int NWAVES = 8;
constexpr int BATCH = 2, SEQ = 8192, D = 1024, M = BATCH * SEQ, DFF = 2816;
constexpr int NH = 8, DK = 128, CH = 64, NCHUNK = M / CH  , CPB = SEQ / CH  , NSEG = 16, CPS = 8  , NUNIT = BATCH * NH * NSEG  ;
constexpr int SCH = 128  , NSC = M / SCH  , SCPB = SEQ / SCH  ;
constexpr float EPS = 1e-6f;
constexpr size_t MiB = 1u << 20;
constexpr size_t WS_CTL = 0, CTL_ZERO_BYTES = 1 * MiB;
constexpr size_t WS_SSQ = 65536;
constexpr size_t WS_DEC = 2 * MiB;
constexpr size_t WS_TAB = 3 * MiB;
constexpr size_t WS_AP = 3 * MiB + 65536, WS_HE = WS_AP + 524288;
constexpr size_t WS_W_HIN = 5 * MiB, WS_W_HOUT = 13 * MiB, WS_W_LIN = 15 * MiB, WS_W_LOUT = 19 * MiB, WS_W_GATE = 21 * MiB;
constexpr size_t WS_W_FIN0 = 22 * MiB, WS_W_FIN1 = 33 * MiB, WS_W_FOUT0 = 44 * MiB, WS_W_FOUT1 = 44 * MiB + 5632 * 1024, WS_XB = 56 * MiB, WS_SLOC = 88 * MiB;
constexpr size_t WS_ACT = 104 * MiB;
constexpr size_t WS_QT = WS_ACT, WS_KT = WS_ACT + 32 * MiB, WS_V = WS_ACT + 64 * MiB, WS_SG = WS_ACT + 96 * MiB;
constexpr size_t WS_H = WS_ACT;
constexpr size_t WS_YG = WS_ACT, WS_U = WS_ACT + 32 * MiB, WS_UC = WS_ACT + 64 * MiB, WS_BI = WS_ACT + 96 * MiB;
constexpr size_t WS_END = WS_ACT + 128 * MiB;
static_assert(WS_W_FOUT1 + 5632 * 1024 <= WS_XB && WS_HE + 524288 <= WS_W_HIN && WS_END <= 256 * MiB, "d_ws map");
constexpr int CW_BAR = 4096;
constexpr int RING_BYTES = 131072, LDSCTL_OFF = RING_BYTES, MISC_OFF = LDSCTL_OFF + 320, LDS_BYTES = 147456;
using pg8::Unit;
typedef unsigned u32x2v __attribute__((ext_vector_type(2)));
__device__ __forceinline__ float bf2f(unsigned short h) { return __builtin_bit_cast(float, (unsigned)h << 16); }
__device__ __forceinline__ float fsigmoid(float x) { return __builtin_amdgcn_rcpf(1.0f + __expf(-x)); }
__device__ __forceinline__ float fsilu(float x) { return x * fsigmoid(x); }
__device__ __forceinline__ float row_rstd(const float* ssq, int row) { return __builtin_amdgcn_rsqf(ssq[row] * (1.0f / D) + EPS); }
__device__ __forceinline__ v4u pack8(const f32x4 a, const f32x4 b) { v4u w; w.x = pg8::cvt_pk_bf16(a[0], a[1]); w.y = pg8::cvt_pk_bf16(a[2], a[3]); w.z = pg8::cvt_pk_bf16(b[0], b[1]); w.w = pg8::cvt_pk_bf16(b[2], b[3]); return w; }
#define EPI_ROWS(...) _Pragma("unroll") for (int ai = 0; ai < 2; ++ai) _Pragma("unroll") for (int m = 0; m < 4; ++m) { const int row = u.pm * 256 + ai * 128 + wr * 64 + m * 16 + fr; __VA_ARGS__ }

#define EPI_RS(rs) float rs[2][4]; _Pragma("unroll") for (int ai = 0; ai < 2; ++ai) _Pragma("unroll") for (int m = 0; m < 4; ++m) rs[ai][m] = row_rstd(ssq, u.pm * 256 + ai * 128 + wr * 64 + m * 16 + fr);
struct EpiHgrnIn {
    static constexpr bool PERM = true, AFTER_DRAIN = false;
    const float* ssq; const float* lbv; const float* oml; bf16* QT; bf16* KT; bf16* V; bf16* SG; float* LF;
    __device__ __forceinline__ void operator()(const f32x4 (&acc)[2][2][4][2], const Unit& u, int wr, int wc, int fr, int fq) const {
        const int type = u.pn >> 2, cg = 256 * (u.pn & 3) + 32 * wc + 8 * fq;
        EPI_RS(rs)
        if (type == 1) {
            f32x4 lbq[2][2], omq[2][2];
#pragma unroll
            for (int bj = 0; bj < 2; ++bj)
#pragma unroll
                for (int n = 0; n < 2; ++n) { lbq[bj][n] = *(const f32x4*)(lbv + cg + 128 * bj + 4 * n); omq[bj][n] = *(const f32x4*)(oml + cg + 128 * bj + 4 * n); }
            EPI_ROWS(
                _Pragma("unroll") for (int bj = 0; bj < 2; ++bj) { const int col = cg + 128 * bj; f32x4 lf[2], kk[2];
                    _Pragma("unroll") for (int n = 0; n < 2; ++n) {
                        _Pragma("unroll") for (int i = 0; i < 4; ++i) { const float z = acc[ai][bj][m][n][i] * rs[ai][m]; const float e = __expf(-z), sg = __builtin_amdgcn_rcpf(1.0f + e);
                            const float f = lbq[bj][n][i] + omq[bj][n][i] * sg; lf[n][i] = __logf(f); kk[n][i] = omq[bj][n][i] * (e * sg); } }
                    *(f32x4*)(LF + (unsigned)row * D + col) = lf[0]; *(f32x4*)(LF + (unsigned)row * D + col + 4) = lf[1];
                    *(v4u*)(KT + (unsigned)row * D + col) = pack8(kk[0], kk[1]); })
        } else {
            bf16* O = QT + (size_t)type * (16u << 20); const bool act = type != 2;
            EPI_ROWS(
                _Pragma("unroll") for (int bj = 0; bj < 2; ++bj) { const int col = cg + 128 * bj; f32x4 o[2];
                    _Pragma("unroll") for (int n = 0; n < 2; ++n) _Pragma("unroll") for (int i = 0; i < 4; ++i) { const float z = acc[ai][bj][m][n][i] * rs[ai][m]; o[n][i] = act ? fsilu(z) : z; }
                    *(v4u*)(O + (unsigned)row * D + col) = pack8(o[0], o[1]); })
        }
    }
};
struct EpiRes {
    static constexpr bool PERM = true, AFTER_DRAIN = false;
    const float* base; float* out; bf16* xb; float* ssq;
    __device__ __forceinline__ void operator()(const f32x4 (&acc)[2][2][4][2], const Unit& u, int wr, int wc, int fr, int fq) const {
        const int c0 = 256 * u.pn + 32 * wc + 8 * fq;
#pragma unroll
        for (int ai = 0; ai < 2; ++ai) {
            f32x4 pre[4][2][2];
#pragma unroll
            for (int m = 0; m < 4; ++m)
#pragma unroll
                for (int bj = 0; bj < 2; ++bj) { const unsigned off = (unsigned)(u.pm * 256 + ai * 128 + wr * 64 + m * 16 + fr) * D + c0 + 128 * bj;
                    pre[m][bj][0] = *(const f32x4*)(base + off); pre[m][bj][1] = *(const f32x4*)(base + off + 4); }
#pragma unroll
            for (int m = 0; m < 4; ++m) { const int row = u.pm * 256 + ai * 128 + wr * 64 + m * 16 + fr; float ss = 0.f;
#pragma unroll
                for (int bj = 0; bj < 2; ++bj) { const unsigned off = (unsigned)row * D + c0 + 128 * bj;
                    const f32x4 v0 = pre[m][bj][0] + acc[ai][bj][m][0], v1 = pre[m][bj][1] + acc[ai][bj][m][1];
                    *(f32x4*)(out + off) = v0; *(f32x4*)(out + off + 4) = v1; *(v4u*)(xb + off) = pack8(v0, v1);
                    ss += ((v0[0] * v0[0] + v0[1] * v0[1]) + (v0[2] * v0[2] + v0[3] * v0[3])) + ((v1[0] * v1[0] + v1[1] * v1[1]) + (v1[2] * v1[2] + v1[3] * v1[3])); }
                ss += __shfl_xor(ss, 16); ss += __shfl_xor(ss, 32);
                if (fq == 0) atomicAdd(ssq + row, ss); }
        }
    }
};
struct EpiFfnIn {
    static constexpr bool PERM = true, AFTER_DRAIN = false;
    const float* ssq; bf16* H;
    __device__ __forceinline__ void operator()(const f32x4 (&acc)[2][2][4][2], const Unit& u, int wr, int wc, int fr, int fq) const {
        const int c0 = 128 * u.pn + 32 * wc + 8 * fq;
        EPI_RS(rs)
        EPI_ROWS(f32x4 o[2];
            _Pragma("unroll") for (int n = 0; n < 2; ++n) _Pragma("unroll") for (int i = 0; i < 4; ++i) { const float g = acc[ai][0][m][n][i] * rs[ai][m], up = acc[ai][1][m][n][i] * rs[ai][m]; o[n][i] = fsilu(g) * up; }
            *(v4u*)(H + (unsigned)row * DFF + c0) = pack8(o[0], o[1]);)
    }
};
struct EpiLruIn {
    static constexpr bool PERM = true, AFTER_DRAIN = false;
    const float* ssq; bf16* YG; bf16* U;
    __device__ __forceinline__ void operator()(const f32x4 (&acc)[2][2][4][2], const Unit& u, int wr, int wc, int fr, int fq) const {
        const int cg = 256 * (u.pn & 3) + 32 * wc + 8 * fq;
        EPI_RS(rs)
        if (u.pn < 4) {
            EPI_ROWS(
                _Pragma("unroll") for (int bj = 0; bj < 2; ++bj) { f32x4 o[2];
                    _Pragma("unroll") for (int n = 0; n < 2; ++n) _Pragma("unroll") for (int i = 0; i < 4; ++i) { const float z = acc[ai][bj][m][n][i] * rs[ai][m];
                        o[n][i] = z * fsigmoid(1.5957691216057308f * (z + 0.044715f * z * z * z)); }
                    *(v4u*)(YG + (unsigned)row * D + cg + 128 * bj) = pack8(o[0], o[1]); })
        } else {
            EPI_ROWS(
                _Pragma("unroll") for (int bj = 0; bj < 2; ++bj)
                    *(v4u*)(U + (unsigned)row * D + cg + 128 * bj) = pack8(acc[ai][bj][m][0] * rs[ai][m], acc[ai][bj][m][1] * rs[ai][m]);)
        }
    }
};
struct EpiGates {
    static constexpr bool PERM = true, AFTER_DRAIN = false;
    const float* ba; const float* bx; const float* sp8  ; const bf16* UC; _Float16* LA; bf16* BI;
    __device__ __forceinline__ void operator()(const f32x4 (&acc)[2][2][4][2], const Unit& u, int wr, int wc, int fr, int fq) const {
        const int c0 = 128 * u.pn + 32 * wc + 8 * fq;
#pragma unroll
        for (int ai = 0; ai < 2; ++ai) {
            v4u uwq[4];
#pragma unroll
            for (int m = 0; m < 4; ++m) uwq[m] = *(const v4u*)(UC + (unsigned)(u.pm * 256 + ai * 128 + wr * 64 + m * 16 + fr) * D + c0);
#pragma unroll
            for (int n = 0; n < 2; ++n) { const f32x4 bav = *(const f32x4*)(ba + c0 + 4 * n), bxv = *(const f32x4*)(bx + c0 + 4 * n), spv = *(const f32x4*)(sp8 + c0 + 4 * n);
#pragma unroll
                for (int m = 0; m < 4; ++m) { const int row = u.pm * 256 + ai * 128 + wr * 64 + m * 16 + fr; f32x4 bi; typedef _Float16 h4 __attribute__((ext_vector_type(4))); h4 hv;
#pragma unroll
                    for (int i = 0; i < 4; ++i) { const unsigned w32 = uwq[m][2 * n + (i >> 1)]; const float ucv = __builtin_bit_cast(float, (i & 1) ? (w32 & 0xffff0000u) : (w32 << 16));
                        const float r = fsigmoid(acc[ai][0][m][n][i] + bav[i]), ig = fsigmoid(acc[ai][1][m][n][i] + bxv[i]);
                        const float lg = spv[i] * r, x = 2.0f * lg;
                        const float em = -x * (1.0f + x * (0.5f + x * (0.16666667f + x * (0.041666668f + x * (0.0083333338f + x * 0.0013888889f)))));
                        hv[i] = (_Float16)lg; bi[i] = __builtin_amdgcn_sqrtf(fmaxf(em, 0.0f)) * (ig * ucv); }
                    *(h4*)(LA + (unsigned)row * D + c0 + 4 * n) = hv;
                    u32x2v pk; pk.x = pg8::cvt_pk_bf16(bi[0], bi[1]); pk.y = pg8::cvt_pk_bf16(bi[2], bi[3]);
                    *(u32x2v*)(BI + (unsigned)row * D + c0 + 4 * n) = pk; } }
        }
    }
};
struct EpiNull {
    static constexpr bool PERM = true, AFTER_DRAIN = false;
    __device__ __forceinline__ void operator()(const f32x4 (&acc)[2][2][4][2], const Unit& u, int wr, int wc, int fr, int fq) const {
#pragma unroll
        for (int ai = 0; ai < 2; ++ai)
#pragma unroll
            for (int bj = 0; bj < 2; ++bj)
#pragma unroll
                for (int m = 0; m < 4; ++m)
#pragma unroll
                    for (int n = 0; n < 2; ++n) asm volatile("" :: "v"(acc[ai][bj][m][n]));
    }
};

template <int MODE> struct EpiFfnX {
    static constexpr bool PERM = true, AFTER_DRAIN = false;
    const float* ssq; bf16* H;
    __device__ __forceinline__ void operator()(const f32x4 (&acc)[2][2][4][2], const Unit& u, int wr, int wc, int fr, int fq) const {
        const int c0 = 128 * u.pn + 32 * wc + 8 * fq;
        float rs[2][4];
#pragma unroll
        for (int ai = 0; ai < 2; ++ai)
#pragma unroll
            for (int m = 0; m < 4; ++m) rs[ai][m] = MODE == 2 ? 1.0f : row_rstd(ssq, u.pm * 256 + ai * 128 + wr * 64 + m * 16 + fr);
        EPI_ROWS(f32x4 o[2];
            _Pragma("unroll") for (int n = 0; n < 2; ++n) _Pragma("unroll") for (int i = 0; i < 4; ++i) { const float g = acc[ai][0][m][n][i] * rs[ai][m], up = acc[ai][1][m][n][i] * rs[ai][m]; o[n][i] = MODE == 3 ? g + up : fsilu(g) * up; }
            const v4u w = pack8(o[0], o[1]);
            if (MODE == 1) asm volatile("" :: "v"(w)); else *(v4u*)(H + (unsigned)row * DFF + c0) = w;)
    }
};
typedef short s16x4 __attribute__((ext_vector_type(4)));
struct Args { const float* in[19]; float* out; unsigned char* ws; int ph_lo, ph_hi; };
static_assert(sizeof(Args) == 19 * 8 + 8 + 8 + 8, "Args has no padding");
__device__ __forceinline__ LAS unsigned char* lds_base() { extern __shared__ __attribute__((aligned(16))) unsigned char lds_dyn[]; return (LAS unsigned char*)lds_dyn; }
#define TID ((int)threadIdx.x)
#define LANE (TID & 63)
#define WAVE (__builtin_amdgcn_readfirstlane(TID >> 6))
#define GSZ ((int)gridDim.x)
#define VCU ((GSZ % 8 == 0) ? ((int)blockIdx.x % 8) * (GSZ / 8) + (int)blockIdx.x / 8 : (int)blockIdx.x)
#define LDSB (lds_base())
#define WSP(T, off) ((T*)(F.ws + (off)))
__device__ __forceinline__ float wave_sum(float v) {
#pragma unroll
    for (int o = 1; o < 64; o <<= 1) v += __shfl_xor(v, o);
    return v;
}
__device__ __forceinline__ void tr_item64(const float* W, int ldw, int k0, int ns0, bf16* WT, int ldt, int drow0, const float* ksc, LAS unsigned char* scr, int lane) {
    const int c = lane & 15, g = lane >> 4;
    f32x4 v[16];
    const float* src = W + (size_t)(k0 + 16 * g) * ldw + ns0 + 4 * c;
#pragma unroll
    for (int i = 0; i < 16; ++i) v[i] = *(const GAS f32x4*)(src + (size_t)i * ldw);
    if (ksc) {
#pragma unroll
        for (int q = 0; q < 4; ++q) { const f32x4 s = *(const GAS f32x4*)(ksc + k0 + 16 * g + 4 * q);
#pragma unroll
            for (int r = 0; r < 4; ++r) v[4 * q + r] = v[4 * q + r] * s[r]; }
    }
#pragma unroll
    for (int j = 0; j < 4; ++j) {
#pragma unroll
        for (int h = 0; h < 2; ++h) { v4u w; w.x = pk2(v[8 * h][j], v[8 * h + 1][j]); w.y = pk2(v[8 * h + 2][j], v[8 * h + 3][j]); w.z = pk2(v[8 * h + 4][j], v[8 * h + 5][j]); w.w = pk2(v[8 * h + 6][j], v[8 * h + 7][j]);
            *(LAS v4u*)(scr + (4 * c + j) * 128 + (((2 * g + h) ^ (c & 7)) * 16)) = w; }
    }
    LDS_WAIT(); asm volatile("" ::: "memory");
#pragma unroll
    for (int i = 0; i < 8; ++i) { const int n = (lane >> 3) + 8 * i, ch = lane & 7;
        const v4u x = *(const LAS v4u*)(scr + n * 128 + ((ch ^ ((n >> 2) & 7)) * 16));
        *(GAS v4u*)(WT + (size_t)(drow0 + n) * ldt + k0 + 8 * ch) = x; }
    LDS_WAIT(); asm volatile("" ::: "memory");
}
constexpr int CV_A = 1024, CV_B = 256, CV_F = 1408, CV_G = 704, CV_C = 512, CV_D = 256, CV_E = 128;
constexpr int CV_EARLY = CV_A + CV_B + CV_F, CV_ALL = CV_EARLY + CV_G + CV_C + CV_D + CV_E + CV_F + CV_G;
__device__ __forceinline__ void convert_items(const Args& F, int first, int last, int gw, int ngw) {
    LAS unsigned char* scr = LDSB + WAVE * 8192; const int lane = LANE;
    for (int it = first + gw; it < last; it += ngw) {
        int r = it;
        if (r < CV_A) { const int kb = r >> 6, nb = r & 63; tr_item64(F.in[4], 4096, 64 * kb, 64 * nb, WSP(bf16, WS_W_HIN), 1024, 64 * nb, F.in[1], scr, lane); continue; } r -= CV_A;
        if (r < CV_B) { const int kb = r >> 4, nb = r & 15; tr_item64(F.in[7], 1024, 64 * kb, 64 * nb, WSP(bf16, WS_W_HOUT), 1024, 64 * nb, nullptr, scr, lane); continue; } r -= CV_B;
        if (r < CV_F) { const int kb = r / 88, nb = r % 88, isup = nb >= 44 ? 1 : 0, j0 = 64 * (nb - 44 * isup);
            tr_item64(F.in[17], 5632, 64 * kb, 64 * nb, WSP(bf16, WS_W_FIN0), 1024, 256 * (j0 >> 7) + (j0 & 127) + 128 * isup, F.in[2], scr, lane); continue; } r -= CV_F;
        if (r < CV_G) { const int kb = r >> 4, nb = r & 15; tr_item64(F.in[18], 1024, 64 * kb, 64 * nb, WSP(bf16, WS_W_FOUT0), 2816, 64 * nb, nullptr, scr, lane); continue; } r -= CV_G;
        if (r < CV_C) { const int kb = r >> 5, nb = r & 31; tr_item64(F.in[8], 2048, 64 * kb, 64 * nb, WSP(bf16, WS_W_LIN), 1024, 64 * nb, F.in[1] + 1024, scr, lane); continue; } r -= CV_C;
        if (r < CV_D) { const int kb = r >> 4, nb = r & 15; tr_item64(F.in[16], 1024, 64 * kb, 64 * nb, WSP(bf16, WS_W_LOUT), 1024, 64 * nb, nullptr, scr, lane); continue; } r -= CV_D;
        if (r < CV_E) { const int isx = r >> 6, n = (r >> 4) & 3, kb = (r >> 2) & 3, nb = r & 3; const int ch0 = 256 * n + 64 * nb;
            tr_item64((isx ? F.in[13] : F.in[11]) + (size_t)n * 65536, 256, 64 * kb, 64 * nb, WSP(bf16, WS_W_GATE), 256, 256 * (ch0 >> 7) + (ch0 & 127) + 128 * isx, nullptr, scr, lane); continue; } r -= CV_E;
        if (r < CV_F) { const int kb = r / 88, nb = r % 88, isup = nb >= 44 ? 1 : 0, j0 = 64 * (nb - 44 * isup);
            tr_item64(F.in[17] + (size_t)1024 * 5632, 5632, 64 * kb, 64 * nb, WSP(bf16, WS_W_FIN1), 1024, 256 * (j0 >> 7) + (j0 & 127) + 128 * isup, F.in[2] + 1024, scr, lane); continue; } r -= CV_F;
        { const int kb = r >> 4, nb = r & 15; tr_item64(F.in[18] + (size_t)2816 * 1024, 1024, 64 * kb, 64 * nb, WSP(bf16, WS_W_FOUT1), 2816, 64 * nb, nullptr, scr, lane); }
    }
}
__device__ __forceinline__ void p0_prologue(const Args& F) {
    const int gw = VCU * NWAVES + WAVE, NGW = GSZ * NWAVES, lane = LANE;
    convert_items(F, 0, GSZ == 256 ? CV_EARLY : CV_ALL, gw, NGW);
    for (int m4 = gw; m4 < M / 4; m4 += NGW) {
        f32x4 v[4][4]; float s[4];
#pragma unroll
        for (int r = 0; r < 4; ++r) { const GAS f32x4* xr = (const GAS f32x4*)(F.in[0] + (size_t)(4 * m4 + r) * D) + lane;
#pragma unroll
            for (int j = 0; j < 4; ++j) v[r][j] = xr[64 * j]; }
#pragma unroll
        for (int r = 0; r < 4; ++r) { float a = 0.f;
#pragma unroll
            for (int j = 0; j < 4; ++j) a += (v[r][j].x * v[r][j].x + v[r][j].y * v[r][j].y) + (v[r][j].z * v[r][j].z + v[r][j].w * v[r][j].w);
            s[r] = wave_sum(a);
            GAS unsigned long long* o8 = (GAS unsigned long long*)(WSP(bf16, WS_XB) + (size_t)(4 * m4 + r) * D) + lane;
#pragma unroll
            for (int j = 0; j < 4; ++j) o8[64 * j] = (unsigned long long)pk2(v[r][j].x, v[r][j].y) | ((unsigned long long)pk2(v[r][j].z, v[r][j].w) << 32); }
        if (lane < 4) WSP(float, WS_SSQ)[4 * m4 + lane] = lane == 0 ? s[0] : (lane == 1 ? s[1] : (lane == 2 ? s[2] : s[3]));
    }
    { const int g = blockIdx.x * (NWAVES * 64) + TID; if (g < 1024) { const float l0 = F.in[5][g], l1 = F.in[5][1024 + g];
        WSP(float, WS_TAB)[g] = __builtin_amdgcn_rcpf(1.0f + __expf(l1 - l0)); WSP(float, WS_TAB)[1024 + g] = __builtin_amdgcn_rcpf(1.0f + __expf(l0 - l1));
        WSP(float, WS_TAB)[2048 + g] = -8.0f * log1pf(__expf(-F.in[15][g])); } }
}
__device__ __forceinline__ void hgrn_prep(const Args& F) {
    bf16* QT = WSP(bf16, WS_QT); bf16* KT = WSP(bf16, WS_KT); const float* LF = F.out; float* DEC = WSP(float, WS_DEC);
    for (int idx = blockIdx.x * (NWAVES * 64) + TID; idx < NCHUNK * 1024; idx += GSZ * NWAVES * 64) {
        const int c = idx >> 10, col = idx & 1023; float b = 0.f; size_t off = (size_t)c * CH * D + col;
#pragma unroll 8
        for (int s = 0; s < CH; ++s, off += D) { b += LF[off]; const float eb = __expf(b), enb = __expf(-b);
            QT[off] = (bf16)f2bf(bf2f(QT[off]) * eb); KT[off] = (bf16)f2bf(bf2f(KT[off]) * enb); }
        DEC[idx] = __expf(b);
    }
}
constexpr int TP = 272  , AP_ = 144  ;
constexpr int L_Q = 0, L_K = 17408, L_V = 34816, L_A = 52224, L_ST = 61440, L_RS = 96256;
__device__ __forceinline__ void stage_tile(LAS unsigned char* img, const bf16* src, int tid) {
#pragma unroll
    for (int i = 0; i < 2; ++i) { const int piece = tid + 512 * i, row = piece >> 4, pc = piece & 15;
        const v4u x = *(const GAS v4u*)(src + (size_t)row * D + pc * 8); *(LAS v4u*)(img + row * TP + pc * 16) = x; }
}
__device__ __forceinline__ bf16x8 frag_row(const LAS unsigned char* img, int pitch, int row0, int k0, int fr, int fq) {
    return *(const LAS bf16x8*)(img + (row0 + fr) * pitch + (k0 + 8 * fq) * 2);
}
__device__ __forceinline__ bf16x8 frag_tr(const LAS unsigned char* img, int pitch, int n0, int k0, int fr, int fq) {
    const int q = fr >> 2, p = fr & 3;
    const s16x4 lo = __builtin_amdgcn_ds_read_tr16_b64_v4i16((LAS s16x4*)(img + (k0 + 8 * fq + q) * pitch + (n0 + 4 * p) * 2));
    const s16x4 hi = __builtin_amdgcn_ds_read_tr16_b64_v4i16((LAS s16x4*)(img + (k0 + 8 * fq + 4 + q) * pitch + (n0 + 4 * p) * 2));
    return __builtin_shufflevector(lo, hi, 0, 1, 2, 3, 4, 5, 6, 7);
}
#define MFMA16(a, b, c) __builtin_amdgcn_mfma_f32_16x16x32_bf16((a), (b), (c), 0, 0, 0)
__device__ __forceinline__ void state_update(f32x4 (&S)[8], const LAS unsigned char* Ki, const LAS unsigned char* Vi, const float* decp, int w, int fr, int fq) {
#pragma unroll
    for (int ks = 0; ks < 2; ++ks) { const bf16x8 X = frag_tr(Ki, TP, 16 * w, 32 * ks, fr, fq);
#pragma unroll
        for (int vb = 0; vb < 8; ++vb) S[vb] = MFMA16(X, frag_tr(Vi, TP, 16 * vb, 32 * ks, fr, fq), S[vb]); }
    const f32x4 dv = *(const f32x4*)(decp + 16 * w + 4 * fq);
#pragma unroll
    for (int vb = 0; vb < 8; ++vb) S[vb] = S[vb] * dv;
}
__device__ __forceinline__ void hgrn_seg_state(const Args& F) {
    LAS unsigned char* Ki = LDSB + L_K; LAS unsigned char* Vi = LDSB + L_V;
    const int w = WAVE, fr = LANE & 15, fq = LANE >> 4;
    for (int unit = VCU; unit < NUNIT; unit += GSZ) {
        const int b = unit / (NH * NSEG), h = (unit / NSEG) % NH, seg = unit % NSEG;
        f32x4 S[8];
#pragma unroll
        for (int vb = 0; vb < 8; ++vb) S[vb] = (f32x4){0.f, 0.f, 0.f, 0.f};
        for (int c = 0; c < CPS; ++c) {
            const int cg = b * CPB + seg * CPS + c; const size_t r0 = (size_t)cg * CH;
            __syncthreads();
            stage_tile(Ki, WSP(bf16, WS_KT) + r0 * D + h * DK, TID); stage_tile(Vi, WSP(bf16, WS_V) + r0 * D + h * DK, TID);
            __syncthreads();
            state_update(S, Ki, Vi, WSP(float, WS_DEC) + (size_t)cg * D + h * DK, w, fr, fq);
        }
        float* sl = WSP(float, WS_SLOC) + (size_t)unit * 16384;
#pragma unroll
        for (int vb = 0; vb < 8; ++vb)
#pragma unroll
            for (int r = 0; r < 4; ++r) sl[(16 * w + 4 * fq + r) * 128 + 16 * vb + fr] = S[vb][r];
    }
}
__device__ __forceinline__ void hgrn_seg_scan(const Args& F) {
    float* SL = WSP(float, WS_SLOC); const float* DEC = WSP(float, WS_DEC);
    for (int idx = blockIdx.x * (NWAVES * 64) + TID; idx < BATCH * NH * 16384; idx += GSZ * NWAVES * 64) {
        const int bh = idx >> 14, kv = idx & 16383, k = kv >> 7, b = bh / NH, h = bh % NH; float S = 0.f;
        for (int seg = 0; seg < NSEG; ++seg) { float* p = SL + ((size_t)(bh * NSEG + seg) << 14) + kv; const float t = *p; *p = S;
            float dsg = 1.f; const float* dp = DEC + (size_t)(b * CPB + seg * CPS) * D + h * DK + k;
#pragma unroll
            for (int c = 0; c < CPS; ++c) dsg *= dp[(size_t)c * D];
            S = dsg * S + t; }
    }
}
__device__ __forceinline__ void hgrn_out(const Args& F) {
    LAS unsigned char* Qi = LDSB + L_Q; LAS unsigned char* Ki = LDSB + L_K; LAS unsigned char* Vi = LDSB + L_V; LAS unsigned char* Ai = LDSB + L_A; LAS unsigned char* STi = LDSB + L_ST;
    LAS float* RS = (LAS float*)(LDSB + L_RS);
    const int w = WAVE, fr = LANE & 15, fq = LANE >> 4, tb = w & 3, wh = w >> 2;
    const float* nw = F.in[6];
    for (int unit = VCU; unit < NUNIT; unit += GSZ) {
        const int b = unit / (NH * NSEG), h = (unit / NSEG) % NH, seg = unit % NSEG;
        f32x4 S[8];
        { const float* sl = WSP(float, WS_SLOC) + (size_t)unit * 16384;
#pragma unroll
          for (int vb = 0; vb < 8; ++vb)
#pragma unroll
            for (int r = 0; r < 4; ++r) S[vb][r] = sl[(16 * w + 4 * fq + r) * 128 + 16 * vb + fr]; }
        __syncthreads();
#pragma unroll
        for (int vb = 0; vb < 8; ++vb) { u32x2v pk; pk.x = pg8::cvt_pk_bf16(S[vb][0], S[vb][1]); pk.y = pg8::cvt_pk_bf16(S[vb][2], S[vb][3]);
            *(LAS u32x2v*)(STi + (16 * vb + fr) * TP + (16 * w + 4 * fq) * 2) = pk; }
        for (int c = 0; c < CPS; ++c) {
            const int cg = b * CPB + seg * CPS + c; const size_t r0 = (size_t)cg * CH;
            bf16* qg = WSP(bf16, WS_QT) + r0 * D + h * DK;
            stage_tile(Qi, qg, TID); stage_tile(Ki, WSP(bf16, WS_KT) + r0 * D + h * DK, TID); stage_tile(Vi, WSP(bf16, WS_V) + r0 * D + h * DK, TID);
            __syncthreads();
            bf16x8 Yq[4];
#pragma unroll
            for (int ks = 0; ks < 4; ++ks) Yq[ks] = frag_row(Qi, TP, 16 * tb, 32 * ks, fr, fq);
#pragma unroll
            for (int sbi = 0; sbi < 2; ++sbi) { const int sb = 2 * wh + sbi; f32x4 a = (f32x4){0.f, 0.f, 0.f, 0.f};
                if (sb <= tb) {
#pragma unroll
                    for (int ks = 0; ks < 4; ++ks) a = MFMA16(frag_row(Ki, TP, 16 * sb, 32 * ks, fr, fq), Yq[ks], a);
                }
                const int t = 16 * tb + fr, s0 = 16 * sb + 4 * fq;
#pragma unroll
                for (int r = 0; r < 4; ++r) a[r] = (s0 + r <= t) ? a[r] : 0.f;
                u32x2v pk; pk.x = pg8::cvt_pk_bf16(a[0], a[1]); pk.y = pg8::cvt_pk_bf16(a[2], a[3]);
                *(LAS u32x2v*)(Ai + t * AP_ + s0 * 2) = pk; }
            __syncthreads();
            bf16x8 Ya[2];
#pragma unroll
            for (int ks = 0; ks < 2; ++ks) Ya[ks] = frag_row(Ai, AP_, 16 * tb, 32 * ks, fr, fq);
            f32x4 o[4]; float ssq = 0.f;
#pragma unroll
            for (int j = 0; j < 4; ++j) { const int vb = 4 * wh + j; f32x4 a = (f32x4){0.f, 0.f, 0.f, 0.f};
#pragma unroll
                for (int ks = 0; ks < 4; ++ks) a = MFMA16(frag_row(STi, TP, 16 * vb, 32 * ks, fr, fq), Yq[ks], a);
#pragma unroll
                for (int ks = 0; ks < 2; ++ks) a = MFMA16(frag_tr(Vi, TP, 16 * vb, 32 * ks, fr, fq), Ya[ks], a);
                o[j] = a; ssq += (a[0] * a[0] + a[1] * a[1]) + (a[2] * a[2] + a[3] * a[3]); }
            ssq += __shfl_xor(ssq, 16); ssq += __shfl_xor(ssq, 32);
            if (fq == 0) RS[(16 * tb + fr) * 2 + wh] = ssq;
            state_update(S, Ki, Vi, WSP(float, WS_DEC) + (size_t)cg * D + h * DK, w, fr, fq);
            __syncthreads();
            { const int t = 16 * tb + fr; const float rstd = __builtin_amdgcn_rsqf((RS[t * 2] + RS[t * 2 + 1]) * (1.0f / DK) + EPS);
              const bf16* sgp = WSP(bf16, WS_SG) + (r0 + t) * D + h * DK;
#pragma unroll
              for (int j = 0; j < 4; ++j) { const int v0 = 16 * (4 * wh + j) + 4 * fq; const u32x2v sgw = *(const GAS u32x2v*)(sgp + v0); const f32x4 nv = *(const f32x4*)(nw + v0);
                  const float g0 = __builtin_bit_cast(float, sgw.x << 16), g1 = __builtin_bit_cast(float, sgw.x & 0xffff0000u), g2 = __builtin_bit_cast(float, sgw.y << 16), g3 = __builtin_bit_cast(float, sgw.y & 0xffff0000u);
                  u32x2v pk; pk.x = pg8::cvt_pk_bf16(o[j][0] * rstd * nv[0] * g0, o[j][1] * rstd * nv[1] * g1); pk.y = pg8::cvt_pk_bf16(o[j][2] * rstd * nv[2] * g2, o[j][3] * rstd * nv[3] * g3);
                  *(GAS u32x2v*)(qg + (size_t)t * D + v0) = pk; } }
#pragma unroll
            for (int vb = 0; vb < 8; ++vb) { u32x2v pk; pk.x = pg8::cvt_pk_bf16(S[vb][0], S[vb][1]); pk.y = pg8::cvt_pk_bf16(S[vb][2], S[vb][3]);
                *(LAS u32x2v*)(STi + (16 * vb + fr) * TP + (16 * w + 4 * fq) * 2) = pk; }
            __syncthreads();
        }
    }
}
__device__ __forceinline__ void lru_conv(const Args& F) {
    const bf16* U = WSP(bf16, WS_U); bf16* UC = WSP(bf16, WS_UC); const float* cw = F.in[9]; const float* cb = F.in[10];
    for (int idx = blockIdx.x * (NWAVES * 64) + TID; idx < M * (D / 8); idx += GSZ * NWAVES * 64) {
        const int row = idx >> 7, c0 = (idx & 127) * 8, t = row & (SEQ - 1); float a[8];
#pragma unroll
        for (int j = 0; j < 8; ++j) a[j] = cb[c0 + j];
#pragma unroll
        for (int tap = 0; tap < 4; ++tap) { const int dt = 3 - tap; if (t - dt >= 0) { const v4u uw = *(const GAS v4u*)(U + (size_t)(row - dt) * D + c0);
#pragma unroll
            for (int j = 0; j < 8; ++j) { const unsigned w32 = uw[j >> 1]; const float uv = __builtin_bit_cast(float, (j & 1) ? (w32 & 0xffff0000u) : (w32 << 16)); a[j] += uv * cw[tap * D + c0 + j]; } } }
        v4u o; o.x = pk2(a[0], a[1]); o.y = pk2(a[2], a[3]); o.z = pk2(a[4], a[5]); o.w = pk2(a[6], a[7]);
        *(GAS v4u*)(UC + (size_t)row * D + c0) = o;
    }
}
__device__ __forceinline__ void lru_scan_local(const Args& F) {
    const _Float16* LA = WSP(_Float16, WS_U); const bf16* BI = WSP(bf16, WS_BI); float* AP = WSP(float, WS_AP); float* HE = WSP(float, WS_HE);
    for (int idx = blockIdx.x * (NWAVES * 64) + TID; idx < NSC * D; idx += GSZ * NWAVES * 64) {
        const int sc = idx >> 10, ch = idx & 1023; size_t off = (size_t)sc * SCH * D + ch; float h = 0.f, sl = 0.f;
#pragma unroll 8
        for (int r = 0; r < SCH; ++r, off += D) { const float la = (float)LA[off]; h = __expf(la) * h + bf2f(BI[off]); sl += la; }
        AP[idx] = __expf(sl); HE[idx] = h;
    }
}
__device__ __forceinline__ void lru_scan_apply(const Args& F) {
    const _Float16* LA = WSP(_Float16, WS_U); const bf16* BI = WSP(bf16, WS_BI); const bf16* YG = WSP(bf16, WS_YG); bf16* HY = WSP(bf16, WS_UC);
    const float* AP = WSP(float, WS_AP); const float* HE = WSP(float, WS_HE);
    for (int idx = blockIdx.x * (NWAVES * 64) + TID; idx < NSC * D; idx += GSZ * NWAVES * 64) {
        const int sc = idx >> 10, ch = idx & 1023, sc0 = (sc / SCPB) * SCPB; float h = 0.f;
        for (int j = sc0; j < sc; ++j) h = AP[j * D + ch] * h + HE[j * D + ch];
        size_t off = (size_t)sc * SCH * D + ch;
#pragma unroll 8
        for (int r = 0; r < SCH; ++r, off += D) { h = __expf((float)LA[off]) * h + bf2f(BI[off]); HY[off] = (bf16)f2bf(h * bf2f(YG[off])); }
    }
}
__device__ __forceinline__ void final_norm(const Args& F) {
    const int gw = VCU * NWAVES + WAVE, NGW = GSZ * NWAVES; const float* nf = F.in[3];
    for (int m = gw; m < M; m += NGW) { const float rs = row_rstd(WSP(float, WS_SSQ) + 4 * M, m); GAS f32x4* xr = (GAS f32x4*)(F.out + (size_t)m * D) + LANE;
#pragma unroll
        for (int j = 0; j < 4; ++j) { const f32x4 w = *((const f32x4*)nf + LANE + 64 * j); xr[64 * j] = xr[64 * j] * rs * w; } }
}
#ifndef MK_N_LAUNCHES
#define MK_N_LAUNCHES 1
#endif
constexpr int N_PHASES = 18;
#ifndef ONLY_PHASE
#define ONLY_PHASE -1
#endif
#ifndef EXTRA_PHASE
#define EXTRA_PHASE 0
#endif
#ifndef PROBE_MASK
#define PROBE_MASK 0u
#endif
#ifndef PROBE_MASK2
#define PROBE_MASK2 0u
#endif
#define GEMM_RUN(EPI, g, nM_, nN_, E) do { pg8::StaticOrder S_; S_.init(nM_, nN_, GSZ, (int)blockIdx.x); pg8::gemm_phase<EPI, pg8::StaticOrder, true, true>(LDSB, g, S_, E); } while (0)
__global__ void __launch_bounds__(NWAVES * 64, 2) trunk_fwd(Args args) {
    const Args& F = args;
    volatile LAS unsigned* MISC = (volatile LAS unsigned*)(LDSB + MISC_OFF);
    gu32* ctl = (gu32*)(args.ws + WS_CTL);
    for (int u = TID; u < (LDS_BYTES - LDSCTL_OFF) / 4; u += NWAVES * 64) ((LAS unsigned*)(LDSB + LDSCTL_OFF))[u] = 0u;
    __syncthreads();
    XcdBarrier bar; bar.bar = (unsigned*)(ctl + CW_BAR); bar.x = 0; bar.st = nullptr;
    if (MK_N_LAUNCHES == 1) bar = xcd_barrier_post((unsigned*)(ctl + CW_BAR), MISC + 8);
    const int lo = args.ph_lo, hi = args.ph_hi;
#define IN(k) ((ONLY_PHASE < 0 || ONLY_PHASE == (k)) && lo <= (k) && (k) < hi)
    unsigned long long tacc = 0ull, tacc2 = 0ull, tph = 0ull;
#define PB(k) do { if (((PROBE_MASK | PROBE_MASK2) >> (k)) & 1u) tph = rt(); } while (0)
#define SEAM(k) do { if (IN(k) && IN((k) + 1)) xcd_barrier(bar); if ((PROBE_MASK >> (k)) & 1u) tacc += rt() - tph; if ((PROBE_MASK2 >> (k)) & 1u) tacc2 += rt() - tph; } while (0)
    bf16* XB = WSP(bf16, WS_XB); float* SSQ = WSP(float, WS_SSQ);
    PB(0); if (IN(0)) { p0_prologue(F); } SEAM(0);
    PB(1); if (IN(1)) { pg8::Gemm g{XB, WSP(bf16, WS_W_HIN), D, D, D, 0};
        EpiHgrnIn E{SSQ, WSP(float, WS_TAB), WSP(float, WS_TAB) + 1024, WSP(bf16, WS_QT), WSP(bf16, WS_KT), WSP(bf16, WS_V), WSP(bf16, WS_SG), F.out};
        GEMM_RUN(EpiHgrnIn, g, M / 256, 16, E); } SEAM(1);
    PB(2); if (IN(2)) { hgrn_prep(F); } SEAM(2);
    PB(3); if (IN(3)) { hgrn_seg_state(F); } SEAM(3);
    PB(4); if (IN(4)) { hgrn_seg_scan(F); } SEAM(4);
    PB(5); if (IN(5)) { hgrn_out(F); } SEAM(5);
    PB(6); if (IN(6)) { pg8::Gemm g{WSP(bf16, WS_QT), WSP(bf16, WS_W_HOUT), D, D, D, 0}; EpiRes E{F.in[0], F.out, XB, SSQ + M}; GEMM_RUN(EpiRes, g, M / 256, 4, E); } SEAM(6);
    PB(7); if (IN(7)) { pg8::Gemm g{XB, WSP(bf16, WS_W_FIN0), D, D, D, 0}; EpiFfnIn E{SSQ + M, WSP(bf16, WS_H)}; GEMM_RUN(EpiFfnIn, g, M / 256, 22, E);
        if (GSZ == 256 && blockIdx.x >= 128) convert_items(F, CV_EARLY, CV_ALL, ((int)blockIdx.x - 128) * NWAVES + WAVE, 128 * NWAVES); } SEAM(7);
    PB(8); if (IN(8)) { pg8::Gemm g{WSP(bf16, WS_H), WSP(bf16, WS_W_FOUT0), DFF, DFF, DFF, 0}; EpiRes E{F.out, F.out, XB, SSQ + 2 * M}; GEMM_RUN(EpiRes, g, M / 256, 4, E); } SEAM(8);
    PB(9); if (IN(9)) { pg8::Gemm g{XB, WSP(bf16, WS_W_LIN), D, D, D, 0}; EpiLruIn E{SSQ + 2 * M, WSP(bf16, WS_YG), WSP(bf16, WS_U)}; GEMM_RUN(EpiLruIn, g, M / 256, 8, E); } SEAM(9);
    PB(10); if (IN(10)) { lru_conv(F); } SEAM(10);
    PB(11); if (IN(11)) { int kg = 256; asm volatile("" : "+s"(kg));
        pg8::Gemm g{WSP(bf16, WS_UC), WSP(bf16, WS_W_GATE), D, 256, kg, 1};
        EpiGates E{F.in[12], F.in[14], WSP(float, WS_TAB) + 2048, WSP(bf16, WS_UC), WSP(_Float16, WS_U), WSP(bf16, WS_BI)}; GEMM_RUN(EpiGates, g, M / 256, 8, E); } SEAM(11);
    PB(12); if (IN(12)) { lru_scan_local(F); } SEAM(12);
    PB(13); if (IN(13)) { lru_scan_apply(F); } SEAM(13);
    PB(14); if (IN(14)) { pg8::Gemm g{WSP(bf16, WS_UC), WSP(bf16, WS_W_LOUT), D, D, D, 0}; EpiRes E{F.out, F.out, XB, SSQ + 3 * M}; GEMM_RUN(EpiRes, g, M / 256, 4, E); } SEAM(14);
    PB(15); if (IN(15)) { pg8::Gemm g{XB, WSP(bf16, WS_W_FIN1), D, D, D, 0}; EpiFfnIn E{SSQ + 3 * M, WSP(bf16, WS_H)}; GEMM_RUN(EpiFfnIn, g, M / 256, 22, E); } SEAM(15);
    PB(16); if (IN(16)) { pg8::Gemm g{WSP(bf16, WS_H), WSP(bf16, WS_W_FOUT1), DFF, DFF, DFF, 0}; EpiRes E{F.out, F.out, XB, SSQ + 4 * M}; GEMM_RUN(EpiRes, g, M / 256, 4, E); } SEAM(16);
    PB(17); if (IN(17)) { final_norm(F); }
    if ((PROBE_MASK >> 17) & 1u) tacc += rt() - tph;
    if ((PROBE_MASK2 >> 17) & 1u) tacc2 += rt() - tph;
    if (EXTRA_PHASE != 0) { xcd_barrier(bar); tph = rt();
        if (EXTRA_PHASE == 1) { pg8::Gemm g{XB, WSP(bf16, WS_W_FIN1), D, D, D, 0}; EpiNull E{}; GEMM_RUN(EpiNull, g, M / 256, 22, E); }
        if (EXTRA_PHASE == 2) { pg8::Gemm g{XB, WSP(bf16, WS_W_FIN1), D, D, D, 0}; EpiFfnIn E{SSQ + 3 * M, WSP(bf16, WS_H)}; GEMM_RUN(EpiFfnIn, g, M / 256, 22, E); }
        if (EXTRA_PHASE == 3) { pg8::Gemm g{XB, WSP(bf16, WS_W_FIN1), D, D, D, 0}; EpiNull E{}; GEMM_RUN(EpiNull, g, M / 256, 20, E); }
        if (EXTRA_PHASE == 4) { pg8::Gemm g{XB, WSP(bf16, WS_W_FIN1), D, D, D, 0}; EpiFfnX<1> E{SSQ + 3 * M, WSP(bf16, WS_H)}; GEMM_RUN(EpiFfnX<1>, g, M / 256, 22, E); }
        if (EXTRA_PHASE == 5) { pg8::Gemm g{XB, WSP(bf16, WS_W_FIN1), D, D, D, 0}; EpiFfnX<2> E{SSQ + 3 * M, WSP(bf16, WS_H)}; GEMM_RUN(EpiFfnX<2>, g, M / 256, 22, E); }
        if (EXTRA_PHASE == 6) { pg8::Gemm g{XB, WSP(bf16, WS_W_FIN1), D, D, D, 0}; EpiFfnX<3> E{SSQ + 3 * M, WSP(bf16, WS_H)}; GEMM_RUN(EpiFfnX<3>, g, M / 256, 22, E); }
        xcd_barrier(bar); tacc += rt() - tph; }
    if ((PROBE_MASK | PROBE_MASK2 | (unsigned)EXTRA_PHASE) != 0u && blockIdx.x == 0 && TID == 0) { const unsigned long long te = rt() + 4ull * tacc + 100000ull * ((tacc2 + 50ull) / 100ull); while (rt() < te) __builtin_amdgcn_s_sleep(32); }
#undef IN
#undef SEAM
}

extern "C" void kernel_launch(void* const* d_in, const int* in_sizes, int n_in, void* d_out, int out_size, void* d_ws, size_t ws_size, hipStream_t stream) {
    static int grid = 0;
    if (grid == 0) {
        if (n_in != 19 || in_sizes[0] != M * D || out_size != M * D || ws_size < WS_END) { fprintf(stderr, "kernel_launch: unexpected shapes: n_in %d in0 %d out %d ws %zu (need %zu); nothing launched\n", n_in, n_in > 0 ? in_sizes[0] : -1, out_size, ws_size, (size_t)WS_END); grid = -1; return; }
        int dev = 0, cus = 0, per_cu = 0;
        if (hipGetDevice(&dev) != hipSuccess || hipDeviceGetAttribute(&cus, hipDeviceAttributeMultiprocessorCount, dev) != hipSuccess) { fprintf(stderr, "kernel_launch: device query failed\n"); grid = -1; return; }
        if (hipFuncSetAttribute((const void*)trunk_fwd, hipFuncAttributeMaxDynamicSharedMemorySize, LDS_BYTES) != hipSuccess) { fprintf(stderr, "kernel_launch: hipFuncSetAttribute failed\n"); grid = -1; return; }
        if (hipOccupancyMaxActiveBlocksPerMultiprocessor(&per_cu, (const void*)trunk_fwd, NWAVES * 64, LDS_BYTES) != hipSuccess || per_cu < 1) { fprintf(stderr, "kernel_launch: occupancy query says %d blocks per CU\n", per_cu); }
        (void)hipGetLastError();
        grid = cus;
        fprintf(stderr, "kernel_launch: grid %d, per_cu %d, ws %zu\n", grid, per_cu, ws_size);
    }
    if (grid < 0) return;
    if (hipMemsetAsync((char*)d_ws + WS_CTL, 0, CTL_ZERO_BYTES, stream) != hipSuccess) { fprintf(stderr, "kernel_launch: memset failed\n"); return; }
    Args a{};
    for (int i = 0; i < 19; ++i) a.in[i] = (const float*)d_in[i];
    a.out = (float*)d_out; a.ws = (unsigned char*)d_ws;
    for (int li = 0; li < MK_N_LAUNCHES; ++li) {
        a.ph_lo = (MK_N_LAUNCHES == 1) ? 0 : li; a.ph_hi = (MK_N_LAUNCHES == 1) ? N_PHASES : li + 1;
        hipLaunchKernelGGL(trunk_fwd, dim3(grid), dim3(NWAVES * 64), LDS_BYTES, stream, a);
        const hipError_t le = hipPeekAtLastError();
        if (le != hipSuccess) { fprintf(stderr, "kernel_launch: launch %d failed: %s\n", li, hipGetErrorName(le)); break; }
    }
}
```

```cpp
#include <hip/hip_runtime.h>
#include <cstdio>
#include <cstdint>
namespace pg8 {
#define PG8_LAS __attribute__((address_space(3)))
typedef unsigned short bf16_t;
typedef short bf16x8 __attribute__((ext_vector_type(8)));
typedef float f32x4 __attribute__((ext_vector_type(4)));
typedef unsigned u32x4 __attribute__((ext_vector_type(4)));
constexpr int BM = 256, BK = 64, HALF = 128, HTB = HALF * BK * 2  , STAGE_BYTES = 8 * HTB, NXCD = 8, WGM = 8;

__host__ __device__ __forceinline__ int lds_byte(int r, int c) { const int st = (r >> 4) * 2 + (c >> 5), rr = r & 15, cc = c & 31, ob = rr * 64 + cc * 2; return st * 1024 + (ob ^ (((ob >> 9) & 1) << 5)); }
__host__ __device__ __forceinline__ void stage_rc(int b, int& R, int& C) { const int st = b / 1024, sb = b % 1024, swz = sb ^ (((sb >> 9) & 1) << 5); R = (st >> 1) * 16 + swz / 64; C = (st & 1) * 32 + (swz % 64) / 2; }
__host__ __device__ __forceinline__ int perm32(int rho) { const int n = rho >> 4, i = rho & 15; return 8 * (i >> 2) + 4 * n + (i & 3); }

struct Unit { int pm, pn; };
struct Gemm { const bf16_t* A; const bf16_t* Bt; int lda, ldb, K, ablk; };

struct StaticOrder {
    int nM, nN, nwg, G, c;
    __host__ __device__ void init(int nM_, int nN_, int G_, int c_) { nM = nM_; nN = nN_; nwg = nM * nN; G = G_; c = c_; }
    __host__ __device__ bool next(int i, Unit& u) const {
        const long L = (long)i * G + c; if (L >= nwg) return false;
        int wgid = (int)L; { const int q = nwg / NXCD, r = nwg % NXCD, xcd = wgid % NXCD, off = wgid / NXCD; wgid = (xcd < r ? xcd * (q + 1) : r * (q + 1) + (xcd - r) * q) + off; }
        const int nig = WGM * nN, gid = wgid / nig, fm = gid * WGM, gsz = (nM - fm) < WGM ? (nM - fm) : WGM;
        u.pm = fm + ((wgid % nig) % gsz); u.pn = (wgid % nig) / gsz; return true;
    }
    __device__ __forceinline__ void a_ready(const Unit&) const {}
    __device__ __forceinline__ void done(const Unit&) const {}
};
__device__ __forceinline__ unsigned cvt_pk_bf16(float lo, float hi) { unsigned r; asm volatile("v_cvt_pk_bf16_f32 %0, %1, %2" : "=v"(r) : "v"(lo), "v"(hi)); return r; }
template <class Epi, class Sched, bool ALIGN_EPI = false, bool SP2 = false>
__device__ __forceinline__ void gemm_phase(PG8_LAS unsigned char* lds, const Gemm g, const Sched& S, const Epi& E) {
    const int tid = threadIdx.x, wid = __builtin_amdgcn_readfirstlane(tid >> 6), lane = tid & 63, wr = wid >> 2, wc = wid & 3, fr = lane & 15, fq = lane >> 4;
    const int K = g.K, nt = K / BK;
    unsigned voffA[2], voffB[2];
#pragma unroll
    for (int i = 0; i < 2; ++i) { int R, C; stage_rc(tid * 16 + i * 8192, R, C); const int Rb = Epi::PERM ? ((R & ~31) + perm32(R & 31)) : R;
        voffA[i] = (unsigned)(R * g.lda + C) * 2u; voffB[i] = (unsigned)(Rb * g.ldb + C) * 2u; }
    const size_t kstep = (size_t)(BK * 2);
    const size_t hstepA = (size_t)HALF * g.lda * 2, hstepB = (size_t)HALF * g.ldb * 2;
    const unsigned ldsw = (unsigned)wid * 1024u;
    const int aoff = lds_byte(wr * 64 + fr, fq * 8), boff = lds_byte(wc * 32 + fr, fq * 8);
#define PG8_UA(u) ((const char*)g.A + (size_t)(u).pm * 2 * hstepA + (g.ablk ? (size_t)((u).pn >> 1) * 512 : (size_t)0))
#define PG8_UB(u) ((const char*)g.Bt + (size_t)(u).pn * 2 * hstepB)
#define PG8_SA(b, h) (((b) * 2 + (h)) * HTB)
#define PG8_SB(b, h) ((4 + (b) * 2 + (h)) * HTB)
#define PG8_STAGE(bufoff, gbase, voff) do { _Pragma("unroll") for (int _i = 0; _i < 2; ++_i) \
        __builtin_amdgcn_global_load_lds((const unsigned*)((const char*)(gbase) + (voff)[_i]), (PG8_LAS unsigned*)(lds + (bufoff) + ldsw + _i * 8192), 16, 0, 0); } while (0)
#define PG8_LDA(dst, b, h) do { _Pragma("unroll") for (int m = 0; m < 4; ++m) _Pragma("unroll") for (int k = 0; k < 2; ++k) dst[m][k] = *(const PG8_LAS bf16x8*)(lds + PG8_SA(b, h) + aoff + m * 2048 + k * 1024); } while (0)
#define PG8_LDB(dst, b, h) do { _Pragma("unroll") for (int n = 0; n < 2; ++n) _Pragma("unroll") for (int k = 0; k < 2; ++k) dst[n][k] = *(const PG8_LAS bf16x8*)(lds + PG8_SB(b, h) + boff + n * 2048 + k * 1024); } while (0)
#define PG8_MMA(ai, bj, At, Bt) do { __builtin_amdgcn_s_setprio(1); _Pragma("unroll") for (int m = 0; m < 4; ++m) _Pragma("unroll") for (int n = 0; n < 2; ++n) _Pragma("unroll") for (int k = 0; k < 2; ++k) \
        acc[ai][bj][m][n] = __builtin_amdgcn_mfma_f32_16x16x32_bf16(Bt[n][k], At[m][k], acc[ai][bj][m][n], 0, 0, 0); __builtin_amdgcn_s_setprio(0); } while (0)
#define PG8_WAIT_V(n) asm volatile("s_waitcnt vmcnt(" #n ")" ::: "memory")
#define PG8_WAIT_L(n) asm volatile("s_waitcnt lgkmcnt(" #n ")" ::: "memory")
#define PG8_BAR __builtin_amdgcn_s_barrier()
#define PG8_SCHED __builtin_amdgcn_sched_barrier(0)
    Unit cur, nxt; int ui = 0;
    if (!S.next(0, cur)) return;
    f32x4 acc[2][2][4][2];
#pragma unroll
    for (int a = 0; a < 2; ++a)
#pragma unroll
        for (int b = 0; b < 2; ++b)
#pragma unroll
            for (int m = 0; m < 4; ++m)
#pragma unroll
                for (int n = 0; n < 2; ++n) acc[a][b][m][n] = (f32x4){0.f, 0.f, 0.f, 0.f};
    bf16x8 At[4][2], B0[2][2], B1[2][2];
    const char* cA = PG8_UA(cur); const char* cB = PG8_UB(cur);
    S.a_ready(cur);
    if constexpr (SP2) {
        PG8_STAGE(PG8_SB(0, 0), cB, voffB); PG8_STAGE(PG8_SB(0, 1), cB + hstepB, voffB); PG8_STAGE(PG8_SA(0, 0), cA, voffA); PG8_STAGE(PG8_SA(0, 1), cA + hstepA, voffA);
        if (wr == 1) PG8_BAR;
        PG8_WAIT_V(2); PG8_BAR;
        PG8_STAGE(PG8_SB(1, 0), cB + kstep, voffB); PG8_STAGE(PG8_SA(1, 0), cA + kstep, voffA); PG8_STAGE(PG8_SB(1, 1), cB + hstepB + kstep, voffB);
        PG8_WAIT_V(6); PG8_BAR;
    } else {
        PG8_STAGE(PG8_SB(0, 0), cB, voffB); PG8_STAGE(PG8_SA(0, 0), cA, voffA); PG8_STAGE(PG8_SB(0, 1), cB + hstepB, voffB); PG8_STAGE(PG8_SA(0, 1), cA + hstepA, voffA);
        if (wr == 1) PG8_BAR;
        PG8_WAIT_V(4); PG8_BAR;
        PG8_STAGE(PG8_SB(1, 0), cB + kstep, voffB); PG8_STAGE(PG8_SA(1, 0), cA + kstep, voffA); PG8_STAGE(PG8_SB(1, 1), cB + hstepB + kstep, voffB);
        PG8_WAIT_V(6); PG8_BAR;
    }
    for (;;) {
        const bool has_next = S.next(ui + 1, nxt);
        const char* nA = has_next ? PG8_UA(nxt) : cA; const char* nB = has_next ? PG8_UB(nxt) : cB;
        for (int t = 0; t < nt; t += 2) {
            const bool last = (t == nt - 2);
            const char* a1 = cA + (size_t)(t + 1) * kstep;
            const char* a2 = last ? nA : cA + (size_t)(t + 2) * kstep; const char* b2 = last ? nB : cB + (size_t)(t + 2) * kstep;
            const char* a3 = a2 + kstep; const char* b3 = b2 + kstep;
            if (last && has_next) S.a_ready(nxt);
            if constexpr (SP2) {
            PG8_LDB(B0, 0, 0); PG8_LDB(B1, 0, 1); PG8_SCHED; PG8_LDA(At, 0, 0); PG8_STAGE(PG8_SA(1, 1), a1 + hstepA, voffA);
            PG8_WAIT_V(8); PG8_WAIT_L(0); PG8_BAR; PG8_MMA(0, 0, At, B0); PG8_MMA(0, 1, At, B1); PG8_BAR; PG8_SCHED;
            PG8_LDA(At, 0, 1); PG8_STAGE(PG8_SB(0, 0), b2, voffB); PG8_STAGE(PG8_SB(0, 1), b2 + hstepB, voffB); PG8_STAGE(PG8_SA(0, 0), a2, voffA);
            PG8_WAIT_V(8); PG8_WAIT_L(0); PG8_BAR; PG8_MMA(1, 0, At, B0); PG8_MMA(1, 1, At, B1); PG8_BAR; PG8_SCHED;
            PG8_LDB(B0, 1, 0); PG8_LDB(B1, 1, 1); PG8_SCHED; PG8_LDA(At, 1, 0); PG8_STAGE(PG8_SA(0, 1), a2 + hstepA, voffA);
            PG8_WAIT_V(8); PG8_WAIT_L(0); PG8_BAR; PG8_MMA(0, 0, At, B0); PG8_MMA(0, 1, At, B1); PG8_BAR; PG8_SCHED;
            PG8_LDA(At, 1, 1); PG8_STAGE(PG8_SB(1, 0), b3, voffB); PG8_STAGE(PG8_SB(1, 1), b3 + hstepB, voffB); PG8_STAGE(PG8_SA(1, 0), a3, voffA);
            PG8_WAIT_V(8); PG8_WAIT_L(0); PG8_BAR; PG8_MMA(1, 0, At, B0); PG8_MMA(1, 1, At, B1); PG8_BAR; PG8_SCHED;
            } else {
            PG8_LDB(B0, 0, 0); PG8_SCHED; PG8_LDA(At, 0, 0); PG8_STAGE(PG8_SA(1, 1), a1 + hstepA, voffA);
            PG8_WAIT_L(8); PG8_BAR; PG8_WAIT_L(0); PG8_MMA(0, 0, At, B0); PG8_BAR; PG8_SCHED;
            PG8_LDB(B1, 0, 1); PG8_STAGE(PG8_SB(0, 0), b2, voffB);
            PG8_BAR; PG8_WAIT_L(0); PG8_MMA(0, 1, At, B1); PG8_BAR;
            PG8_LDA(At, 0, 1); PG8_STAGE(PG8_SA(0, 0), a2, voffA);
            PG8_BAR; PG8_WAIT_L(0); PG8_MMA(1, 0, At, B0); PG8_BAR; PG8_SCHED;
            PG8_STAGE(PG8_SB(0, 1), b2 + hstepB, voffB);
            PG8_WAIT_V(6); PG8_BAR; PG8_MMA(1, 1, At, B1); PG8_BAR;
            PG8_LDB(B0, 1, 0); PG8_SCHED; PG8_LDA(At, 1, 0); PG8_STAGE(PG8_SA(0, 1), a2 + hstepA, voffA);
            PG8_WAIT_L(8); PG8_BAR; PG8_WAIT_L(0); PG8_MMA(0, 0, At, B0); PG8_BAR; PG8_SCHED;
            PG8_LDB(B1, 1, 1); PG8_STAGE(PG8_SB(1, 0), b3, voffB);
            PG8_BAR; PG8_WAIT_L(0); PG8_MMA(0, 1, At, B1); PG8_BAR;
            PG8_LDA(At, 1, 1); PG8_STAGE(PG8_SA(1, 0), a3, voffA);
            PG8_BAR; PG8_WAIT_L(0); PG8_MMA(1, 0, At, B0); PG8_BAR; PG8_SCHED;
            PG8_STAGE(PG8_SB(1, 1), b3 + hstepB, voffB);
            PG8_WAIT_V(6); PG8_BAR; PG8_MMA(1, 1, At, B1); PG8_BAR;
            }
        }
        if constexpr (ALIGN_EPI) { if (wr == 0) PG8_BAR; }
        if constexpr (!Epi::AFTER_DRAIN) { E(acc, cur, wr, wc, fr, fq); S.done(cur); }
        if (!has_next) break;
#pragma unroll
        for (int a = 0; a < 2; ++a)
#pragma unroll
            for (int b = 0; b < 2; ++b)
#pragma unroll
                for (int m = 0; m < 4; ++m)
#pragma unroll
                    for (int n = 0; n < 2; ++n) acc[a][b][m][n] = (f32x4){0.f, 0.f, 0.f, 0.f};
        cur = nxt; cA = nA; cB = nB; ++ui;
        if constexpr (ALIGN_EPI) { if (wr == 1) PG8_BAR; }
    }
    PG8_WAIT_V(0);
    if constexpr (!ALIGN_EPI) { if (wr == 0) PG8_BAR; }
    PG8_BAR;
    if constexpr (Epi::AFTER_DRAIN) { E.fused(acc, cur, wr, wc, fr, fq, lds, wid, lane); S.done(cur); }
#undef PG8_UA
#undef PG8_UB
#undef PG8_SA
#undef PG8_SB
#undef PG8_STAGE
#undef PG8_LDA
#undef PG8_LDB
#undef PG8_MMA
#undef PG8_WAIT_V
#undef PG8_WAIT_L
#undef PG8_BAR
#undef PG8_SCHED
}
}
#define GAS __attribute__((address_space(1)))
#define LAS __attribute__((address_space(3)))
typedef unsigned short bf16;
typedef unsigned v4u __attribute__((ext_vector_type(4)));
typedef float f32x4 __attribute__((ext_vector_type(4)));
typedef short bf16x8 __attribute__((ext_vector_type(8)));
typedef GAS unsigned gu32;
typedef GAS unsigned long long gu64;
#define RLX_AGENT __ATOMIC_RELAXED, __HIP_MEMORY_SCOPE_AGENT
#define LDS_WAIT() asm volatile("s_waitcnt lgkmcnt(0)" ::: "memory")
#define VM_WAIT() asm volatile("s_waitcnt vmcnt(0)" ::: "memory")
__device__ __forceinline__ unsigned long long rt() { return __builtin_amdgcn_s_memrealtime(); }
__device__ __forceinline__ unsigned f2bf(float f) { unsigned u = __builtin_bit_cast(unsigned, f); return (u + 0x7fffu + ((u >> 16) & 1u)) >> 16; }
__device__ __forceinline__ unsigned pk2(float lo, float hi) { return f2bf(lo) | (f2bf(hi) << 16); }

#define XB_TMO      128
#define XB_XCNT(j)  (256  + 64 * (j))
#define XB_XSUB(j)  (1280 + 64 * (j))
#define XB_XGEN(j)  (2304 + 64 * (j))
#define XB_TOP      3328
#define XB_TOPGEN   3392
#define XCD_BAR_WORDS 3456
#define XB_SPIN_CAP (1u << 18)

__device__ __forceinline__ unsigned xb_ld(unsigned* p)              { return __hip_atomic_load(p, __ATOMIC_RELAXED, __HIP_MEMORY_SCOPE_AGENT); }
__device__ __forceinline__ unsigned xb_add(unsigned* p, unsigned v) { return __hip_atomic_fetch_add(p, v, __ATOMIC_RELAXED, __HIP_MEMORY_SCOPE_AGENT); }
__device__ __forceinline__ unsigned xb_xcc_id() { return (unsigned)__builtin_amdgcn_s_getreg((3 << 11) | 20) & 0xFu; }
#define XB_SPIN(cond, bar) do { unsigned _sp = 0; while (cond) { __builtin_amdgcn_s_sleep(1); \
    if ((++_sp & 255u) == 0u) { if (xb_ld(&(bar)[XB_TMO])) break; if (_sp > XB_SPIN_CAP) { atomicAdd(&(bar)[XB_TMO], 1u); break; } } } } while (0)

struct XcdBarrier {
    unsigned* bar; unsigned x;
    volatile LAS unsigned* st;
};

__device__ __forceinline__ XcdBarrier xcd_barrier_post(unsigned* bar, volatile LAS unsigned* st) {
    XcdBarrier b; b.bar = bar; b.x = xb_xcc_id(); b.st = st;
    if (threadIdx.x == 0) (void)xb_add(&bar[XB_XCNT(b.x)], 1u);
    return b;
}
__device__ __forceinline__ void xcd_barrier_complete(unsigned* bar, unsigned x, unsigned& nloc, unsigned& nx) {
    const unsigned G = gridDim.x * gridDim.y * gridDim.z;
    unsigned sum, cnt, mine, sp = 0u;
    for (;;) {
        sum = 0u; cnt = 0u; mine = 0u;
#pragma unroll
        for (unsigned j = 0; j < 16; ++j) { const unsigned c = xb_ld(&bar[XB_XCNT(j)]); sum += c; cnt += (c > 0u) ? 1u : 0u; mine = (j == x) ? c : mine; }
        if (sum == G) break;
        __builtin_amdgcn_s_sleep(1);
        if ((++sp & 255u) == 0u) { if (xb_ld(&bar[XB_TMO])) break; if (sp > XB_SPIN_CAP) { atomicAdd(&bar[XB_TMO], 1u); break; } }
    }
    nloc = mine > 0u ? mine : 1u; nx = cnt > 0u ? cnt : 1u;
}

__device__ __forceinline__ void xcd_barrier(const XcdBarrier& b) {
    asm volatile("s_waitcnt vmcnt(0)" ::: "memory");
    __syncthreads();
    if (threadIdx.x == 0) {
        unsigned* bar = b.bar;
        __builtin_amdgcn_s_waitcnt(0);
        unsigned nloc = b.st[0], nx = b.st[1];
        if (nloc == 0u) { xcd_barrier_complete(bar, b.x, nloc, nx); b.st[0] = nloc; b.st[1] = nx; }
        const unsigned old = xb_add(&bar[XB_XSUB(b.x)], 1u);
        const unsigned gen = old / nloc;
        if (old + 1u == (gen + 1u) * nloc) {
            __builtin_amdgcn_fence(__ATOMIC_RELEASE, "agent");
            asm volatile("s_waitcnt vmcnt(0)" ::: "memory");
            const unsigned og = xb_add(&bar[XB_TOP], 1u);
            const unsigned tg = og / nx;
            if (og + 1u == (tg + 1u) * nx) xb_add(&bar[XB_TOPGEN], 1u);
            else XB_SPIN(xb_ld(&bar[XB_TOPGEN]) == tg, bar);
            __builtin_amdgcn_fence(__ATOMIC_ACQUIRE, "agent");
            xb_add(&bar[XB_XGEN(b.x)], 1u);
            asm volatile("s_waitcnt vmcnt(0)" ::: "memory");
        } else {
            XB_SPIN(xb_ld(&bar[XB_XGEN(b.x)]) == gen, bar);
            __builtin_amdgcn_fence(__ATOMIC_ACQUIRE, "agent");
            asm volatile("s_waitcnt vmcnt(0)" ::: "memory");
        }
    }
    __syncthreads();
}
constexpr int NWAVES = 8;
constexpr int BATCH = 2, SEQ = 8192, D = 1024, M = BATCH * SEQ, DFF = 2816;
constexpr int NH = 8, DK = 128, CH = 64, NCHUNK = M / CH  , CPB = SEQ / CH  , NSEG = 16, CPS = 8  , NUNIT = BATCH * NH * NSEG  ;
constexpr int SCH = 128  , NSC = M / SCH  , SCPB = SEQ / SCH  ;
constexpr float EPS = 1e-6f;
constexpr size_t MiB = 1u << 20;
constexpr size_t WS_CTL = 0, CTL_ZERO_BYTES = 1 * MiB;
constexpr size_t WS_SSQ = 65536;
constexpr size_t WS_DEC = 2 * MiB;
constexpr size_t WS_TAB = 3 * MiB;
constexpr size_t WS_AP = 3 * MiB + 65536, WS_HE = WS_AP + 524288;
constexpr size_t WS_W_HIN = 5 * MiB, WS_W_HOUT = 13 * MiB, WS_W_LIN = 15 * MiB, WS_W_LOUT = 19 * MiB, WS_W_GATE = 21 * MiB;
constexpr size_t WS_W_FIN0 = 22 * MiB, WS_W_FIN1 = 33 * MiB, WS_W_FOUT0 = 44 * MiB, WS_W_FOUT1 = 44 * MiB + 5632 * 1024, WS_XB = 56 * MiB, WS_SLOC = 88 * MiB;
constexpr size_t WS_ACT = 104 * MiB;
constexpr size_t WS_QT = WS_ACT, WS_KT = WS_ACT + 32 * MiB, WS_V = WS_ACT + 64 * MiB, WS_SG = WS_ACT + 96 * MiB;
constexpr size_t WS_H = WS_ACT;
constexpr size_t WS_YG = WS_ACT, WS_U = WS_ACT + 32 * MiB, WS_UC = WS_ACT + 64 * MiB, WS_BI = WS_ACT + 96 * MiB;
constexpr size_t WS_END = WS_ACT + 128 * MiB;
static_assert(WS_W_FOUT1 + 5632 * 1024 <= WS_XB && WS_HE + 524288 <= WS_W_HIN && WS_END <= 256 * MiB, "d_ws map");
constexpr int CW_BAR = 4096;
constexpr int RING_BYTES = 131072, LDSCTL_OFF = RING_BYTES, MISC_OFF = LDSCTL_OFF + 320, LDS_BYTES = 147456;
using pg8::Unit;
typedef unsigned u32x2v __attribute__((ext_vector_type(2)));
__device__ __forceinline__ float bf2f(unsigned short h) { return __builtin_bit_cast(float, (unsigned)h << 16); }
__device__ __forceinline__ float fsigmoid(float x) { return __builtin_amdgcn_rcpf(1.0f + __expf(-x)); }
__device__ __forceinline__ float fsilu(float x) { return x * fsigmoid(x); }
__device__ __forceinline__ float row_rstd(const float* ssq, int row) { return __builtin_amdgcn_rsqf(ssq[row] * (1.0f / D) + EPS); }
__device__ __forceinline__ v4u pack8(const f32x4 a, const f32x4 b) { v4u w; w.x = pg8::cvt_pk_bf16(a[0], a[1]); w.y = pg8::cvt_pk_bf16(a[2], a[3]); w.z = pg8::cvt_pk_bf16(b[0], b[1]); w.w = pg8::cvt_pk_bf16(b[2], b[3]); return w; }
#define EPI_ROWS(...) _Pragma("unroll") for (int ai = 0; ai < 2; ++ai) _Pragma("unroll") for (int m = 0; m < 4; ++m) { const int row = u.pm * 256 + ai * 128 + wr * 64 + m * 16 + fr; __VA_ARGS__ }

#define EPI_RS(rs) float rs[2][4]; _Pragma("unroll") for (int ai = 0; ai < 2; ++ai) _Pragma("unroll") for (int m = 0; m < 4; ++m) rs[ai][m] = row_rstd(ssq, u.pm * 256 + ai * 128 + wr * 64 + m * 16 + fr);
struct EpiHgrnIn {
    static constexpr bool PERM = true, AFTER_DRAIN = false;
    const float* ssq; const float* lbv; const float* oml; bf16* QT; bf16* KT; bf16* V; bf16* SG; float* LF;
    __device__ __forceinline__ void operator()(const f32x4 (&acc)[2][2][4][2], const Unit& u, int wr, int wc, int fr, int fq) const {
        const int type = u.pn >> 2, cg = 256 * (u.pn & 3) + 32 * wc + 8 * fq;
        EPI_RS(rs)
        if (type == 1) {
            f32x4 lbq[2][2], omq[2][2];
#pragma unroll
            for (int bj = 0; bj < 2; ++bj)
#pragma unroll
                for (int n = 0; n < 2; ++n) { lbq[bj][n] = *(const f32x4*)(lbv + cg + 128 * bj + 4 * n); omq[bj][n] = *(const f32x4*)(oml + cg + 128 * bj + 4 * n); }
            EPI_ROWS(
                _Pragma("unroll") for (int bj = 0; bj < 2; ++bj) { const int col = cg + 128 * bj; f32x4 lf[2], kk[2];
                    _Pragma("unroll") for (int n = 0; n < 2; ++n) {
                        _Pragma("unroll") for (int i = 0; i < 4; ++i) { const float z = acc[ai][bj][m][n][i] * rs[ai][m]; const float e = __expf(-z), sg = __builtin_amdgcn_rcpf(1.0f + e);
                            const float f = lbq[bj][n][i] + omq[bj][n][i] * sg; lf[n][i] = __logf(f); kk[n][i] = omq[bj][n][i] * (e * sg); } }
                    *(f32x4*)(LF + (unsigned)row * D + col) = lf[0]; *(f32x4*)(LF + (unsigned)row * D + col + 4) = lf[1];
                    *(v4u*)(KT + (unsigned)row * D + col) = pack8(kk[0], kk[1]); })
        } else {
            bf16* O = QT + (size_t)type * (16u << 20); const bool act = type != 2;
            EPI_ROWS(
                _Pragma("unroll") for (int bj = 0; bj < 2; ++bj) { const int col = cg + 128 * bj; f32x4 o[2];
                    _Pragma("unroll") for (int n = 0; n < 2; ++n) _Pragma("unroll") for (int i = 0; i < 4; ++i) { const float z = acc[ai][bj][m][n][i] * rs[ai][m]; o[n][i] = act ? fsilu(z) : z; }
                    *(v4u*)(O + (unsigned)row * D + col) = pack8(o[0], o[1]); })
        }
    }
};
template <bool LAST> struct EpiRes {
    static constexpr bool PERM = true, AFTER_DRAIN = false;
    bf16* xb; float* out; float* ssq;
    __device__ __forceinline__ void operator()(const f32x4 (&acc)[2][2][4][2], const Unit& u, int wr, int wc, int fr, int fq) const {
        const int c0 = 256 * u.pn + 32 * wc + 8 * fq;
#pragma unroll
        for (int ai = 0; ai < 2; ++ai) {
            v4u pre[4][2];
#pragma unroll
            for (int m = 0; m < 4; ++m)
#pragma unroll
                for (int bj = 0; bj < 2; ++bj) pre[m][bj] = *(const v4u*)(xb + (unsigned)(u.pm * 256 + ai * 128 + wr * 64 + m * 16 + fr) * D + c0 + 128 * bj);
#pragma unroll
            for (int m = 0; m < 4; ++m) { const int row = u.pm * 256 + ai * 128 + wr * 64 + m * 16 + fr; float ss = 0.f;
#pragma unroll
                for (int bj = 0; bj < 2; ++bj) { const unsigned off = (unsigned)row * D + c0 + 128 * bj; const v4u p = pre[m][bj];
                    const f32x4 b0 = {__builtin_bit_cast(float, p.x << 16), __builtin_bit_cast(float, p.x & 0xffff0000u), __builtin_bit_cast(float, p.y << 16), __builtin_bit_cast(float, p.y & 0xffff0000u)};
                    const f32x4 b1 = {__builtin_bit_cast(float, p.z << 16), __builtin_bit_cast(float, p.z & 0xffff0000u), __builtin_bit_cast(float, p.w << 16), __builtin_bit_cast(float, p.w & 0xffff0000u)};
                    const f32x4 v0 = b0 + acc[ai][bj][m][0], v1 = b1 + acc[ai][bj][m][1];
                    if (LAST) { *(f32x4*)(out + off) = v0; *(f32x4*)(out + off + 4) = v1; } else *(v4u*)(xb + off) = pack8(v0, v1);
                    ss += ((v0[0] * v0[0] + v0[1] * v0[1]) + (v0[2] * v0[2] + v0[3] * v0[3])) + ((v1[0] * v1[0] + v1[1] * v1[1]) + (v1[2] * v1[2] + v1[3] * v1[3])); }
                ss += __shfl_xor(ss, 16); ss += __shfl_xor(ss, 32);
                if (fq == 0) atomicAdd(ssq + row, ss); }
        }
    }
};
struct EpiFfnIn {
    static constexpr bool PERM = true, AFTER_DRAIN = false;
    const float* ssq; bf16* H;
    __device__ __forceinline__ void operator()(const f32x4 (&acc)[2][2][4][2], const Unit& u, int wr, int wc, int fr, int fq) const {
        const int c0 = 128 * u.pn + 32 * wc + 8 * fq;
        EPI_RS(rs)
        EPI_ROWS(f32x4 o[2];
            _Pragma("unroll") for (int n = 0; n < 2; ++n) _Pragma("unroll") for (int i = 0; i < 4; ++i) { const float g = acc[ai][0][m][n][i] * rs[ai][m], up = acc[ai][1][m][n][i] * rs[ai][m]; o[n][i] = fsilu(g) * up; }
            *(v4u*)(H + (unsigned)row * DFF + c0) = pack8(o[0], o[1]);)
    }
};
struct EpiLruIn {
    static constexpr bool PERM = true, AFTER_DRAIN = false;
    const float* ssq; bf16* YG; bf16* U;
    __device__ __forceinline__ void operator()(const f32x4 (&acc)[2][2][4][2], const Unit& u, int wr, int wc, int fr, int fq) const {
        const int cg = 256 * (u.pn & 3) + 32 * wc + 8 * fq;
        EPI_RS(rs)
        if (u.pn < 4) {
            EPI_ROWS(
                _Pragma("unroll") for (int bj = 0; bj < 2; ++bj) { f32x4 o[2];
                    _Pragma("unroll") for (int n = 0; n < 2; ++n) _Pragma("unroll") for (int i = 0; i < 4; ++i) { const float z = acc[ai][bj][m][n][i] * rs[ai][m];
                        o[n][i] = z * fsigmoid(1.5957691216057308f * (z + 0.044715f * z * z * z)); }
                    *(v4u*)(YG + (unsigned)row * D + cg + 128 * bj) = pack8(o[0], o[1]); })
        } else {
            EPI_ROWS(
                _Pragma("unroll") for (int bj = 0; bj < 2; ++bj)
                    *(v4u*)(U + (unsigned)row * D + cg + 128 * bj) = pack8(acc[ai][bj][m][0] * rs[ai][m], acc[ai][bj][m][1] * rs[ai][m]);)
        }
    }
};
struct EpiGates {
    static constexpr bool PERM = true, AFTER_DRAIN = false;
    const float* ba; const float* bx; const float* sp8  ; const bf16* UC; _Float16* LA; bf16* BI;
    __device__ __forceinline__ void operator()(const f32x4 (&acc)[2][2][4][2], const Unit& u, int wr, int wc, int fr, int fq) const {
        const int c0 = 128 * u.pn + 32 * wc + 8 * fq;
#pragma unroll
        for (int ai = 0; ai < 2; ++ai) {
            v4u uwq[4];
#pragma unroll
            for (int m = 0; m < 4; ++m) uwq[m] = *(const v4u*)(UC + (unsigned)(u.pm * 256 + ai * 128 + wr * 64 + m * 16 + fr) * D + c0);
#pragma unroll
            for (int n = 0; n < 2; ++n) { const f32x4 bav = *(const f32x4*)(ba + c0 + 4 * n), bxv = *(const f32x4*)(bx + c0 + 4 * n), spv = *(const f32x4*)(sp8 + c0 + 4 * n);
#pragma unroll
                for (int m = 0; m < 4; ++m) { const int row = u.pm * 256 + ai * 128 + wr * 64 + m * 16 + fr; f32x4 bi; typedef _Float16 h4 __attribute__((ext_vector_type(4))); h4 hv;
#pragma unroll
                    for (int i = 0; i < 4; ++i) { const unsigned w32 = uwq[m][2 * n + (i >> 1)]; const float ucv = __builtin_bit_cast(float, (i & 1) ? (w32 & 0xffff0000u) : (w32 << 16));
                        const float r = fsigmoid(acc[ai][0][m][n][i] + bav[i]), ig = fsigmoid(acc[ai][1][m][n][i] + bxv[i]);
                        const float lg = spv[i] * r, x = 2.0f * lg;
                        const float em = -x * (1.0f + x * (0.5f + x * (0.16666667f + x * (0.041666668f + x * (0.0083333338f + x * 0.0013888889f)))));
                        hv[i] = (_Float16)lg; bi[i] = __builtin_amdgcn_sqrtf(fmaxf(em, 0.0f)) * (ig * ucv); }
                    *(h4*)(LA + (unsigned)row * D + c0 + 4 * n) = hv;
                    u32x2v pk; pk.x = pg8::cvt_pk_bf16(bi[0], bi[1]); pk.y = pg8::cvt_pk_bf16(bi[2], bi[3]);
                    *(u32x2v*)(BI + (unsigned)row * D + c0 + 4 * n) = pk; } }
        }
    }
};
struct EpiNull {
    static constexpr bool PERM = true, AFTER_DRAIN = false;
    __device__ __forceinline__ void operator()(const f32x4 (&acc)[2][2][4][2], const Unit& u, int wr, int wc, int fr, int fq) const {
#pragma unroll
        for (int ai = 0; ai < 2; ++ai)
#pragma unroll
            for (int bj = 0; bj < 2; ++bj)
#pragma unroll
                for (int m = 0; m < 4; ++m)
#pragma unroll
                    for (int n = 0; n < 2; ++n) asm volatile("" :: "v"(acc[ai][bj][m][n]));
    }
};

template <int MODE> struct EpiFfnX {
    static constexpr bool PERM = true, AFTER_DRAIN = false;
    const float* ssq; bf16* H;
    __device__ __forceinline__ void operator()(const f32x4 (&acc)[2][2][4][2], const Unit& u, int wr, int wc, int fr, int fq) const {
        const int c0 = 128 * u.pn + 32 * wc + 8 * fq;
        float rs[2][4];
#pragma unroll
        for (int ai = 0; ai < 2; ++ai)
#pragma unroll
            for (int m = 0; m < 4; ++m) rs[ai][m] = MODE == 2 ? 1.0f : row_rstd(ssq, u.pm * 256 + ai * 128 + wr * 64 + m * 16 + fr);
        EPI_ROWS(f32x4 o[2];
            _Pragma("unroll") for (int n = 0; n < 2; ++n) _Pragma("unroll") for (int i = 0; i < 4; ++i) { const float g = acc[ai][0][m][n][i] * rs[ai][m], up = acc[ai][1][m][n][i] * rs[ai][m]; o[n][i] = MODE == 3 ? g + up : fsilu(g) * up; }
            const v4u w = pack8(o[0], o[1]);
            if (MODE == 1) asm volatile("" :: "v"(w)); else *(v4u*)(H + (unsigned)row * DFF + c0) = w;)
    }
};
typedef short s16x4 __attribute__((ext_vector_type(4)));
struct Args { const float* in[19]; float* out; unsigned char* ws; int ph_lo, ph_hi; };
static_assert(sizeof(Args) == 19 * 8 + 8 + 8 + 8, "Args has no padding");
__device__ __forceinline__ LAS unsigned char* lds_base() { extern __shared__ __attribute__((aligned(16))) unsigned char lds_dyn[]; return (LAS unsigned char*)lds_dyn; }
#define TID ((int)threadIdx.x)
#define LANE (TID & 63)
#define WAVE (__builtin_amdgcn_readfirstlane(TID >> 6))
#define GSZ ((int)gridDim.x)
#define VCU ((GSZ % 8 == 0) ? ((int)blockIdx.x % 8) * (GSZ / 8) + (int)blockIdx.x / 8 : (int)blockIdx.x)
#define LDSB (lds_base())
#define WSP(T, off) ((T*)(F.ws + (off)))
__device__ __forceinline__ float wave_sum(float v) {
#pragma unroll
    for (int o = 1; o < 64; o <<= 1) v += __shfl_xor(v, o);
    return v;
}
__device__ __forceinline__ void tr_item64(const float* W, int ldw, int k0, int ns0, bf16* WT, int ldt, int drow0, const float* ksc, LAS unsigned char* scr, int lane) {
    const int c = lane & 15, g = lane >> 4;
    f32x4 v[16];
    const float* src = W + (size_t)(k0 + 16 * g) * ldw + ns0 + 4 * c;
#pragma unroll
    for (int i = 0; i < 16; ++i) v[i] = *(const GAS f32x4*)(src + (size_t)i * ldw);
    if (ksc) {
#pragma unroll
        for (int q = 0; q < 4; ++q) { const f32x4 s = *(const GAS f32x4*)(ksc + k0 + 16 * g + 4 * q);
#pragma unroll
            for (int r = 0; r < 4; ++r) v[4 * q + r] = v[4 * q + r] * s[r]; }
    }
#pragma unroll
    for (int j = 0; j < 4; ++j) {
#pragma unroll
        for (int h = 0; h < 2; ++h) { v4u w; w.x = pk2(v[8 * h][j], v[8 * h + 1][j]); w.y = pk2(v[8 * h + 2][j], v[8 * h + 3][j]); w.z = pk2(v[8 * h + 4][j], v[8 * h + 5][j]); w.w = pk2(v[8 * h + 6][j], v[8 * h + 7][j]);
            *(LAS v4u*)(scr + (4 * c + j) * 128 + (((2 * g + h) ^ (c & 7)) * 16)) = w; }
    }
    LDS_WAIT(); asm volatile("" ::: "memory");
#pragma unroll
    for (int i = 0; i < 8; ++i) { const int n = (lane >> 3) + 8 * i, ch = lane & 7;
        const v4u x = *(const LAS v4u*)(scr + n * 128 + ((ch ^ ((n >> 2) & 7)) * 16));
        *(GAS v4u*)(WT + (size_t)(drow0 + n) * ldt + k0 + 8 * ch) = x; }
    LDS_WAIT(); asm volatile("" ::: "memory");
}
constexpr int CV_A = 1024, CV_B = 256, CV_F = 1408, CV_G = 704, CV_C = 512, CV_D = 256, CV_E = 128;
constexpr int CV_EARLY = CV_A + CV_B + CV_F, CV_ALL = CV_EARLY + CV_G + CV_C + CV_D + CV_E + CV_F + CV_G;
__device__ __forceinline__ void convert_items(const Args& F, int first, int last, int gw, int ngw) {
    LAS unsigned char* scr = LDSB + WAVE * 8192; const int lane = LANE;
    for (int it = first + gw; it < last; it += ngw) {
        int r = it;
        if (r < CV_A) { const int kb = r >> 6, nb = r & 63; tr_item64(F.in[4], 4096, 64 * kb, 64 * nb, WSP(bf16, WS_W_HIN), 1024, 64 * nb, F.in[1], scr, lane); continue; } r -= CV_A;
        if (r < CV_B) { const int kb = r >> 4, nb = r & 15; tr_item64(F.in[7], 1024, 64 * kb, 64 * nb, WSP(bf16, WS_W_HOUT), 1024, 64 * nb, nullptr, scr, lane); continue; } r -= CV_B;
        if (r < CV_F) { const int kb = r / 88, nb = r % 88, isup = nb >= 44 ? 1 : 0, j0 = 64 * (nb - 44 * isup);
            tr_item64(F.in[17], 5632, 64 * kb, 64 * nb, WSP(bf16, WS_W_FIN0), 1024, 256 * (j0 >> 7) + (j0 & 127) + 128 * isup, F.in[2], scr, lane); continue; } r -= CV_F;
        if (r < CV_G) { const int kb = r >> 4, nb = r & 15; tr_item64(F.in[18], 1024, 64 * kb, 64 * nb, WSP(bf16, WS_W_FOUT0), 2816, 64 * nb, nullptr, scr, lane); continue; } r -= CV_G;
        if (r < CV_C) { const int kb = r >> 5, nb = r & 31; tr_item64(F.in[8], 2048, 64 * kb, 64 * nb, WSP(bf16, WS_W_LIN), 1024, 64 * nb, F.in[1] + 1024, scr, lane); continue; } r -= CV_C;
        if (r < CV_D) { const int kb = r >> 4, nb = r & 15; tr_item64(F.in[16], 1024, 64 * kb, 64 * nb, WSP(bf16, WS_W_LOUT), 1024, 64 * nb, nullptr, scr, lane); continue; } r -= CV_D;
        if (r < CV_E) { const int isx = r >> 6, n = (r >> 4) & 3, kb = (r >> 2) & 3, nb = r & 3; const int ch0 = 256 * n + 64 * nb;
            tr_item64((isx ? F.in[13] : F.in[11]) + (size_t)n * 65536, 256, 64 * kb, 64 * nb, WSP(bf16, WS_W_GATE), 256, 256 * (ch0 >> 7) + (ch0 & 127) + 128 * isx, nullptr, scr, lane); continue; } r -= CV_E;
        if (r < CV_F) { const int kb = r / 88, nb = r % 88, isup = nb >= 44 ? 1 : 0, j0 = 64 * (nb - 44 * isup);
            tr_item64(F.in[17] + (size_t)1024 * 5632, 5632, 64 * kb, 64 * nb, WSP(bf16, WS_W_FIN1), 1024, 256 * (j0 >> 7) + (j0 & 127) + 128 * isup, F.in[2] + 1024, scr, lane); continue; } r -= CV_F;
        { const int kb = r >> 4, nb = r & 15; tr_item64(F.in[18] + (size_t)2816 * 1024, 1024, 64 * kb, 64 * nb, WSP(bf16, WS_W_FOUT1), 2816, 64 * nb, nullptr, scr, lane); }
    }
}
__device__ __forceinline__ void p0_prologue(const Args& F) {
    const int gw = VCU * NWAVES + WAVE, NGW = GSZ * NWAVES, lane = LANE;
    convert_items(F, 0, GSZ == 256 ? CV_EARLY : CV_ALL, gw, NGW);
    for (int m4 = gw; m4 < M / 4; m4 += NGW) {
        f32x4 v[4][4]; float s[4];
#pragma unroll
        for (int r = 0; r < 4; ++r) { const GAS f32x4* xr = (const GAS f32x4*)(F.in[0] + (size_t)(4 * m4 + r) * D) + lane;
#pragma unroll
            for (int j = 0; j < 4; ++j) v[r][j] = xr[64 * j]; }
#pragma unroll
        for (int r = 0; r < 4; ++r) { float a = 0.f;
#pragma unroll
            for (int j = 0; j < 4; ++j) a += (v[r][j].x * v[r][j].x + v[r][j].y * v[r][j].y) + (v[r][j].z * v[r][j].z + v[r][j].w * v[r][j].w);
            s[r] = wave_sum(a);
            GAS unsigned long long* o8 = (GAS unsigned long long*)(WSP(bf16, WS_XB) + (size_t)(4 * m4 + r) * D) + lane;
#pragma unroll
            for (int j = 0; j < 4; ++j) o8[64 * j] = (unsigned long long)pk2(v[r][j].x, v[r][j].y) | ((unsigned long long)pk2(v[r][j].z, v[r][j].w) << 32); }
        if (lane < 4) WSP(float, WS_SSQ)[4 * m4 + lane] = lane == 0 ? s[0] : (lane == 1 ? s[1] : (lane == 2 ? s[2] : s[3]));
    }
    { const int g = blockIdx.x * (NWAVES * 64) + TID; if (g < 1024) { const float l0 = F.in[5][g], l1 = F.in[5][1024 + g];
        WSP(float, WS_TAB)[g] = __builtin_amdgcn_rcpf(1.0f + __expf(l1 - l0)); WSP(float, WS_TAB)[1024 + g] = __builtin_amdgcn_rcpf(1.0f + __expf(l0 - l1));
        WSP(float, WS_TAB)[2048 + g] = -8.0f * log1pf(__expf(-F.in[15][g])); } }
}
__device__ __forceinline__ void hgrn_prep(const Args& F) {
    bf16* QT = WSP(bf16, WS_QT); bf16* KT = WSP(bf16, WS_KT); const float* LF = F.out; float* DEC = WSP(float, WS_DEC);
    for (int idx = blockIdx.x * (NWAVES * 64) + TID; idx < NCHUNK * 1024; idx += GSZ * NWAVES * 64) {
        const int c = idx >> 10, col = idx & 1023; float b = 0.f; size_t off = (size_t)c * CH * D + col;
#pragma unroll 8
        for (int s = 0; s < CH; ++s, off += D) { b += LF[off]; const float eb = __expf(b), enb = __expf(-b);
            QT[off] = (bf16)f2bf(bf2f(QT[off]) * eb); KT[off] = (bf16)f2bf(bf2f(KT[off]) * enb); }
        DEC[idx] = __expf(b);
    }
}
constexpr int TP = 272  , AP_ = 144  ;
constexpr int L_Q = 0, L_K = 17408, L_V = 34816, L_A = 52224, L_ST = 61440, L_RS = 96256;
__device__ __forceinline__ void stage_tile(LAS unsigned char* img, const bf16* src, int tid) {
#pragma unroll
    for (int i = 0; i < 2; ++i) { const int piece = tid + 512 * i, row = piece >> 4, pc = piece & 15;
        const v4u x = *(const GAS v4u*)(src + (size_t)row * D + pc * 8); *(LAS v4u*)(img + row * TP + pc * 16) = x; }
}
__device__ __forceinline__ bf16x8 frag_row(const LAS unsigned char* img, int pitch, int row0, int k0, int fr, int fq) {
    return *(const LAS bf16x8*)(img + (row0 + fr) * pitch + (k0 + 8 * fq) * 2);
}
__device__ __forceinline__ bf16x8 frag_tr(const LAS unsigned char* img, int pitch, int n0, int k0, int fr, int fq) {
    const int q = fr >> 2, p = fr & 3;
    const s16x4 lo = __builtin_amdgcn_ds_read_tr16_b64_v4i16((LAS s16x4*)(img + (k0 + 8 * fq + q) * pitch + (n0 + 4 * p) * 2));
    const s16x4 hi = __builtin_amdgcn_ds_read_tr16_b64_v4i16((LAS s16x4*)(img + (k0 + 8 * fq + 4 + q) * pitch + (n0 + 4 * p) * 2));
    return __builtin_shufflevector(lo, hi, 0, 1, 2, 3, 4, 5, 6, 7);
}
#define MFMA16(a, b, c) __builtin_amdgcn_mfma_f32_16x16x32_bf16((a), (b), (c), 0, 0, 0)
__device__ __forceinline__ void state_update(f32x4 (&S)[8], const LAS unsigned char* Ki, const LAS unsigned char* Vi, const float* decp, int w, int fr, int fq) {
#pragma unroll
    for (int ks = 0; ks < 2; ++ks) { const bf16x8 X = frag_tr(Ki, TP, 16 * w, 32 * ks, fr, fq);
#pragma unroll
        for (int vb = 0; vb < 8; ++vb) S[vb] = MFMA16(X, frag_tr(Vi, TP, 16 * vb, 32 * ks, fr, fq), S[vb]); }
    const f32x4 dv = *(const f32x4*)(decp + 16 * w + 4 * fq);
#pragma unroll
    for (int vb = 0; vb < 8; ++vb) S[vb] = S[vb] * dv;
}
__device__ __forceinline__ void hgrn_seg_state(const Args& F) {
    LAS unsigned char* Ki = LDSB + L_K; LAS unsigned char* Vi = LDSB + L_V;
    const int w = WAVE, fr = LANE & 15, fq = LANE >> 4;
    for (int unit = VCU; unit < NUNIT; unit += GSZ) {
        const int b = unit / (NH * NSEG), h = (unit / NSEG) % NH, seg = unit % NSEG;
        f32x4 S[8];
#pragma unroll
        for (int vb = 0; vb < 8; ++vb) S[vb] = (f32x4){0.f, 0.f, 0.f, 0.f};
        for (int c = 0; c < CPS; ++c) {
            const int cg = b * CPB + seg * CPS + c; const size_t r0 = (size_t)cg * CH;
            __syncthreads();
            stage_tile(Ki, WSP(bf16, WS_KT) + r0 * D + h * DK, TID); stage_tile(Vi, WSP(bf16, WS_V) + r0 * D + h * DK, TID);
            __syncthreads();
            state_update(S, Ki, Vi, WSP(float, WS_DEC) + (size_t)cg * D + h * DK, w, fr, fq);
        }
        float* sl = WSP(float, WS_SLOC) + (size_t)unit * 16384;
#pragma unroll
        for (int vb = 0; vb < 8; ++vb)
#pragma unroll
            for (int r = 0; r < 4; ++r) sl[(16 * w + 4 * fq + r) * 128 + 16 * vb + fr] = S[vb][r];
    }
}
__device__ __forceinline__ void hgrn_seg_scan(const Args& F) {
    float* SL = WSP(float, WS_SLOC); const float* DEC = WSP(float, WS_DEC);
    for (int idx = blockIdx.x * (NWAVES * 64) + TID; idx < BATCH * NH * 16384; idx += GSZ * NWAVES * 64) {
        const int bh = idx >> 14, kv = idx & 16383, k = kv >> 7, b = bh / NH, h = bh % NH; float S = 0.f;
        for (int seg = 0; seg < NSEG; ++seg) { float* p = SL + ((size_t)(bh * NSEG + seg) << 14) + kv; const float t = *p; *p = S;
            float dsg = 1.f; const float* dp = DEC + (size_t)(b * CPB + seg * CPS) * D + h * DK + k;
#pragma unroll
            for (int c = 0; c < CPS; ++c) dsg *= dp[(size_t)c * D];
            S = dsg * S + t; }
    }
}
__device__ __forceinline__ void hgrn_out(const Args& F) {
    LAS unsigned char* Qi = LDSB + L_Q; LAS unsigned char* Ki = LDSB + L_K; LAS unsigned char* Vi = LDSB + L_V; LAS unsigned char* Ai = LDSB + L_A; LAS unsigned char* STi = LDSB + L_ST;
    LAS float* RS = (LAS float*)(LDSB + L_RS);
    const int w = WAVE, fr = LANE & 15, fq = LANE >> 4, tb = w & 3, wh = w >> 2;
    const float* nw = F.in[6];
    for (int unit = VCU; unit < NUNIT; unit += GSZ) {
        const int b = unit / (NH * NSEG), h = (unit / NSEG) % NH, seg = unit % NSEG;
        f32x4 S[8];
        { const float* sl = WSP(float, WS_SLOC) + (size_t)unit * 16384;
#pragma unroll
          for (int vb = 0; vb < 8; ++vb)
#pragma unroll
            for (int r = 0; r < 4; ++r) S[vb][r] = sl[(16 * w + 4 * fq + r) * 128 + 16 * vb + fr]; }
        __syncthreads();
#pragma unroll
        for (int vb = 0; vb < 8; ++vb) { u32x2v pk; pk.x = pg8::cvt_pk_bf16(S[vb][0], S[vb][1]); pk.y = pg8::cvt_pk_bf16(S[vb][2], S[vb][3]);
            *(LAS u32x2v*)(STi + (16 * vb + fr) * TP + (16 * w + 4 * fq) * 2) = pk; }
        for (int c = 0; c < CPS; ++c) {
            const int cg = b * CPB + seg * CPS + c; const size_t r0 = (size_t)cg * CH;
            bf16* qg = WSP(bf16, WS_QT) + r0 * D + h * DK;
            stage_tile(Qi, qg, TID); stage_tile(Ki, WSP(bf16, WS_KT) + r0 * D + h * DK, TID); stage_tile(Vi, WSP(bf16, WS_V) + r0 * D + h * DK, TID);
            __syncthreads();
            bf16x8 Yq[4];
#pragma unroll
            for (int ks = 0; ks < 4; ++ks) Yq[ks] = frag_row(Qi, TP, 16 * tb, 32 * ks, fr, fq);
#pragma unroll
            for (int sbi = 0; sbi < 2; ++sbi) { const int sb = 2 * wh + sbi; f32x4 a = (f32x4){0.f, 0.f, 0.f, 0.f};
                if (sb <= tb) {
#pragma unroll
                    for (int ks = 0; ks < 4; ++ks) a = MFMA16(frag_row(Ki, TP, 16 * sb, 32 * ks, fr, fq), Yq[ks], a);
                }
                const int t = 16 * tb + fr, s0 = 16 * sb + 4 * fq;
#pragma unroll
                for (int r = 0; r < 4; ++r) a[r] = (s0 + r <= t) ? a[r] : 0.f;
                u32x2v pk; pk.x = pg8::cvt_pk_bf16(a[0], a[1]); pk.y = pg8::cvt_pk_bf16(a[2], a[3]);
                *(LAS u32x2v*)(Ai + t * AP_ + s0 * 2) = pk; }
            __syncthreads();
            bf16x8 Ya[2];
#pragma unroll
            for (int ks = 0; ks < 2; ++ks) Ya[ks] = frag_row(Ai, AP_, 16 * tb, 32 * ks, fr, fq);
            f32x4 o[4]; float ssq = 0.f;
#pragma unroll
            for (int j = 0; j < 4; ++j) { const int vb = 4 * wh + j; f32x4 a = (f32x4){0.f, 0.f, 0.f, 0.f};
#pragma unroll
                for (int ks = 0; ks < 4; ++ks) a = MFMA16(frag_row(STi, TP, 16 * vb, 32 * ks, fr, fq), Yq[ks], a);
#pragma unroll
                for (int ks = 0; ks < 2; ++ks) a = MFMA16(frag_tr(Vi, TP, 16 * vb, 32 * ks, fr, fq), Ya[ks], a);
                o[j] = a; ssq += (a[0] * a[0] + a[1] * a[1]) + (a[2] * a[2] + a[3] * a[3]); }
            ssq += __shfl_xor(ssq, 16); ssq += __shfl_xor(ssq, 32);
            if (fq == 0) RS[(16 * tb + fr) * 2 + wh] = ssq;
            state_update(S, Ki, Vi, WSP(float, WS_DEC) + (size_t)cg * D + h * DK, w, fr, fq);
            __syncthreads();
            { const int t = 16 * tb + fr; const float rstd = __builtin_amdgcn_rsqf((RS[t * 2] + RS[t * 2 + 1]) * (1.0f / DK) + EPS);
              const bf16* sgp = WSP(bf16, WS_SG) + (r0 + t) * D + h * DK;
#pragma unroll
              for (int j = 0; j < 4; ++j) { const int v0 = 16 * (4 * wh + j) + 4 * fq; const u32x2v sgw = *(const GAS u32x2v*)(sgp + v0); const f32x4 nv = *(const f32x4*)(nw + v0);
                  const float g0 = __builtin_bit_cast(float, sgw.x << 16), g1 = __builtin_bit_cast(float, sgw.x & 0xffff0000u), g2 = __builtin_bit_cast(float, sgw.y << 16), g3 = __builtin_bit_cast(float, sgw.y & 0xffff0000u);
                  u32x2v pk; pk.x = pg8::cvt_pk_bf16(o[j][0] * rstd * nv[0] * g0, o[j][1] * rstd * nv[1] * g1); pk.y = pg8::cvt_pk_bf16(o[j][2] * rstd * nv[2] * g2, o[j][3] * rstd * nv[3] * g3);
                  *(GAS u32x2v*)(qg + (size_t)t * D + v0) = pk; } }
#pragma unroll
            for (int vb = 0; vb < 8; ++vb) { u32x2v pk; pk.x = pg8::cvt_pk_bf16(S[vb][0], S[vb][1]); pk.y = pg8::cvt_pk_bf16(S[vb][2], S[vb][3]);
                *(LAS u32x2v*)(STi + (16 * vb + fr) * TP + (16 * w + 4 * fq) * 2) = pk; }
            __syncthreads();
        }
    }
}
__device__ __forceinline__ void lru_conv(const Args& F) {
    const bf16* U = WSP(bf16, WS_U); bf16* UC = WSP(bf16, WS_UC); const float* cw = F.in[9]; const float* cb = F.in[10];
    for (int idx = blockIdx.x * (NWAVES * 64) + TID; idx < M * (D / 8); idx += GSZ * NWAVES * 64) {
        const int row = idx >> 7, c0 = (idx & 127) * 8, t = row & (SEQ - 1); float a[8];
#pragma unroll
        for (int j = 0; j < 8; ++j) a[j] = cb[c0 + j];
#pragma unroll
        for (int tap = 0; tap < 4; ++tap) { const int dt = 3 - tap; if (t - dt >= 0) { const v4u uw = *(const GAS v4u*)(U + (size_t)(row - dt) * D + c0);
#pragma unroll
            for (int j = 0; j < 8; ++j) { const unsigned w32 = uw[j >> 1]; const float uv = __builtin_bit_cast(float, (j & 1) ? (w32 & 0xffff0000u) : (w32 << 16)); a[j] += uv * cw[tap * D + c0 + j]; } } }
        v4u o; o.x = pk2(a[0], a[1]); o.y = pk2(a[2], a[3]); o.z = pk2(a[4], a[5]); o.w = pk2(a[6], a[7]);
        *(GAS v4u*)(UC + (size_t)row * D + c0) = o;
    }
}
__device__ __forceinline__ void lru_scan_local(const Args& F) {
    const _Float16* LA = WSP(_Float16, WS_U); const bf16* BI = WSP(bf16, WS_BI); float* AP = WSP(float, WS_AP); float* HE = WSP(float, WS_HE);
    for (int idx = blockIdx.x * (NWAVES * 64) + TID; idx < NSC * D; idx += GSZ * NWAVES * 64) {
        const int sc = idx >> 10, ch = idx & 1023; size_t off = (size_t)sc * SCH * D + ch; float h = 0.f, sl = 0.f;
#pragma unroll 8
        for (int r = 0; r < SCH; ++r, off += D) { const float la = (float)LA[off]; h = __expf(la) * h + bf2f(BI[off]); sl += la; }
        AP[idx] = __expf(sl); HE[idx] = h;
    }
}
__device__ __forceinline__ void lru_scan_apply(const Args& F) {
    const _Float16* LA = WSP(_Float16, WS_U); const bf16* BI = WSP(bf16, WS_BI); const bf16* YG = WSP(bf16, WS_YG); bf16* HY = WSP(bf16, WS_UC);
    const float* AP = WSP(float, WS_AP); const float* HE = WSP(float, WS_HE);
    for (int idx = blockIdx.x * (NWAVES * 64) + TID; idx < NSC * D; idx += GSZ * NWAVES * 64) {
        const int sc = idx >> 10, ch = idx & 1023, sc0 = (sc / SCPB) * SCPB; float h = 0.f;
        for (int j = sc0; j < sc; ++j) h = AP[j * D + ch] * h + HE[j * D + ch];
        size_t off = (size_t)sc * SCH * D + ch;
#pragma unroll 8
        for (int r = 0; r < SCH; ++r, off += D) { h = __expf((float)LA[off]) * h + bf2f(BI[off]); HY[off] = (bf16)f2bf(h * bf2f(YG[off])); }
    }
}
__device__ __forceinline__ void final_norm(const Args& F) {
    const int gw = VCU * NWAVES + WAVE, NGW = GSZ * NWAVES; const float* nf = F.in[3];
    for (int m = gw; m < M; m += NGW) { const float rs = row_rstd(WSP(float, WS_SSQ) + 4 * M, m); GAS f32x4* xr = (GAS f32x4*)(F.out + (size_t)m * D) + LANE;
#pragma unroll
        for (int j = 0; j < 4; ++j) { const f32x4 w = *((const f32x4*)nf + LANE + 64 * j); xr[64 * j] = xr[64 * j] * rs * w; } }
}
#ifndef MK_N_LAUNCHES
#define MK_N_LAUNCHES 1
#endif
constexpr int N_PHASES = 18;
#ifndef ONLY_PHASE
#define ONLY_PHASE -1
#endif
#ifndef EXTRA_PHASE
#define EXTRA_PHASE 0
#endif
#ifndef PROBE_MASK
#define PROBE_MASK 0u
#endif
#ifndef PROBE_MASK2
#define PROBE_MASK2 0u
#endif
#define GEMM_RUN(EPI, g, nM_, nN_, E) do { pg8::StaticOrder S_; S_.init(nM_, nN_, GSZ, (int)blockIdx.x); pg8::gemm_phase<EPI, pg8::StaticOrder, true, true>(LDSB, g, S_, E); } while (0)
__global__ void __launch_bounds__(NWAVES * 64, 2) trunk_fwd(Args args) {
    const Args& F = args;
    volatile LAS unsigned* MISC = (volatile LAS unsigned*)(LDSB + MISC_OFF);
    gu32* ctl = (gu32*)(args.ws + WS_CTL);
    for (int u = TID; u < (LDS_BYTES - LDSCTL_OFF) / 4; u += NWAVES * 64) ((LAS unsigned*)(LDSB + LDSCTL_OFF))[u] = 0u;
    __syncthreads();
    XcdBarrier bar; bar.bar = (unsigned*)(ctl + CW_BAR); bar.x = 0; bar.st = nullptr;
    if (MK_N_LAUNCHES == 1) bar = xcd_barrier_post((unsigned*)(ctl + CW_BAR), MISC + 8);
    const int lo = args.ph_lo, hi = args.ph_hi;
#define IN(k) ((ONLY_PHASE < 0 || ONLY_PHASE == (k)) && lo <= (k) && (k) < hi)
    unsigned long long tacc = 0ull, tacc2 = 0ull, tph = 0ull;
#define PB(k) do { if (((PROBE_MASK | PROBE_MASK2) >> (k)) & 1u) tph = rt(); } while (0)
#define SEAM(k) do { if (IN(k) && IN((k) + 1)) xcd_barrier(bar); if ((PROBE_MASK >> (k)) & 1u) tacc += rt() - tph; if ((PROBE_MASK2 >> (k)) & 1u) tacc2 += rt() - tph; } while (0)
    bf16* XB = WSP(bf16, WS_XB); float* SSQ = WSP(float, WS_SSQ);
    PB(0); if (IN(0)) { p0_prologue(F); } SEAM(0);
    PB(1); if (IN(1)) { pg8::Gemm g{XB, WSP(bf16, WS_W_HIN), D, D, D, 0};
        EpiHgrnIn E{SSQ, WSP(float, WS_TAB), WSP(float, WS_TAB) + 1024, WSP(bf16, WS_QT), WSP(bf16, WS_KT), WSP(bf16, WS_V), WSP(bf16, WS_SG), F.out};
        GEMM_RUN(EpiHgrnIn, g, M / 256, 16, E); } SEAM(1);
    PB(2); if (IN(2)) { hgrn_prep(F); } SEAM(2);
    PB(3); if (IN(3)) { hgrn_seg_state(F); } SEAM(3);
    PB(4); if (IN(4)) { hgrn_seg_scan(F); } SEAM(4);
    PB(5); if (IN(5)) { hgrn_out(F); } SEAM(5);
    PB(6); if (IN(6)) { pg8::Gemm g{WSP(bf16, WS_QT), WSP(bf16, WS_W_HOUT), D, D, D, 0}; EpiRes<false> E{XB, nullptr, SSQ + M}; GEMM_RUN(EpiRes<false>, g, M / 256, 4, E); } SEAM(6);
    PB(7); if (IN(7)) { pg8::Gemm g{XB, WSP(bf16, WS_W_FIN0), D, D, D, 0}; EpiFfnIn E{SSQ + M, WSP(bf16, WS_H)}; GEMM_RUN(EpiFfnIn, g, M / 256, 22, E);
        if (GSZ == 256 && blockIdx.x >= 128) convert_items(F, CV_EARLY, CV_ALL, ((int)blockIdx.x - 128) * NWAVES + WAVE, 128 * NWAVES); } SEAM(7);
    PB(8); if (IN(8)) { pg8::Gemm g{WSP(bf16, WS_H), WSP(bf16, WS_W_FOUT0), DFF, DFF, DFF, 0}; EpiRes<false> E{XB, nullptr, SSQ + 2 * M}; GEMM_RUN(EpiRes<false>, g, M / 256, 4, E); } SEAM(8);
    PB(9); if (IN(9)) { pg8::Gemm g{XB, WSP(bf16, WS_W_LIN), D, D, D, 0}; EpiLruIn E{SSQ + 2 * M, WSP(bf16, WS_YG), WSP(bf16, WS_U)}; GEMM_RUN(EpiLruIn, g, M / 256, 8, E); } SEAM(9);
    PB(10); if (IN(10)) { lru_conv(F); } SEAM(10);
    PB(11); if (IN(11)) { int kg = 256; asm volatile("" : "+s"(kg));
        pg8::Gemm g{WSP(bf16, WS_UC), WSP(bf16, WS_W_GATE), D, 256, kg, 1};
        EpiGates E{F.in[12], F.in[14], WSP(float, WS_TAB) + 2048, WSP(bf16, WS_UC), WSP(_Float16, WS_U), WSP(bf16, WS_BI)}; GEMM_RUN(EpiGates, g, M / 256, 8, E); } SEAM(11);
    PB(12); if (IN(12)) { lru_scan_local(F); } SEAM(12);
    PB(13); if (IN(13)) { lru_scan_apply(F); } SEAM(13);
    PB(14); if (IN(14)) { pg8::Gemm g{WSP(bf16, WS_UC), WSP(bf16, WS_W_LOUT), D, D, D, 0}; EpiRes<false> E{XB, nullptr, SSQ + 3 * M}; GEMM_RUN(EpiRes<false>, g, M / 256, 4, E); } SEAM(14);
    PB(15); if (IN(15)) { pg8::Gemm g{XB, WSP(bf16, WS_W_FIN1), D, D, D, 0}; EpiFfnIn E{SSQ + 3 * M, WSP(bf16, WS_H)}; GEMM_RUN(EpiFfnIn, g, M / 256, 22, E); } SEAM(15);
    PB(16); if (IN(16)) { pg8::Gemm g{WSP(bf16, WS_H), WSP(bf16, WS_W_FOUT1), DFF, DFF, DFF, 0}; EpiRes<true> E{XB, F.out, SSQ + 4 * M}; GEMM_RUN(EpiRes<true>, g, M / 256, 4, E); } SEAM(16);
    PB(17); if (IN(17)) { final_norm(F); }
    if ((PROBE_MASK >> 17) & 1u) tacc += rt() - tph;
    if ((PROBE_MASK2 >> 17) & 1u) tacc2 += rt() - tph;
    if (EXTRA_PHASE != 0) { xcd_barrier(bar); tph = rt();
        if (EXTRA_PHASE == 1) { pg8::Gemm g{XB, WSP(bf16, WS_W_FIN1), D, D, D, 0}; EpiNull E{}; GEMM_RUN(EpiNull, g, M / 256, 22, E); }
        if (EXTRA_PHASE == 2) { pg8::Gemm g{XB, WSP(bf16, WS_W_FIN1), D, D, D, 0}; EpiFfnIn E{SSQ + 3 * M, WSP(bf16, WS_H)}; GEMM_RUN(EpiFfnIn, g, M / 256, 22, E); }
        if (EXTRA_PHASE == 3) { pg8::Gemm g{XB, WSP(bf16, WS_W_FIN1), D, D, D, 0}; EpiNull E{}; GEMM_RUN(EpiNull, g, M / 256, 20, E); }
        if (EXTRA_PHASE == 4) { pg8::Gemm g{XB, WSP(bf16, WS_W_FIN1), D, D, D, 0}; EpiFfnX<1> E{SSQ + 3 * M, WSP(bf16, WS_H)}; GEMM_RUN(EpiFfnX<1>, g, M / 256, 22, E); }
        if (EXTRA_PHASE == 5) { pg8::Gemm g{XB, WSP(bf16, WS_W_FIN1), D, D, D, 0}; EpiFfnX<2> E{SSQ + 3 * M, WSP(bf16, WS_H)}; GEMM_RUN(EpiFfnX<2>, g, M / 256, 22, E); }
        if (EXTRA_PHASE == 6) { pg8::Gemm g{XB, WSP(bf16, WS_W_FIN1), D, D, D, 0}; EpiFfnX<3> E{SSQ + 3 * M, WSP(bf16, WS_H)}; GEMM_RUN(EpiFfnX<3>, g, M / 256, 22, E); }
        xcd_barrier(bar); tacc += rt() - tph; }
    if ((PROBE_MASK | PROBE_MASK2 | (unsigned)EXTRA_PHASE) != 0u && blockIdx.x == 0 && TID == 0) { const unsigned long long te = rt() + 4ull * tacc + 100000ull * ((tacc2 + 50ull) / 100ull); while (rt() < te) __builtin_amdgcn_s_sleep(32); }
#undef IN
#undef SEAM
}

extern "C" void kernel_launch(void* const* d_in, const int* in_sizes, int n_in, void* d_out, int out_size, void* d_ws, size_t ws_size, hipStream_t stream) {
    static int grid = 0;
    if (grid == 0) {
        if (n_in != 19 || in_sizes[0] != M * D || out_size != M * D || ws_size < WS_END) { fprintf(stderr, "kernel_launch: unexpected shapes: n_in %d in0 %d out %d ws %zu (need %zu); nothing launched\n", n_in, n_in > 0 ? in_sizes[0] : -1, out_size, ws_size, (size_t)WS_END); grid = -1; return; }
        int dev = 0, cus = 0, per_cu = 0;
        if (hipGetDevice(&dev) != hipSuccess || hipDeviceGetAttribute(&cus, hipDeviceAttributeMultiprocessorCount, dev) != hipSuccess) { fprintf(stderr, "kernel_launch: device query failed\n"); grid = -1; return; }
        if (hipFuncSetAttribute((const void*)trunk_fwd, hipFuncAttributeMaxDynamicSharedMemorySize, LDS_BYTES) != hipSuccess) { fprintf(stderr, "kernel_launch: hipFuncSetAttribute failed\n"); grid = -1; return; }
        if (hipOccupancyMaxActiveBlocksPerMultiprocessor(&per_cu, (const void*)trunk_fwd, NWAVES * 64, LDS_BYTES) != hipSuccess || per_cu < 1) { fprintf(stderr, "kernel_launch: occupancy query says %d blocks per CU\n", per_cu); }
        (void)hipGetLastError();
        grid = cus;
        fprintf(stderr, "kernel_launch: grid %d, per_cu %d, ws %zu\n", grid, per_cu, ws_size);
    }
    if (grid < 0) return;
    if (hipMemsetAsync((char*)d_ws + WS_CTL, 0, CTL_ZERO_BYTES, stream) != hipSuccess) { fprintf(stderr, "kernel_launch: memset failed\n"); return; }
    Args a{};
    for (int i = 0; i < 19; ++i) a.in[i] = (const float*)d_in[i];
    a.out = (float*)d_out; a.ws = (unsigned char*)d_ws;
    for (int li = 0; li < MK_N_LAUNCHES; ++li) {
        a.ph_lo = (MK_N_LAUNCHES == 1) ? 0 : li; a.ph_hi = (MK_N_LAUNCHES == 1) ? N_PHASES : li + 1;
        hipLaunchKernelGGL(trunk_fwd, dim3(grid), dim3(NWAVES * 64), LDS_BYTES, stream, a);
        const hipError_t le = hipPeekAtLastError();
        if (le != hipSuccess) { fprintf(stderr, "kernel_launch: launch %d failed: %s\n", li, hipGetErrorName(le)); break; }
    }
}
```

```cpp
#include <hip/hip_runtime.h>
#include <cstdio>
#include <cstdint>
namespace pg8 {
#define PG8_LAS __attribute__((address_space(3)))
typedef unsigned short bf16_t;
typedef short bf16x8 __attribute__((ext_vector_type(8)));
typedef float f32x4 __attribute__((ext_vector_type(4)));
typedef unsigned u32x4 __attribute__((ext_vector_type(4)));
constexpr int BM = 256, BK = 64, HALF = 128, HTB = HALF * BK * 2  , STAGE_BYTES = 8 * HTB, NXCD = 8, WGM = 8;

__host__ __device__ __forceinline__ int lds_byte(int r, int c) { const int st = (r >> 4) * 2 + (c >> 5), rr = r & 15, cc = c & 31, ob = rr * 64 + cc * 2; return st * 1024 + (ob ^ (((ob >> 9) & 1) << 5)); }
__host__ __device__ __forceinline__ void stage_rc(int b, int& R, int& C) { const int st = b / 1024, sb = b % 1024, swz = sb ^ (((sb >> 9) & 1) << 5); R = (st >> 1) * 16 + swz / 64; C = (st & 1) * 32 + (swz % 64) / 2; }
__host__ __device__ __forceinline__ int perm32(int rho) { const int n = rho >> 4, i = rho & 15; return 8 * (i >> 2) + 4 * n + (i & 3); }

struct Unit { int pm, pn; };
struct Gemm { const bf16_t* A; const bf16_t* Bt; int lda, ldb, K, ablk; };

struct StaticOrder {
    int nM, nN, nwg, G, c;
    __host__ __device__ void init(int nM_, int nN_, int G_, int c_) { nM = nM_; nN = nN_; nwg = nM * nN; G = G_; c = c_; }
    __host__ __device__ bool next(int i, Unit& u) const {
        const long L = (long)i * G + c; if (L >= nwg) return false;
        int wgid = (int)L; { const int q = nwg / NXCD, r = nwg % NXCD, xcd = wgid % NXCD, off = wgid / NXCD; wgid = (xcd < r ? xcd * (q + 1) : r * (q + 1) + (xcd - r) * q) + off; }
        const int nig = WGM * nN, gid = wgid / nig, fm = gid * WGM, gsz = (nM - fm) < WGM ? (nM - fm) : WGM;
        u.pm = fm + ((wgid % nig) % gsz); u.pn = (wgid % nig) / gsz; return true;
    }
    __device__ __forceinline__ void a_ready(const Unit&) const {}
    __device__ __forceinline__ void done(const Unit&) const {}
};
__device__ __forceinline__ unsigned cvt_pk_bf16(float lo, float hi) { unsigned r; asm volatile("v_cvt_pk_bf16_f32 %0, %1, %2" : "=v"(r) : "v"(lo), "v"(hi)); return r; }
template <class Epi, class Sched, bool ALIGN_EPI = false, bool SP2 = false>
__device__ __forceinline__ void gemm_phase(PG8_LAS unsigned char* lds, const Gemm g, const Sched& S, const Epi& E) {
    const int tid = threadIdx.x, wid = __builtin_amdgcn_readfirstlane(tid >> 6), lane = tid & 63, wr = wid >> 2, wc = wid & 3, fr = lane & 15, fq = lane >> 4;
    const int K = g.K, nt = K / BK;
    unsigned voffA[2], voffB[2];
#pragma unroll
    for (int i = 0; i < 2; ++i) { int R, C; stage_rc(tid * 16 + i * 8192, R, C); const int Rb = Epi::PERM ? ((R & ~31) + perm32(R & 31)) : R;
        voffA[i] = (unsigned)(R * g.lda + C) * 2u; voffB[i] = (unsigned)(Rb * g.ldb + C) * 2u; }
    const size_t kstep = (size_t)(BK * 2);
    const size_t hstepA = (size_t)HALF * g.lda * 2, hstepB = (size_t)HALF * g.ldb * 2;
    const unsigned ldsw = (unsigned)wid * 1024u;
    const int aoff = lds_byte(wr * 64 + fr, fq * 8), boff = lds_byte(wc * 32 + fr, fq * 8);
#define PG8_UA(u) ((const char*)g.A + (size_t)(u).pm * 2 * hstepA + (g.ablk ? (size_t)((u).pn >> 1) * 512 : (size_t)0))
#define PG8_UB(u) ((const char*)g.Bt + (size_t)(u).pn * 2 * hstepB)
#define PG8_SA(b, h) (((b) * 2 + (h)) * HTB)
#define PG8_SB(b, h) ((4 + (b) * 2 + (h)) * HTB)
#define PG8_STAGE(bufoff, gbase, voff) do { _Pragma("unroll") for (int _i = 0; _i < 2; ++_i) \
        __builtin_amdgcn_global_load_lds((const unsigned*)((const char*)(gbase) + (voff)[_i]), (PG8_LAS unsigned*)(lds + (bufoff) + ldsw + _i * 8192), 16, 0, 0); } while (0)
#define PG8_LDA(dst, b, h) do { _Pragma("unroll") for (int m = 0; m < 4; ++m) _Pragma("unroll") for (int k = 0; k < 2; ++k) dst[m][k] = *(const PG8_LAS bf16x8*)(lds + PG8_SA(b, h) + aoff + m * 2048 + k * 1024); } while (0)
#define PG8_LDB(dst, b, h) do { _Pragma("unroll") for (int n = 0; n < 2; ++n) _Pragma("unroll") for (int k = 0; k < 2; ++k) dst[n][k] = *(const PG8_LAS bf16x8*)(lds + PG8_SB(b, h) + boff + n * 2048 + k * 1024); } while (0)
#define PG8_MMA(ai, bj, At, Bt) do { __builtin_amdgcn_s_setprio(1); _Pragma("unroll") for (int m = 0; m < 4; ++m) _Pragma("unroll") for (int n = 0; n < 2; ++n) _Pragma("unroll") for (int k = 0; k < 2; ++k) \
        acc[ai][bj][m][n] = __builtin_amdgcn_mfma_f32_16x16x32_bf16(Bt[n][k], At[m][k], acc[ai][bj][m][n], 0, 0, 0); __builtin_amdgcn_s_setprio(0); } while (0)
#define PG8_WAIT_V(n) asm volatile("s_waitcnt vmcnt(" #n ")" ::: "memory")
#define PG8_WAIT_L(n) asm volatile("s_waitcnt lgkmcnt(" #n ")" ::: "memory")
#define PG8_BAR __builtin_amdgcn_s_barrier()
#define PG8_SCHED __builtin_amdgcn_sched_barrier(0)
    Unit cur, nxt; int ui = 0;
    if (!S.next(0, cur)) return;
    f32x4 acc[2][2][4][2];
#pragma unroll
    for (int a = 0; a < 2; ++a)
#pragma unroll
        for (int b = 0; b < 2; ++b)
#pragma unroll
            for (int m = 0; m < 4; ++m)
#pragma unroll
                for (int n = 0; n < 2; ++n) acc[a][b][m][n] = (f32x4){0.f, 0.f, 0.f, 0.f};
    bf16x8 At[4][2], B0[2][2], B1[2][2];
    const char* cA = PG8_UA(cur); const char* cB = PG8_UB(cur);
    S.a_ready(cur);
    if constexpr (SP2) {
        PG8_STAGE(PG8_SB(0, 0), cB, voffB); PG8_STAGE(PG8_SB(0, 1), cB + hstepB, voffB); PG8_STAGE(PG8_SA(0, 0), cA, voffA); PG8_STAGE(PG8_SA(0, 1), cA + hstepA, voffA);
        if (wr == 1) PG8_BAR;
        PG8_WAIT_V(2); PG8_BAR;
        PG8_STAGE(PG8_SB(1, 0), cB + kstep, voffB); PG8_STAGE(PG8_SA(1, 0), cA + kstep, voffA); PG8_STAGE(PG8_SB(1, 1), cB + hstepB + kstep, voffB);
        PG8_WAIT_V(6); PG8_BAR;
    } else {
        PG8_STAGE(PG8_SB(0, 0), cB, voffB); PG8_STAGE(PG8_SA(0, 0), cA, voffA); PG8_STAGE(PG8_SB(0, 1), cB + hstepB, voffB); PG8_STAGE(PG8_SA(0, 1), cA + hstepA, voffA);
        if (wr == 1) PG8_BAR;
        PG8_WAIT_V(4); PG8_BAR;
        PG8_STAGE(PG8_SB(1, 0), cB + kstep, voffB); PG8_STAGE(PG8_SA(1, 0), cA + kstep, voffA); PG8_STAGE(PG8_SB(1, 1), cB + hstepB + kstep, voffB);
        PG8_WAIT_V(6); PG8_BAR;
    }
    for (;;) {
        const bool has_next = S.next(ui + 1, nxt);
        const char* nA = has_next ? PG8_UA(nxt) : cA; const char* nB = has_next ? PG8_UB(nxt) : cB;
        for (int t = 0; t < nt; t += 2) {
            const bool last = (t == nt - 2);
            const char* a1 = cA + (size_t)(t + 1) * kstep;
            const char* a2 = last ? nA : cA + (size_t)(t + 2) * kstep; const char* b2 = last ? nB : cB + (size_t)(t + 2) * kstep;
            const char* a3 = a2 + kstep; const char* b3 = b2 + kstep;
            if (last && has_next) S.a_ready(nxt);
            if constexpr (SP2) {
            PG8_LDB(B0, 0, 0); PG8_LDB(B1, 0, 1); PG8_SCHED; PG8_LDA(At, 0, 0); PG8_STAGE(PG8_SA(1, 1), a1 + hstepA, voffA);
            PG8_WAIT_V(8); PG8_WAIT_L(0); PG8_BAR; PG8_MMA(0, 0, At, B0); PG8_MMA(0, 1, At, B1); PG8_BAR; PG8_SCHED;
            PG8_LDA(At, 0, 1); PG8_STAGE(PG8_SB(0, 0), b2, voffB); PG8_STAGE(PG8_SB(0, 1), b2 + hstepB, voffB); PG8_STAGE(PG8_SA(0, 0), a2, voffA);
            PG8_WAIT_V(8); PG8_WAIT_L(0); PG8_BAR; PG8_MMA(1, 0, At, B0); PG8_MMA(1, 1, At, B1); PG8_BAR; PG8_SCHED;
            PG8_LDB(B0, 1, 0); PG8_LDB(B1, 1, 1); PG8_SCHED; PG8_LDA(At, 1, 0); PG8_STAGE(PG8_SA(0, 1), a2 + hstepA, voffA);
            PG8_WAIT_V(8); PG8_WAIT_L(0); PG8_BAR; PG8_MMA(0, 0, At, B0); PG8_MMA(0, 1, At, B1); PG8_BAR; PG8_SCHED;
            PG8_LDA(At, 1, 1); PG8_STAGE(PG8_SB(1, 0), b3, voffB); PG8_STAGE(PG8_SB(1, 1), b3 + hstepB, voffB); PG8_STAGE(PG8_SA(1, 0), a3, voffA);
            PG8_WAIT_V(8); PG8_WAIT_L(0); PG8_BAR; PG8_MMA(1, 0, At, B0); PG8_MMA(1, 1, At, B1); PG8_BAR; PG8_SCHED;
            } else {
            PG8_LDB(B0, 0, 0); PG8_SCHED; PG8_LDA(At, 0, 0); PG8_STAGE(PG8_SA(1, 1), a1 + hstepA, voffA);
            PG8_WAIT_L(8); PG8_BAR; PG8_WAIT_L(0); PG8_MMA(0, 0, At, B0); PG8_BAR; PG8_SCHED;
            PG8_LDB(B1, 0, 1); PG8_STAGE(PG8_SB(0, 0), b2, voffB);
            PG8_BAR; PG8_WAIT_L(0); PG8_MMA(0, 1, At, B1); PG8_BAR;
            PG8_LDA(At, 0, 1); PG8_STAGE(PG8_SA(0, 0), a2, voffA);
            PG8_BAR; PG8_WAIT_L(0); PG8_MMA(1, 0, At, B0); PG8_BAR; PG8_SCHED;
            PG8_STAGE(PG8_SB(0, 1), b2 + hstepB, voffB);
            PG8_WAIT_V(6); PG8_BAR; PG8_MMA(1, 1, At, B1); PG8_BAR;
            PG8_LDB(B0, 1, 0); PG8_SCHED; PG8_LDA(At, 1, 0); PG8_STAGE(PG8_SA(0, 1), a2 + hstepA, voffA);
            PG8_WAIT_L(8); PG8_BAR; PG8_WAIT_L(0); PG8_MMA(0, 0, At, B0); PG8_BAR; PG8_SCHED;
            PG8_LDB(B1, 1, 1); PG8_STAGE(PG8_SB(1, 0), b3, voffB);
            PG8_BAR; PG8_WAIT_L(0); PG8_MMA(0, 1, At, B1); PG8_BAR;
            PG8_LDA(At, 1, 1); PG8_STAGE(PG8_SA(1, 0), a3, voffA);
            PG8_BAR; PG8_WAIT_L(0); PG8_MMA(1, 0, At, B0); PG8_BAR; PG8_SCHED;
            PG8_STAGE(PG8_SB(1, 1), b3 + hstepB, voffB);
            PG8_WAIT_V(6); PG8_BAR; PG8_MMA(1, 1, At, B1); PG8_BAR;
            }
        }
        if constexpr (ALIGN_EPI) { if (wr == 0) PG8_BAR; }
        if constexpr (!Epi::AFTER_DRAIN) { E(acc, cur, wr, wc, fr, fq); S.done(cur); }
        if (!has_next) break;
#pragma unroll
        for (int a = 0; a < 2; ++a)
#pragma unroll
            for (int b = 0; b < 2; ++b)
#pragma unroll
                for (int m = 0; m < 4; ++m)
#pragma unroll
                    for (int n = 0; n < 2; ++n) acc[a][b][m][n] = (f32x4){0.f, 0.f, 0.f, 0.f};
        cur = nxt; cA = nA; cB = nB; ++ui;
        if constexpr (ALIGN_EPI) { if (wr == 1) PG8_BAR; }
    }
    PG8_WAIT_V(0);
    if constexpr (!ALIGN_EPI) { if (wr == 0) PG8_BAR; }
    PG8_BAR;
    if constexpr (Epi::AFTER_DRAIN) { E.fused(acc, cur, wr, wc, fr, fq, lds, wid, lane); S.done(cur); }
#undef PG8_UA
#undef PG8_UB
#undef PG8_SA
#undef PG8_SB
#undef PG8_STAGE
#undef PG8_LDA
#undef PG8_LDB
#undef PG8_MMA
#undef PG8_WAIT_V
#undef PG8_WAIT_L
#undef PG8_BAR
#undef PG8_SCHED
}
}
#define GAS __attribute__((address_space(1)))
#define LAS __attribute__((address_space(3)))
typedef unsigned short bf16;
typedef unsigned v4u __attribute__((ext_vector_type(4)));
typedef float f32x4 __attribute__((ext_vector_type(4)));
typedef short bf16x8 __attribute__((ext_vector_type(8)));
typedef GAS unsigned gu32;
typedef GAS unsigned long long gu64;
#define RLX_AGENT __ATOMIC_RELAXED, __HIP_MEMORY_SCOPE_AGENT
#define LDS_WAIT() asm volatile("s_waitcnt lgkmcnt(0)" ::: "memory")
#define VM_WAIT() asm volatile("s_waitcnt vmcnt(0)" ::: "memory")
__device__ __forceinline__ unsigned long long rt() { return __builtin_amdgcn_s_memrealtime(); }
__device__ __forceinline__ unsigned f2bf(float f) { unsigned u = __builtin_bit_cast(unsigned, f); return (u + 0x7fffu + ((u >> 16) & 1u)) >> 16; }
__device__ __forceinline__ unsigned pk2(float lo, float hi) { return f2bf(lo) | (f2bf(hi) << 16); }

#define XB_TMO      128
#define XB_XCNT(j)  (256  + 64 * (j))
#define XB_XSUB(j)  (1280 + 64 * (j))
#define XB_XGEN(j)  (2304 + 64 * (j))
#define XB_TOP      3328
#define XB_TOPGEN   3392
#define XCD_BAR_WORDS 3456
#define XB_SPIN_CAP (1u << 18)

__device__ __forceinline__ unsigned xb_ld(unsigned* p)              { return __hip_atomic_load(p, __ATOMIC_RELAXED, __HIP_MEMORY_SCOPE_AGENT); }
__device__ __forceinline__ unsigned xb_add(unsigned* p, unsigned v) { return __hip_atomic_fetch_add(p, v, __ATOMIC_RELAXED, __HIP_MEMORY_SCOPE_AGENT); }
__device__ __forceinline__ unsigned xb_xcc_id() { return (unsigned)__builtin_amdgcn_s_getreg((3 << 11) | 20) & 0xFu; }
#define XB_SPIN(cond, bar) do { unsigned _sp = 0; while (cond) { __builtin_amdgcn_s_sleep(1); \
    if ((++_sp & 255u) == 0u) { if (xb_ld(&(bar)[XB_TMO])) break; if (_sp > XB_SPIN_CAP) { atomicAdd(&(bar)[XB_TMO], 1u); break; } } } } while (0)

struct XcdBarrier {
    unsigned* bar; unsigned x;
    volatile LAS unsigned* st;
};

__device__ __forceinline__ XcdBarrier xcd_barrier_post(unsigned* bar, volatile LAS unsigned* st) {
    XcdBarrier b; b.bar = bar; b.x = xb_xcc_id(); b.st = st;
    if (threadIdx.x == 0) (void)xb_add(&bar[XB_XCNT(b.x)], 1u);
    return b;
}
__device__ __forceinline__ void xcd_barrier_complete(unsigned* bar, unsigned x, unsigned& nloc, unsigned& nx) {
    const unsigned G = gridDim.x * gridDim.y * gridDim.z;
    unsigned sum, cnt, mine, sp = 0u;
    for (;;) {
        sum = 0u; cnt = 0u; mine = 0u;
#pragma unroll
        for (unsigned j = 0; j < 16; ++j) { const unsigned c = xb_ld(&bar[XB_XCNT(j)]); sum += c; cnt += (c > 0u) ? 1u : 0u; mine = (j == x) ? c : mine; }
        if (sum == G) break;
        __builtin_amdgcn_s_sleep(1);
        if ((++sp & 255u) == 0u) { if (xb_ld(&bar[XB_TMO])) break; if (sp > XB_SPIN_CAP) { atomicAdd(&bar[XB_TMO], 1u); break; } }
    }
    nloc = mine > 0u ? mine : 1u; nx = cnt > 0u ? cnt : 1u;
}

__device__ __forceinline__ void xcd_barrier(const XcdBarrier& b) {
    asm volatile("s_waitcnt vmcnt(0)" ::: "memory");
    __syncthreads();
    if (threadIdx.x == 0) {
        unsigned* bar = b.bar;
        __builtin_amdgcn_s_waitcnt(0);
        unsigned nloc = b.st[0], nx = b.st[1];
        if (nloc == 0u) { xcd_barrier_complete(bar, b.x, nloc, nx); b.st[0] = nloc; b.st[1] = nx; }
        const unsigned old = xb_add(&bar[XB_XSUB(b.x)], 1u);
        const unsigned gen = old / nloc;
        if (old + 1u == (gen + 1u) * nloc) {
            __builtin_amdgcn_fence(__ATOMIC_RELEASE, "agent");
            asm volatile("s_waitcnt vmcnt(0)" ::: "memory");
            const unsigned og = xb_add(&bar[XB_TOP], 1u);
            const unsigned tg = og / nx;
            if (og + 1u == (tg + 1u) * nx) xb_add(&bar[XB_TOPGEN], 1u);
            else XB_SPIN(xb_ld(&bar[XB_TOPGEN]) == tg, bar);
            __builtin_amdgcn_fence(__ATOMIC_ACQUIRE, "agent");
            xb_add(&bar[XB_XGEN(b.x)], 1u);
            asm volatile("s_waitcnt vmcnt(0)" ::: "memory");
        } else {
            XB_SPIN(xb_ld(&bar[XB_XGEN(b.x)]) == gen, bar);
            __builtin_amdgcn_fence(__ATOMIC_ACQUIRE, "agent");
            asm volatile("s_waitcnt vmcnt(0)" ::: "memory");
        }
    }
    __syncthreads();
}
constexpr int NWAVES = 8;
constexpr int BATCH = 2, SEQ = 8192, D = 1024, M = BATCH * SEQ, DFF = 2816;
constexpr int NH = 8, DK = 128, CH = 64, NCHUNK = M / CH  , CPB = SEQ / CH  , NSEG = 16, CPS = 8  , NUNIT = BATCH * NH * NSEG  ;
constexpr int SCH = 128  , NSC = M / SCH  , SCPB = SEQ / SCH  ;
constexpr float EPS = 1e-6f;
constexpr size_t MiB = 1u << 20;
constexpr size_t WS_CTL = 0, CTL_ZERO_BYTES = 1 * MiB;
constexpr size_t WS_SSQ = 65536;
constexpr size_t WS_DEC = 2 * MiB;
constexpr size_t WS_TAB = 3 * MiB;
constexpr size_t WS_AP = 3 * MiB + 65536, WS_HE = WS_AP + 524288;
constexpr size_t WS_W_HIN = 5 * MiB, WS_W_HOUT = 13 * MiB, WS_W_LIN = 15 * MiB, WS_W_LOUT = 19 * MiB, WS_W_GATE = 21 * MiB;
constexpr size_t WS_W_FIN0 = 22 * MiB, WS_W_FIN1 = 33 * MiB, WS_W_FOUT0 = 44 * MiB, WS_W_FOUT1 = 44 * MiB + 5632 * 1024, WS_XB = 56 * MiB, WS_SLOC = 88 * MiB;
constexpr size_t WS_ACT = 104 * MiB;
constexpr size_t WS_QT = WS_ACT, WS_KT = WS_ACT + 32 * MiB, WS_V = WS_ACT + 64 * MiB, WS_SG = WS_ACT + 96 * MiB;
constexpr size_t WS_H = WS_ACT;
constexpr size_t WS_YG = WS_ACT, WS_U = WS_ACT + 32 * MiB, WS_UC = WS_ACT + 64 * MiB, WS_BI = WS_ACT + 96 * MiB;
constexpr size_t WS_END = WS_ACT + 128 * MiB;
static_assert(WS_W_FOUT1 + 5632 * 1024 <= WS_XB && WS_HE + 524288 <= WS_W_HIN && WS_END <= 256 * MiB, "d_ws map");
constexpr int CW_BAR = 4096;
constexpr int RING_BYTES = 131072, LDSCTL_OFF = RING_BYTES, MISC_OFF = LDSCTL_OFF + 320, LDS_BYTES = 147456;
using pg8::Unit;
typedef unsigned u32x2v __attribute__((ext_vector_type(2)));
__device__ __forceinline__ float bf2f(unsigned short h) { return __builtin_bit_cast(float, (unsigned)h << 16); }
__device__ __forceinline__ float fsigmoid(float x) { return __builtin_amdgcn_rcpf(1.0f + __expf(-x)); }
__device__ __forceinline__ float fsilu(float x) { return x * fsigmoid(x); }
typedef unsigned long long u64;
__device__ __forceinline__ float row_rstd(const u64* ssq, int row) { return __builtin_amdgcn_rsqf((float)ssq[row] * (1.0f / (16777216.0f * D)) + EPS); }
__device__ __forceinline__ v4u pack8(const f32x4 a, const f32x4 b) { v4u w; w.x = pg8::cvt_pk_bf16(a[0], a[1]); w.y = pg8::cvt_pk_bf16(a[2], a[3]); w.z = pg8::cvt_pk_bf16(b[0], b[1]); w.w = pg8::cvt_pk_bf16(b[2], b[3]); return w; }
#define EPI_ROWS(...) _Pragma("unroll") for (int ai = 0; ai < 2; ++ai) _Pragma("unroll") for (int m = 0; m < 4; ++m) { const int row = u.pm * 256 + ai * 128 + wr * 64 + m * 16 + fr; __VA_ARGS__ }

#define EPI_RS(rs) float rs[2][4]; _Pragma("unroll") for (int ai = 0; ai < 2; ++ai) _Pragma("unroll") for (int m = 0; m < 4; ++m) rs[ai][m] = row_rstd(ssq, u.pm * 256 + ai * 128 + wr * 64 + m * 16 + fr);
template <int CTRL> __device__ __forceinline__ float dpp0(float x) { return __builtin_bit_cast(float, __builtin_amdgcn_update_dpp(0, __builtin_bit_cast(int, x), CTRL, 0xf, 0xf, true)); }
__device__ __forceinline__ float row_scan16(float x) { x += dpp0<0x111>(x); x += dpp0<0x112>(x); x += dpp0<0x114>(x); x += dpp0<0x118>(x); return x; }
__device__ __forceinline__ float row_sum16(float x) { x += dpp0<0x128>(x); x += dpp0<0x124>(x); x += dpp0<0x122>(x); x += dpp0<0x121>(x); return x; }
struct EpiHgrnIn {
    static constexpr bool PERM = true, AFTER_DRAIN = false;
    const u64* ssq; const float* lbv; const float* oml; bf16* QT; bf16* KT; float* DEC;
    __device__ __forceinline__ void operator()(const f32x4 (&acc)[2][2][4][2], const Unit& u, int wr, int wc, int fr, int fq) const {
        EPI_RS(rs)
        if (u.pn < 8) {
            const int kc0 = 128 * u.pn + 32 * wc + 8 * fq;
#pragma unroll
            for (int ai = 0; ai < 2; ++ai) {
                const int cg = 4 * u.pm + 2 * ai + wr;
#pragma unroll
                for (int n = 0; n < 2; ++n) {
                    const f32x4 lb = *(const f32x4*)(lbv + kc0 + 4 * n), om = *(const f32x4*)(oml + kc0 + 4 * n);
                    f32x4 bq[4], kk[4];
#pragma unroll
                    for (int m = 0; m < 4; ++m)
#pragma unroll
                        for (int i = 0; i < 4; ++i) { const float z = acc[ai][1][m][n][i] * rs[ai][m]; const float e = __expf(-z), sg = __builtin_amdgcn_rcpf(1.0f + e);
                            bq[m][i] = __logf(lb[i] + om[i] * sg); kk[m][i] = om[i] * (e * sg); }
                    f32x4 carry = {0.f, 0.f, 0.f, 0.f};
#pragma unroll
                    for (int m = 0; m < 4; ++m)
#pragma unroll
                        for (int i = 0; i < 4; ++i) { const float x = bq[m][i]; const float tot = row_sum16(x); bq[m][i] = row_scan16(x) + carry[i]; carry[i] += tot; }
#pragma unroll
                    for (int m = 0; m < 4; ++m) { const unsigned off = (unsigned)(u.pm * 256 + ai * 128 + wr * 64 + m * 16 + fr) * D + kc0 + 4 * n; f32x4 qo, ko;
#pragma unroll
                        for (int i = 0; i < 4; ++i) { const float b = bq[m][i]; qo[i] = fsilu(acc[ai][0][m][n][i] * rs[ai][m]) * __expf(b); ko[i] = kk[m][i] * __expf(-b); }
                        u32x2v pq, pk; pq.x = pg8::cvt_pk_bf16(qo[0], qo[1]); pq.y = pg8::cvt_pk_bf16(qo[2], qo[3]); pk.x = pg8::cvt_pk_bf16(ko[0], ko[1]); pk.y = pg8::cvt_pk_bf16(ko[2], ko[3]);
                        *(u32x2v*)(QT + off) = pq; *(u32x2v*)(KT + off) = pk; }
                    if (fr == 15) { f32x4 dv;
#pragma unroll
                        for (int i = 0; i < 4; ++i) dv[i] = __expf(bq[3][i]);
                        *(f32x4*)(DEC + (unsigned)cg * D + kc0 + 4 * n) = dv; }
                }
            }
        } else {
            const int cg = 256 * (u.pn & 3) + 32 * wc + 8 * fq;
            bf16* O = QT + (size_t)(u.pn < 12 ? 2 : 3) * (16u << 20); const bool act = u.pn >= 12;
            EPI_ROWS(
                _Pragma("unroll") for (int bj = 0; bj < 2; ++bj) { const int col = cg + 128 * bj; f32x4 o[2];
                    _Pragma("unroll") for (int n = 0; n < 2; ++n) _Pragma("unroll") for (int i = 0; i < 4; ++i) { const float z = acc[ai][bj][m][n][i] * rs[ai][m]; o[n][i] = act ? fsilu(z) : z; }
                    *(v4u*)(O + (unsigned)row * D + col) = pack8(o[0], o[1]); })
        }
    }
};
template <bool LAST> struct EpiRes {
    static constexpr bool PERM = true, AFTER_DRAIN = false;
    bf16* xb; float* out; u64* ssq;
    __device__ __forceinline__ void operator()(const f32x4 (&acc)[2][2][4][2], const Unit& u, int wr, int wc, int fr, int fq) const {
        const int c0 = 256 * u.pn + 32 * wc + 8 * fq;
#pragma unroll
        for (int ai = 0; ai < 2; ++ai) {
            v4u pre[4][2];
#pragma unroll
            for (int m = 0; m < 4; ++m)
#pragma unroll
                for (int bj = 0; bj < 2; ++bj) pre[m][bj] = *(const v4u*)(xb + (unsigned)(u.pm * 256 + ai * 128 + wr * 64 + m * 16 + fr) * D + c0 + 128 * bj);
#pragma unroll
            for (int m = 0; m < 4; ++m) { const int row = u.pm * 256 + ai * 128 + wr * 64 + m * 16 + fr; float ss = 0.f;
#pragma unroll
                for (int bj = 0; bj < 2; ++bj) { const unsigned off = (unsigned)row * D + c0 + 128 * bj; const v4u p = pre[m][bj];
                    const f32x4 b0 = {__builtin_bit_cast(float, p.x << 16), __builtin_bit_cast(float, p.x & 0xffff0000u), __builtin_bit_cast(float, p.y << 16), __builtin_bit_cast(float, p.y & 0xffff0000u)};
                    const f32x4 b1 = {__builtin_bit_cast(float, p.z << 16), __builtin_bit_cast(float, p.z & 0xffff0000u), __builtin_bit_cast(float, p.w << 16), __builtin_bit_cast(float, p.w & 0xffff0000u)};
                    const f32x4 v0 = b0 + acc[ai][bj][m][0], v1 = b1 + acc[ai][bj][m][1];
                    if (LAST) { *(f32x4*)(out + off) = v0; *(f32x4*)(out + off + 4) = v1; } else *(v4u*)(xb + off) = pack8(v0, v1);
                    ss += ((v0[0] * v0[0] + v0[1] * v0[1]) + (v0[2] * v0[2] + v0[3] * v0[3])) + ((v1[0] * v1[0] + v1[1] * v1[1]) + (v1[2] * v1[2] + v1[3] * v1[3])); }
                ss += __shfl_xor(ss, 16); ss += __shfl_xor(ss, 32);
                if (fq == 0) atomicAdd(ssq + row, (u64)(ss * 16777216.0f)); }
        }
    }
};
struct EpiFfnIn {
    static constexpr bool PERM = true, AFTER_DRAIN = false;
    const u64* ssq; bf16* H;
    __device__ __forceinline__ void operator()(const f32x4 (&acc)[2][2][4][2], const Unit& u, int wr, int wc, int fr, int fq) const {
        const int c0 = 128 * u.pn + 32 * wc + 8 * fq;
        EPI_RS(rs)
        EPI_ROWS(f32x4 o[2];
            _Pragma("unroll") for (int n = 0; n < 2; ++n) _Pragma("unroll") for (int i = 0; i < 4; ++i) { const float g = acc[ai][0][m][n][i] * rs[ai][m], up = acc[ai][1][m][n][i] * rs[ai][m]; o[n][i] = fsilu(g) * up; }
            *(v4u*)(H + (unsigned)row * DFF + c0) = pack8(o[0], o[1]);)
    }
};
struct EpiLruIn {
    static constexpr bool PERM = true, AFTER_DRAIN = false;
    const u64* ssq; bf16* YG; bf16* U;
    __device__ __forceinline__ void operator()(const f32x4 (&acc)[2][2][4][2], const Unit& u, int wr, int wc, int fr, int fq) const {
        const int cg = 256 * (u.pn & 3) + 32 * wc + 8 * fq;
        EPI_RS(rs)
        if (u.pn < 4) {
            EPI_ROWS(
                _Pragma("unroll") for (int bj = 0; bj < 2; ++bj) { f32x4 o[2];
                    _Pragma("unroll") for (int n = 0; n < 2; ++n) _Pragma("unroll") for (int i = 0; i < 4; ++i) { const float z = acc[ai][bj][m][n][i] * rs[ai][m];
                        o[n][i] = z * fsigmoid(1.5957691216057308f * (z + 0.044715f * z * z * z)); }
                    *(v4u*)(YG + (unsigned)row * D + cg + 128 * bj) = pack8(o[0], o[1]); })
        } else {
            EPI_ROWS(
                _Pragma("unroll") for (int bj = 0; bj < 2; ++bj)
                    *(v4u*)(U + (unsigned)row * D + cg + 128 * bj) = pack8(acc[ai][bj][m][0] * rs[ai][m], acc[ai][bj][m][1] * rs[ai][m]);)
        }
    }
};
struct EpiGates {
    static constexpr bool PERM = true, AFTER_DRAIN = false;
    const float* ba; const float* bx; const float* sp8  ; const bf16* UC; _Float16* LA; bf16* BI;
    __device__ __forceinline__ void operator()(const f32x4 (&acc)[2][2][4][2], const Unit& u, int wr, int wc, int fr, int fq) const {
        const int c0 = 128 * u.pn + 32 * wc + 8 * fq;
#pragma unroll
        for (int ai = 0; ai < 2; ++ai) {
            v4u uwq[4];
#pragma unroll
            for (int m = 0; m < 4; ++m) uwq[m] = *(const v4u*)(UC + (unsigned)(u.pm * 256 + ai * 128 + wr * 64 + m * 16 + fr) * D + c0);
#pragma unroll
            for (int n = 0; n < 2; ++n) { const f32x4 bav = *(const f32x4*)(ba + c0 + 4 * n), bxv = *(const f32x4*)(bx + c0 + 4 * n), spv = *(const f32x4*)(sp8 + c0 + 4 * n);
#pragma unroll
                for (int m = 0; m < 4; ++m) { const int row = u.pm * 256 + ai * 128 + wr * 64 + m * 16 + fr; f32x4 bi; typedef _Float16 h4 __attribute__((ext_vector_type(4))); h4 hv;
#pragma unroll
                    for (int i = 0; i < 4; ++i) { const unsigned w32 = uwq[m][2 * n + (i >> 1)]; const float ucv = __builtin_bit_cast(float, (i & 1) ? (w32 & 0xffff0000u) : (w32 << 16));
                        const float r = fsigmoid(acc[ai][0][m][n][i] + bav[i]), ig = fsigmoid(acc[ai][1][m][n][i] + bxv[i]);
                        const float lg = spv[i] * r, x = 2.0f * lg;
                        const float em = -x * (1.0f + x * (0.5f + x * (0.16666667f + x * (0.041666668f + x * (0.0083333338f + x * 0.0013888889f)))));
                        hv[i] = (_Float16)lg; bi[i] = __builtin_amdgcn_sqrtf(fmaxf(em, 0.0f)) * (ig * ucv); }
                    *(h4*)(LA + (unsigned)row * D + c0 + 4 * n) = hv;
                    u32x2v pk; pk.x = pg8::cvt_pk_bf16(bi[0], bi[1]); pk.y = pg8::cvt_pk_bf16(bi[2], bi[3]);
                    *(u32x2v*)(BI + (unsigned)row * D + c0 + 4 * n) = pk; } }
        }
    }
};
struct EpiNull {
    static constexpr bool PERM = true, AFTER_DRAIN = false;
    __device__ __forceinline__ void operator()(const f32x4 (&acc)[2][2][4][2], const Unit& u, int wr, int wc, int fr, int fq) const {
#pragma unroll
        for (int ai = 0; ai < 2; ++ai)
#pragma unroll
            for (int bj = 0; bj < 2; ++bj)
#pragma unroll
                for (int m = 0; m < 4; ++m)
#pragma unroll
                    for (int n = 0; n < 2; ++n) asm volatile("" :: "v"(acc[ai][bj][m][n]));
    }
};

template <int MODE> struct EpiFfnX {
    static constexpr bool PERM = true, AFTER_DRAIN = false;
    const u64* ssq; bf16* H;
    __device__ __forceinline__ void operator()(const f32x4 (&acc)[2][2][4][2], const Unit& u, int wr, int wc, int fr, int fq) const {
        const int c0 = 128 * u.pn + 32 * wc + 8 * fq;
        float rs[2][4];
#pragma unroll
        for (int ai = 0; ai < 2; ++ai)
#pragma unroll
            for (int m = 0; m < 4; ++m) rs[ai][m] = MODE == 2 ? 1.0f : row_rstd(ssq, u.pm * 256 + ai * 128 + wr * 64 + m * 16 + fr);
        EPI_ROWS(f32x4 o[2];
            _Pragma("unroll") for (int n = 0; n < 2; ++n) _Pragma("unroll") for (int i = 0; i < 4; ++i) { const float g = acc[ai][0][m][n][i] * rs[ai][m], up = acc[ai][1][m][n][i] * rs[ai][m]; o[n][i] = MODE == 3 ? g + up : fsilu(g) * up; }
            const v4u w = pack8(o[0], o[1]);
            if (MODE == 1) asm volatile("" :: "v"(w)); else *(v4u*)(H + (unsigned)row * DFF + c0) = w;)
    }
};
typedef short s16x4 __attribute__((ext_vector_type(4)));
struct Args { const float* in[19]; float* out; unsigned char* ws; int ph_lo, ph_hi; };
static_assert(sizeof(Args) == 19 * 8 + 8 + 8 + 8, "Args has no padding");
__device__ __forceinline__ LAS unsigned char* lds_base() { extern __shared__ __attribute__((aligned(16))) unsigned char lds_dyn[]; return (LAS unsigned char*)lds_dyn; }
#define TID ((int)threadIdx.x)
#define LANE (TID & 63)
#define WAVE (__builtin_amdgcn_readfirstlane(TID >> 6))
#define GSZ ((int)gridDim.x)
#define VCU ((GSZ % 8 == 0) ? ((int)blockIdx.x % 8) * (GSZ / 8) + (int)blockIdx.x / 8 : (int)blockIdx.x)
#define LDSB (lds_base())
#define WSP(T, off) ((T*)(F.ws + (off)))
__device__ __forceinline__ float wave_sum(float v) {
#pragma unroll
    for (int o = 1; o < 64; o <<= 1) v += __shfl_xor(v, o);
    return v;
}
__device__ __forceinline__ void tr_item64(const float* W, int ldw, int k0, int ns0, bf16* WT, int ldt, int drow0, const float* ksc, LAS unsigned char* scr, int lane) {
    const int c = lane & 15, g = lane >> 4;
    f32x4 v[16];
    const float* src = W + (size_t)(k0 + 16 * g) * ldw + ns0 + 4 * c;
#pragma unroll
    for (int i = 0; i < 16; ++i) v[i] = *(const GAS f32x4*)(src + (size_t)i * ldw);
    if (ksc) {
#pragma unroll
        for (int q = 0; q < 4; ++q) { const f32x4 s = *(const GAS f32x4*)(ksc + k0 + 16 * g + 4 * q);
#pragma unroll
            for (int r = 0; r < 4; ++r) v[4 * q + r] = v[4 * q + r] * s[r]; }
    }
#pragma unroll
    for (int j = 0; j < 4; ++j) {
#pragma unroll
        for (int h = 0; h < 2; ++h) { v4u w; w.x = pk2(v[8 * h][j], v[8 * h + 1][j]); w.y = pk2(v[8 * h + 2][j], v[8 * h + 3][j]); w.z = pk2(v[8 * h + 4][j], v[8 * h + 5][j]); w.w = pk2(v[8 * h + 6][j], v[8 * h + 7][j]);
            *(LAS v4u*)(scr + (4 * c + j) * 128 + (((2 * g + h) ^ (c & 7)) * 16)) = w; }
    }
    LDS_WAIT(); asm volatile("" ::: "memory");
#pragma unroll
    for (int i = 0; i < 8; ++i) { const int n = (lane >> 3) + 8 * i, ch = lane & 7;
        const v4u x = *(const LAS v4u*)(scr + n * 128 + ((ch ^ ((n >> 2) & 7)) * 16));
        *(GAS v4u*)(WT + (size_t)(drow0 + n) * ldt + k0 + 8 * ch) = x; }
    LDS_WAIT(); asm volatile("" ::: "memory");
}
constexpr int CV_A = 1024, CV_B = 256, CV_F = 1408, CV_G = 704, CV_C = 512, CV_D = 256, CV_E = 128;
constexpr int CV_EARLY = CV_A + CV_B + CV_F, CV_ALL = CV_EARLY + CV_G + CV_C + CV_D + CV_E + CV_F + CV_G;
__device__ __forceinline__ void convert_items(const Args& F, int first, int last, int gw, int ngw) {
    LAS unsigned char* scr = LDSB + WAVE * 8192; const int lane = LANE;
    for (int it = first + gw; it < last; it += ngw) {
        int r = it;
        if (r < CV_A) { const int kb = r >> 6, nb = r & 63, ns0 = 64 * nb;
            const int drow0 = ns0 < 1024 ? 256 * (ns0 >> 7) + (ns0 & 127) : (ns0 < 2048 ? 256 * ((ns0 - 1024) >> 7) + 128 + (ns0 & 127) : ns0);
            tr_item64(F.in[4], 4096, 64 * kb, ns0, WSP(bf16, WS_W_HIN), 1024, drow0, F.in[1], scr, lane); continue; } r -= CV_A;
        if (r < CV_B) { const int kb = r >> 4, nb = r & 15; tr_item64(F.in[7], 1024, 64 * kb, 64 * nb, WSP(bf16, WS_W_HOUT), 1024, 64 * nb, nullptr, scr, lane); continue; } r -= CV_B;
        if (r < CV_F) { const int kb = r / 88, nb = r % 88, isup = nb >= 44 ? 1 : 0, j0 = 64 * (nb - 44 * isup);
            tr_item64(F.in[17], 5632, 64 * kb, 64 * nb, WSP(bf16, WS_W_FIN0), 1024, 256 * (j0 >> 7) + (j0 & 127) + 128 * isup, F.in[2], scr, lane); continue; } r -= CV_F;
        if (r < CV_G) { const int kb = r >> 4, nb = r & 15; tr_item64(F.in[18], 1024, 64 * kb, 64 * nb, WSP(bf16, WS_W_FOUT0), 2816, 64 * nb, nullptr, scr, lane); continue; } r -= CV_G;
        if (r < CV_C) { const int kb = r >> 5, nb = r & 31; tr_item64(F.in[8], 2048, 64 * kb, 64 * nb, WSP(bf16, WS_W_LIN), 1024, 64 * nb, F.in[1] + 1024, scr, lane); continue; } r -= CV_C;
        if (r < CV_D) { const int kb = r >> 4, nb = r & 15; tr_item64(F.in[16], 1024, 64 * kb, 64 * nb, WSP(bf16, WS_W_LOUT), 1024, 64 * nb, nullptr, scr, lane); continue; } r -= CV_D;
        if (r < CV_E) { const int isx = r >> 6, n = (r >> 4) & 3, kb = (r >> 2) & 3, nb = r & 3; const int ch0 = 256 * n + 64 * nb;
            tr_item64((isx ? F.in[13] : F.in[11]) + (size_t)n * 65536, 256, 64 * kb, 64 * nb, WSP(bf16, WS_W_GATE), 256, 256 * (ch0 >> 7) + (ch0 & 127) + 128 * isx, nullptr, scr, lane); continue; } r -= CV_E;
        if (r < CV_F) { const int kb = r / 88, nb = r % 88, isup = nb >= 44 ? 1 : 0, j0 = 64 * (nb - 44 * isup);
            tr_item64(F.in[17] + (size_t)1024 * 5632, 5632, 64 * kb, 64 * nb, WSP(bf16, WS_W_FIN1), 1024, 256 * (j0 >> 7) + (j0 & 127) + 128 * isup, F.in[2] + 1024, scr, lane); continue; } r -= CV_F;
        { const int kb = r >> 4, nb = r & 15; tr_item64(F.in[18] + (size_t)2816 * 1024, 1024, 64 * kb, 64 * nb, WSP(bf16, WS_W_FOUT1), 2816, 64 * nb, nullptr, scr, lane); }
    }
}
__device__ __forceinline__ void p0_prologue(const Args& F) {
    const int gw = VCU * NWAVES + WAVE, NGW = GSZ * NWAVES, lane = LANE;
    convert_items(F, 0, GSZ == 256 ? CV_EARLY : CV_ALL, gw, NGW);
    for (int m4 = gw; m4 < M / 4; m4 += NGW) {
        f32x4 v[4][4]; float s[4];
#pragma unroll
        for (int r = 0; r < 4; ++r) { const GAS f32x4* xr = (const GAS f32x4*)(F.in[0] + (size_t)(4 * m4 + r) * D) + lane;
#pragma unroll
            for (int j = 0; j < 4; ++j) v[r][j] = xr[64 * j]; }
#pragma unroll
        for (int r = 0; r < 4; ++r) { float a = 0.f;
#pragma unroll
            for (int j = 0; j < 4; ++j) a += (v[r][j].x * v[r][j].x + v[r][j].y * v[r][j].y) + (v[r][j].z * v[r][j].z + v[r][j].w * v[r][j].w);
            s[r] = wave_sum(a);
            GAS unsigned long long* o8 = (GAS unsigned long long*)(WSP(bf16, WS_XB) + (size_t)(4 * m4 + r) * D) + lane;
#pragma unroll
            for (int j = 0; j < 4; ++j) o8[64 * j] = (unsigned long long)pk2(v[r][j].x, v[r][j].y) | ((unsigned long long)pk2(v[r][j].z, v[r][j].w) << 32); }
        if (lane < 4) WSP(u64, WS_SSQ)[4 * m4 + lane] = (u64)((lane == 0 ? s[0] : (lane == 1 ? s[1] : (lane == 2 ? s[2] : s[3]))) * 16777216.0f);
    }
    { const int g = blockIdx.x * (NWAVES * 64) + TID; if (g < 1024) { const float l0 = F.in[5][g], l1 = F.in[5][1024 + g];
        WSP(float, WS_TAB)[g] = __builtin_amdgcn_rcpf(1.0f + __expf(l1 - l0)); WSP(float, WS_TAB)[1024 + g] = __builtin_amdgcn_rcpf(1.0f + __expf(l0 - l1));
        WSP(float, WS_TAB)[2048 + g] = -8.0f * log1pf(__expf(-F.in[15][g])); } }
}
constexpr int TP = 272  , AP_ = 144  ;
constexpr int L_Q = 0, L_K = 17408, L_V = 34816, L_A = 52224, L_ST = 61440, L_RS = 96256;
__device__ __forceinline__ void stage_tile(LAS unsigned char* img, const bf16* src, int tid) {
#pragma unroll
    for (int i = 0; i < 2; ++i) { const int piece = tid + 512 * i, row = piece >> 4, pc = piece & 15;
        const v4u x = *(const GAS v4u*)(src + (size_t)row * D + pc * 8); *(LAS v4u*)(img + row * TP + pc * 16) = x; }
}
__device__ __forceinline__ bf16x8 frag_row(const LAS unsigned char* img, int pitch, int row0, int k0, int fr, int fq) {
    return *(const LAS bf16x8*)(img + (row0 + fr) * pitch + (k0 + 8 * fq) * 2);
}
__device__ __forceinline__ bf16x8 frag_tr(const LAS unsigned char* img, int pitch, int n0, int k0, int fr, int fq) {
    const int q = fr >> 2, p = fr & 3;
    const s16x4 lo = __builtin_amdgcn_ds_read_tr16_b64_v4i16((LAS s16x4*)(img + (k0 + 8 * fq + q) * pitch + (n0 + 4 * p) * 2));
    const s16x4 hi = __builtin_amdgcn_ds_read_tr16_b64_v4i16((LAS s16x4*)(img + (k0 + 8 * fq + 4 + q) * pitch + (n0 + 4 * p) * 2));
    return __builtin_shufflevector(lo, hi, 0, 1, 2, 3, 4, 5, 6, 7);
}
#define MFMA16(a, b, c) __builtin_amdgcn_mfma_f32_16x16x32_bf16((a), (b), (c), 0, 0, 0)
__device__ __forceinline__ void state_update(f32x4 (&S)[8], const LAS unsigned char* Ki, const LAS unsigned char* Vi, const float* decp, int w, int fr, int fq) {
#pragma unroll
    for (int ks = 0; ks < 2; ++ks) { const bf16x8 X = frag_tr(Ki, TP, 16 * w, 32 * ks, fr, fq);
#pragma unroll
        for (int vb = 0; vb < 8; ++vb) S[vb] = MFMA16(X, frag_tr(Vi, TP, 16 * vb, 32 * ks, fr, fq), S[vb]); }
    const f32x4 dv = *(const f32x4*)(decp + 16 * w + 4 * fq);
#pragma unroll
    for (int vb = 0; vb < 8; ++vb) S[vb] = S[vb] * dv;
}
__device__ __forceinline__ void hgrn_seg_state(const Args& F) {
    LAS unsigned char* Ki = LDSB + L_K; LAS unsigned char* Vi = LDSB + L_V;
    const int w = WAVE, fr = LANE & 15, fq = LANE >> 4;
    for (int unit = VCU; unit < NUNIT; unit += GSZ) {
        const int b = unit / (NH * NSEG), h = (unit / NSEG) % NH, seg = unit % NSEG;
        f32x4 S[8];
#pragma unroll
        for (int vb = 0; vb < 8; ++vb) S[vb] = (f32x4){0.f, 0.f, 0.f, 0.f};
        for (int c = 0; c < CPS; ++c) {
            const int cg = b * CPB + seg * CPS + c; const size_t r0 = (size_t)cg * CH;
            __syncthreads();
            stage_tile(Ki, WSP(bf16, WS_KT) + r0 * D + h * DK, TID); stage_tile(Vi, WSP(bf16, WS_V) + r0 * D + h * DK, TID);
            __syncthreads();
            state_update(S, Ki, Vi, WSP(float, WS_DEC) + (size_t)cg * D + h * DK, w, fr, fq);
        }
        float* sl = WSP(float, WS_SLOC) + (size_t)unit * 16384;
#pragma unroll
        for (int vb = 0; vb < 8; ++vb)
#pragma unroll
            for (int r = 0; r < 4; ++r) sl[(16 * w + 4 * fq + r) * 128 + 16 * vb + fr] = S[vb][r];
    }
}
__device__ __forceinline__ void hgrn_seg_scan(const Args& F) {
    float* SL = WSP(float, WS_SLOC); const float* DEC = WSP(float, WS_DEC);
    for (int idx = blockIdx.x * (NWAVES * 64) + TID; idx < BATCH * NH * 16384; idx += GSZ * NWAVES * 64) {
        const int bh = idx >> 14, kv = idx & 16383, k = kv >> 7, b = bh / NH, h = bh % NH; float S = 0.f;
        for (int seg = 0; seg < NSEG; ++seg) { float* p = SL + ((size_t)(bh * NSEG + seg) << 14) + kv; const float t = *p; *p = S;
            float dsg = 1.f; const float* dp = DEC + (size_t)(b * CPB + seg * CPS) * D + h * DK + k;
#pragma unroll
            for (int c = 0; c < CPS; ++c) dsg *= dp[(size_t)c * D];
            S = dsg * S + t; }
    }
}
__device__ __forceinline__ void hgrn_out(const Args& F) {
    LAS unsigned char* Qi = LDSB + L_Q; LAS unsigned char* Ki = LDSB + L_K; LAS unsigned char* Vi = LDSB + L_V; LAS unsigned char* Ai = LDSB + L_A; LAS unsigned char* STi = LDSB + L_ST;
    LAS float* RS = (LAS float*)(LDSB + L_RS);
    const int w = WAVE, fr = LANE & 15, fq = LANE >> 4, tb = w & 3, wh = w >> 2;
    const float* nw = F.in[6];
    for (int unit = VCU; unit < NUNIT; unit += GSZ) {
        const int b = unit / (NH * NSEG), h = (unit / NSEG) % NH, seg = unit % NSEG;
        f32x4 S[8];
        { const float* sl = WSP(float, WS_SLOC) + (size_t)unit * 16384;
#pragma unroll
          for (int vb = 0; vb < 8; ++vb)
#pragma unroll
            for (int r = 0; r < 4; ++r) S[vb][r] = sl[(16 * w + 4 * fq + r) * 128 + 16 * vb + fr]; }
        __syncthreads();
#pragma unroll
        for (int vb = 0; vb < 8; ++vb) { u32x2v pk; pk.x = pg8::cvt_pk_bf16(S[vb][0], S[vb][1]); pk.y = pg8::cvt_pk_bf16(S[vb][2], S[vb][3]);
            *(LAS u32x2v*)(STi + (16 * vb + fr) * TP + (16 * w + 4 * fq) * 2) = pk; }
        for (int c = 0; c < CPS; ++c) {
            const int cg = b * CPB + seg * CPS + c; const size_t r0 = (size_t)cg * CH;
            bf16* qg = WSP(bf16, WS_QT) + r0 * D + h * DK;
            stage_tile(Qi, qg, TID); stage_tile(Ki, WSP(bf16, WS_KT) + r0 * D + h * DK, TID); stage_tile(Vi, WSP(bf16, WS_V) + r0 * D + h * DK, TID);
            __syncthreads();
            bf16x8 Yq[4];
#pragma unroll
            for (int ks = 0; ks < 4; ++ks) Yq[ks] = frag_row(Qi, TP, 16 * tb, 32 * ks, fr, fq);
#pragma unroll
            for (int sbi = 0; sbi < 2; ++sbi) { const int sb = 2 * wh + sbi; f32x4 a = (f32x4){0.f, 0.f, 0.f, 0.f};
                if (sb <= tb) {
#pragma unroll
                    for (int ks = 0; ks < 4; ++ks) a = MFMA16(frag_row(Ki, TP, 16 * sb, 32 * ks, fr, fq), Yq[ks], a);
                }
                const int t = 16 * tb + fr, s0 = 16 * sb + 4 * fq;
#pragma unroll
                for (int r = 0; r < 4; ++r) a[r] = (s0 + r <= t) ? a[r] : 0.f;
                u32x2v pk; pk.x = pg8::cvt_pk_bf16(a[0], a[1]); pk.y = pg8::cvt_pk_bf16(a[2], a[3]);
                *(LAS u32x2v*)(Ai + t * AP_ + s0 * 2) = pk; }
            __syncthreads();
            bf16x8 Ya[2];
#pragma unroll
            for (int ks = 0; ks < 2; ++ks) Ya[ks] = frag_row(Ai, AP_, 16 * tb, 32 * ks, fr, fq);
            f32x4 o[4]; float ssq = 0.f;
#pragma unroll
            for (int j = 0; j < 4; ++j) { const int vb = 4 * wh + j; f32x4 a = (f32x4){0.f, 0.f, 0.f, 0.f};
#pragma unroll
                for (int ks = 0; ks < 4; ++ks) a = MFMA16(frag_row(STi, TP, 16 * vb, 32 * ks, fr, fq), Yq[ks], a);
#pragma unroll
                for (int ks = 0; ks < 2; ++ks) a = MFMA16(frag_tr(Vi, TP, 16 * vb, 32 * ks, fr, fq), Ya[ks], a);
                o[j] = a; ssq += (a[0] * a[0] + a[1] * a[1]) + (a[2] * a[2] + a[3] * a[3]); }
            ssq += __shfl_xor(ssq, 16); ssq += __shfl_xor(ssq, 32);
            if (fq == 0) RS[(16 * tb + fr) * 2 + wh] = ssq;
            state_update(S, Ki, Vi, WSP(float, WS_DEC) + (size_t)cg * D + h * DK, w, fr, fq);
            __syncthreads();
            { const int t = 16 * tb + fr; const float rstd = __builtin_amdgcn_rsqf((RS[t * 2] + RS[t * 2 + 1]) * (1.0f / DK) + EPS);
              const bf16* sgp = WSP(bf16, WS_SG) + (r0 + t) * D + h * DK;
#pragma unroll
              for (int j = 0; j < 4; ++j) { const int v0 = 16 * (4 * wh + j) + 4 * fq; const u32x2v sgw = *(const GAS u32x2v*)(sgp + v0); const f32x4 nv = *(const f32x4*)(nw + v0);
                  const float g0 = __builtin_bit_cast(float, sgw.x << 16), g1 = __builtin_bit_cast(float, sgw.x & 0xffff0000u), g2 = __builtin_bit_cast(float, sgw.y << 16), g3 = __builtin_bit_cast(float, sgw.y & 0xffff0000u);
                  u32x2v pk; pk.x = pg8::cvt_pk_bf16(o[j][0] * rstd * nv[0] * g0, o[j][1] * rstd * nv[1] * g1); pk.y = pg8::cvt_pk_bf16(o[j][2] * rstd * nv[2] * g2, o[j][3] * rstd * nv[3] * g3);
                  *(GAS u32x2v*)(qg + (size_t)t * D + v0) = pk; } }
#pragma unroll
            for (int vb = 0; vb < 8; ++vb) { u32x2v pk; pk.x = pg8::cvt_pk_bf16(S[vb][0], S[vb][1]); pk.y = pg8::cvt_pk_bf16(S[vb][2], S[vb][3]);
                *(LAS u32x2v*)(STi + (16 * vb + fr) * TP + (16 * w + 4 * fq) * 2) = pk; }
            __syncthreads();
        }
    }
}
__device__ __forceinline__ void lru_conv(const Args& F) {
    const bf16* U = WSP(bf16, WS_U); bf16* UC = WSP(bf16, WS_UC); const float* cw = F.in[9]; const float* cb = F.in[10];
    for (int idx = blockIdx.x * (NWAVES * 64) + TID; idx < M * (D / 8); idx += GSZ * NWAVES * 64) {
        const int row = idx >> 7, c0 = (idx & 127) * 8, t = row & (SEQ - 1); float a[8];
#pragma unroll
        for (int j = 0; j < 8; ++j) a[j] = cb[c0 + j];
#pragma unroll
        for (int tap = 0; tap < 4; ++tap) { const int dt = 3 - tap; if (t - dt >= 0) { const v4u uw = *(const GAS v4u*)(U + (size_t)(row - dt) * D + c0);
#pragma unroll
            for (int j = 0; j < 8; ++j) { const unsigned w32 = uw[j >> 1]; const float uv = __builtin_bit_cast(float, (j & 1) ? (w32 & 0xffff0000u) : (w32 << 16)); a[j] += uv * cw[tap * D + c0 + j]; } } }
        v4u o; o.x = pk2(a[0], a[1]); o.y = pk2(a[2], a[3]); o.z = pk2(a[4], a[5]); o.w = pk2(a[6], a[7]);
        *(GAS v4u*)(UC + (size_t)row * D + c0) = o;
    }
}
__device__ __forceinline__ void lru_scan_local(const Args& F) {
    const _Float16* LA = WSP(_Float16, WS_U); const bf16* BI = WSP(bf16, WS_BI); float* AP = WSP(float, WS_AP); float* HE = WSP(float, WS_HE);
    for (int idx = blockIdx.x * (NWAVES * 64) + TID; idx < NSC * D; idx += GSZ * NWAVES * 64) {
        const int sc = idx >> 10, ch = idx & 1023; size_t off = (size_t)sc * SCH * D + ch; float h = 0.f, sl = 0.f;
#pragma unroll 8
        for (int r = 0; r < SCH; ++r, off += D) { const float la = (float)LA[off]; h = __expf(la) * h + bf2f(BI[off]); sl += la; }
        AP[idx] = __expf(sl); HE[idx] = h;
    }
}
__device__ __forceinline__ void lru_scan_apply(const Args& F) {
    const _Float16* LA = WSP(_Float16, WS_U); const bf16* BI = WSP(bf16, WS_BI); const bf16* YG = WSP(bf16, WS_YG); bf16* HY = WSP(bf16, WS_UC);
    const float* AP = WSP(float, WS_AP); const float* HE = WSP(float, WS_HE);
    for (int idx = blockIdx.x * (NWAVES * 64) + TID; idx < NSC * D; idx += GSZ * NWAVES * 64) {
        const int sc = idx >> 10, ch = idx & 1023, sc0 = (sc / SCPB) * SCPB; float h = 0.f;
        for (int j = sc0; j < sc; ++j) h = AP[j * D + ch] * h + HE[j * D + ch];
        size_t off = (size_t)sc * SCH * D + ch;
#pragma unroll 8
        for (int r = 0; r < SCH; ++r, off += D) { h = __expf((float)LA[off]) * h + bf2f(BI[off]); HY[off] = (bf16)f2bf(h * bf2f(YG[off])); }
    }
}
__device__ __forceinline__ void final_norm(const Args& F) {
    const int gw = VCU * NWAVES + WAVE, NGW = GSZ * NWAVES; const float* nf = F.in[3];
    for (int m = gw; m < M; m += NGW) { const float rs = row_rstd(WSP(u64, WS_SSQ) + 4 * M, m);
        const GAS v4u* xr = (const GAS v4u*)(WSP(bf16, WS_XB) + (size_t)m * D) + LANE; GAS f32x4* orow = (GAS f32x4*)(F.out + (size_t)m * D);
#pragma unroll
        for (int j = 0; j < 2; ++j) { const v4u p = xr[64 * j]; const int c = 8 * (LANE + 64 * j); const f32x4 w0 = *(const f32x4*)(nf + c), w1 = *(const f32x4*)(nf + c + 4);
            const f32x4 b0 = {__builtin_bit_cast(float, p.x << 16), __builtin_bit_cast(float, p.x & 0xffff0000u), __builtin_bit_cast(float, p.y << 16), __builtin_bit_cast(float, p.y & 0xffff0000u)};
            const f32x4 b1 = {__builtin_bit_cast(float, p.z << 16), __builtin_bit_cast(float, p.z & 0xffff0000u), __builtin_bit_cast(float, p.w << 16), __builtin_bit_cast(float, p.w & 0xffff0000u)};
            orow[c / 4] = b0 * rs * w0; orow[c / 4 + 1] = b1 * rs * w1; } }
}
#ifndef MK_N_LAUNCHES
#define MK_N_LAUNCHES 1
#endif
constexpr int N_PHASES = 18;
#ifndef ONLY_PHASE
#define ONLY_PHASE -1
#endif
#ifndef EXTRA_PHASE
#define EXTRA_PHASE 0
#endif
#ifndef PROBE_MASK
#define PROBE_MASK 0u
#endif
#ifndef PROBE_MASK2
#define PROBE_MASK2 0u
#endif
#define GEMM_RUN(EPI, g, nM_, nN_, E) do { pg8::StaticOrder S_; S_.init(nM_, nN_, GSZ, (int)blockIdx.x); pg8::gemm_phase<EPI, pg8::StaticOrder, true, true>(LDSB, g, S_, E); } while (0)
__global__ void __launch_bounds__(NWAVES * 64, 2) trunk_fwd(Args args) {
    const Args& F = args;
    volatile LAS unsigned* MISC = (volatile LAS unsigned*)(LDSB + MISC_OFF);
    gu32* ctl = (gu32*)(args.ws + WS_CTL);
    for (int u = TID; u < (LDS_BYTES - LDSCTL_OFF) / 4; u += NWAVES * 64) ((LAS unsigned*)(LDSB + LDSCTL_OFF))[u] = 0u;
    __syncthreads();
    XcdBarrier bar; bar.bar = (unsigned*)(ctl + CW_BAR); bar.x = 0; bar.st = nullptr;
    if (MK_N_LAUNCHES == 1) bar = xcd_barrier_post((unsigned*)(ctl + CW_BAR), MISC + 8);
    const int lo = args.ph_lo, hi = args.ph_hi;
#define IN(k) ((ONLY_PHASE < 0 || ONLY_PHASE == (k)) && lo <= (k) && (k) < hi)
    unsigned long long tacc = 0ull, tacc2 = 0ull, tph = 0ull;
#define PB(k) do { if (((PROBE_MASK | PROBE_MASK2) >> (k)) & 1u) tph = rt(); } while (0)
#define SEAM(k) SEAM2(k, (k) + 1)
#define SEAM2(k, k2) do { if (IN(k) && IN(k2)) xcd_barrier(bar); if ((PROBE_MASK >> (k)) & 1u) tacc += rt() - tph; if ((PROBE_MASK2 >> (k)) & 1u) tacc2 += rt() - tph; } while (0)
    bf16* XB = WSP(bf16, WS_XB); u64* SSQ = WSP(u64, WS_SSQ);
    PB(0); if (IN(0)) { p0_prologue(F); } SEAM(0);
    PB(1); if (IN(1)) { pg8::Gemm g{XB, WSP(bf16, WS_W_HIN), D, D, D, 0};
        EpiHgrnIn E{SSQ, WSP(float, WS_TAB), WSP(float, WS_TAB) + 1024, WSP(bf16, WS_QT), WSP(bf16, WS_KT), WSP(float, WS_DEC)};
        GEMM_RUN(EpiHgrnIn, g, M / 256, 16, E); } SEAM2(1, 3);
    PB(3); if (IN(3)) { hgrn_seg_state(F); } SEAM(3);
    PB(4); if (IN(4)) { hgrn_seg_scan(F); } SEAM(4);
    PB(5); if (IN(5)) { hgrn_out(F); } SEAM(5);
    PB(6); if (IN(6)) { pg8::Gemm g{WSP(bf16, WS_QT), WSP(bf16, WS_W_HOUT), D, D, D, 0}; EpiRes<false> E{XB, nullptr, SSQ + M}; GEMM_RUN(EpiRes<false>, g, M / 256, 4, E); } SEAM(6);
    PB(7); if (IN(7)) { pg8::Gemm g{XB, WSP(bf16, WS_W_FIN0), D, D, D, 0}; EpiFfnIn E{SSQ + M, WSP(bf16, WS_H)}; GEMM_RUN(EpiFfnIn, g, M / 256, 22, E);
        if (GSZ == 256 && blockIdx.x >= 128) convert_items(F, CV_EARLY, CV_ALL, ((int)blockIdx.x - 128) * NWAVES + WAVE, 128 * NWAVES); } SEAM(7);
    PB(8); if (IN(8)) { pg8::Gemm g{WSP(bf16, WS_H), WSP(bf16, WS_W_FOUT0), DFF, DFF, DFF, 0}; EpiRes<false> E{XB, nullptr, SSQ + 2 * M}; GEMM_RUN(EpiRes<false>, g, M / 256, 4, E); } SEAM(8);
    PB(9); if (IN(9)) { pg8::Gemm g{XB, WSP(bf16, WS_W_LIN), D, D, D, 0}; EpiLruIn E{SSQ + 2 * M, WSP(bf16, WS_YG), WSP(bf16, WS_U)}; GEMM_RUN(EpiLruIn, g, M / 256, 8, E); } SEAM(9);
    PB(10); if (IN(10)) { lru_conv(F); } SEAM(10);
    PB(11); if (IN(11)) { int kg = 256; asm volatile("" : "+s"(kg));
        pg8::Gemm g{WSP(bf16, WS_UC), WSP(bf16, WS_W_GATE), D, 256, kg, 1};
        EpiGates E{F.in[12], F.in[14], WSP(float, WS_TAB) + 2048, WSP(bf16, WS_UC), WSP(_Float16, WS_U), WSP(bf16, WS_BI)}; GEMM_RUN(EpiGates, g, M / 256, 8, E); } SEAM(11);
    PB(12); if (IN(12)) { lru_scan_local(F); } SEAM(12);
    PB(13); if (IN(13)) { lru_scan_apply(F); } SEAM(13);
    PB(14); if (IN(14)) { pg8::Gemm g{WSP(bf16, WS_UC), WSP(bf16, WS_W_LOUT), D, D, D, 0}; EpiRes<false> E{XB, nullptr, SSQ + 3 * M}; GEMM_RUN(EpiRes<false>, g, M / 256, 4, E); } SEAM(14);
    PB(15); if (IN(15)) { pg8::Gemm g{XB, WSP(bf16, WS_W_FIN1), D, D, D, 0}; EpiFfnIn E{SSQ + 3 * M, WSP(bf16, WS_H)}; GEMM_RUN(EpiFfnIn, g, M / 256, 22, E); } SEAM(15);
    PB(16); if (IN(16)) { pg8::Gemm g{WSP(bf16, WS_H), WSP(bf16, WS_W_FOUT1), DFF, DFF, DFF, 0}; EpiRes<false> E{XB, nullptr, SSQ + 4 * M}; GEMM_RUN(EpiRes<false>, g, M / 256, 4, E); } SEAM(16);
    PB(17); if (IN(17)) { final_norm(F); }
    if ((PROBE_MASK >> 17) & 1u) tacc += rt() - tph;
    if ((PROBE_MASK2 >> 17) & 1u) tacc2 += rt() - tph;
    if (EXTRA_PHASE != 0) { xcd_barrier(bar); tph = rt();
        if (EXTRA_PHASE == 1) { pg8::Gemm g{XB, WSP(bf16, WS_W_FIN1), D, D, D, 0}; EpiNull E{}; GEMM_RUN(EpiNull, g, M / 256, 22, E); }
        if (EXTRA_PHASE == 2) { pg8::Gemm g{XB, WSP(bf16, WS_W_FIN1), D, D, D, 0}; EpiFfnIn E{SSQ + 3 * M, WSP(bf16, WS_H)}; GEMM_RUN(EpiFfnIn, g, M / 256, 22, E); }
        if (EXTRA_PHASE == 3) { pg8::Gemm g{XB, WSP(bf16, WS_W_FIN1), D, D, D, 0}; EpiNull E{}; GEMM_RUN(EpiNull, g, M / 256, 20, E); }
        if (EXTRA_PHASE == 4) { pg8::Gemm g{XB, WSP(bf16, WS_W_FIN1), D, D, D, 0}; EpiFfnX<1> E{SSQ + 3 * M, WSP(bf16, WS_H)}; GEMM_RUN(EpiFfnX<1>, g, M / 256, 22, E); }
        if (EXTRA_PHASE == 5) { pg8::Gemm g{XB, WSP(bf16, WS_W_FIN1), D, D, D, 0}; EpiFfnX<2> E{SSQ + 3 * M, WSP(bf16, WS_H)}; GEMM_RUN(EpiFfnX<2>, g, M / 256, 22, E); }
        if (EXTRA_PHASE == 6) { pg8::Gemm g{XB, WSP(bf16, WS_W_FIN1), D, D, D, 0}; EpiFfnX<3> E{SSQ + 3 * M, WSP(bf16, WS_H)}; GEMM_RUN(EpiFfnX<3>, g, M / 256, 22, E); }
        xcd_barrier(bar); tacc += rt() - tph; }
    if ((PROBE_MASK | PROBE_MASK2 | (unsigned)EXTRA_PHASE) != 0u && blockIdx.x == 0 && TID == 0) { const unsigned long long te = rt() + 4ull * tacc + 100000ull * ((tacc2 + 50ull) / 100ull); while (rt() < te) __builtin_amdgcn_s_sleep(32); }
#undef IN
#undef SEAM
}

extern "C" void kernel_launch(void* const* d_in, const int* in_sizes, int n_in, void* d_out, int out_size, void* d_ws, size_t ws_size, hipStream_t stream) {
    static int grid = 0;
    if (grid == 0) {
        if (n_in != 19 || in_sizes[0] != M * D || out_size != M * D || ws_size < WS_END) { fprintf(stderr, "kernel_launch: unexpected shapes: n_in %d in0 %d out %d ws %zu (need %zu); nothing launched\n", n_in, n_in > 0 ? in_sizes[0] : -1, out_size, ws_size, (size_t)WS_END); grid = -1; return; }
        int dev = 0, cus = 0, per_cu = 0;
        if (hipGetDevice(&dev) != hipSuccess || hipDeviceGetAttribute(&cus, hipDeviceAttributeMultiprocessorCount, dev) != hipSuccess) { fprintf(stderr, "kernel_launch: device query failed\n"); grid = -1; return; }
        if (hipFuncSetAttribute((const void*)trunk_fwd, hipFuncAttributeMaxDynamicSharedMemorySize, LDS_BYTES) != hipSuccess) { fprintf(stderr, "kernel_launch: hipFuncSetAttribute failed\n"); grid = -1; return; }
        if (hipOccupancyMaxActiveBlocksPerMultiprocessor(&per_cu, (const void*)trunk_fwd, NWAVES * 64, LDS_BYTES) != hipSuccess || per_cu < 1) { fprintf(stderr, "kernel_launch: occupancy query says %d blocks per CU\n", per_cu); }
        (void)hipGetLastError();
        grid = cus;
        fprintf(stderr, "kernel_launch: grid %d, per_cu %d, ws %zu\n", grid, per_cu, ws_size);
    }
    if (grid < 0) return;
    if (hipMemsetAsync((char*)d_ws + WS_CTL, 0, CTL_ZERO_BYTES, stream) != hipSuccess) { fprintf(stderr, "kernel_launch: memset failed\n"); return; }
    Args a{};
    for (int i = 0; i < 19; ++i) a.in[i] = (const float*)d_in[i];
    a.out = (float*)d_out; a.ws = (unsigned char*)d_ws;
    for (int li = 0; li < MK_N_LAUNCHES; ++li) {
        a.ph_lo = (MK_N_LAUNCHES == 1) ? 0 : li; a.ph_hi = (MK_N_LAUNCHES == 1) ? N_PHASES : li + 1;
        hipLaunchKernelGGL(trunk_fwd, dim3(grid), dim3(NWAVES * 64), LDS_BYTES, stream, a);
        const hipError_t le = hipPeekAtLastError();
        if (le != hipSuccess) { fprintf(stderr, "kernel_launch: launch %d failed: %s\n", li, hipGetErrorName(le)); break; }
    }
}
```
